# Optimizing an MI355X kernel written in HIP

```python
import jax, jax.numpy as jnp
from jax import lax
import numpy as np

D_MODEL = 1024
BATCH = 4
SEQ = 4096
DEPTH = 2

HEAD_DIM = 64
N_HEADS = 8
N_KV_HEADS = 2
ROT_DIM = HEAD_DIM // 4
ROPE_THETA = 500000.0
IDX_HEADS = 8
IDX_DIM = 64
MAX_TOPK = 256
Q_BLOCK = 128
POOL_CH = D_MODEL // 2
POOL_WINDOWS = (2, 4, 8, 16)
POOL_GROUP = POOL_CH // 4
N_EXPERTS = 32
TOP_K = 4
D_FF = D_MODEL
SWIGLU_LIMIT = 7.0
SWIGLU_ALPHA = 1.702
EXPERT_BLOCK = 128
PLE_DIM = 256
LN_EPS = 1e-5
DN_ALPHA = (2 * DEPTH) ** 0.25
DN_BETA = (8 * DEPTH) ** -0.25
SPLIT_SIZES = (N_HEADS * HEAD_DIM, N_KV_HEADS * HEAD_DIM, N_KV_HEADS * HEAD_DIM,
               IDX_HEADS * IDX_DIM, IDX_DIM, IDX_HEADS, POOL_CH, D_MODEL, D_MODEL)
D_IN = sum(SPLIT_SIZES)

kernel_name = 'hybrid_dsa_pool_moe_deepnorm'


def _layer_norm(x, g, b):
    xf = x.astype(jnp.float32)
    mu = xf.mean(-1, keepdims=True)
    var = jnp.square(xf - mu).mean(-1, keepdims=True)
    y = (xf - mu) * lax.rsqrt(var + LN_EPS) * g.astype(jnp.float32) + b.astype(jnp.float32)
    return y.astype(x.dtype)


def _rope_tables(L):
    pos = jnp.arange(L, dtype=jnp.float32)
    inv = ROPE_THETA ** (-jnp.arange(0, ROT_DIM, 2, dtype=jnp.float32) / ROT_DIM)
    ang = pos[:, None] * inv[None, :]
    return jnp.cos(ang), jnp.sin(ang)


def _partial_rope(x, cos, sin):
    half = ROT_DIM // 2
    xf = x.astype(jnp.float32)
    x1, x2 = xf[..., :half], xf[..., half:ROT_DIM]
    c, s = cos[None, :, None, :], sin[None, :, None, :]
    out = jnp.concatenate([x1 * c - x2 * s, x2 * c + x1 * s, xf[..., ROT_DIM:]], axis=-1)
    return out.astype(x.dtype)


def _dsa_attention(q, k, v, qi, ki, wi):
    B, L, H, Dh = q.shape
    n_sel = min(MAX_TOPK, L // 4)
    n_blk = L // Q_BLOCK
    group = N_HEADS // N_KV_HEADS
    key_pos = jnp.arange(L)
    wi = wi * (IDX_HEADS ** -0.5)

    def to_blocks(a):
        return a.reshape((B, n_blk, Q_BLOCK) + a.shape[2:]).swapaxes(0, 1)

    def one_block(args):
        qb, qib, wib, start = args
        qpos = start + jnp.arange(Q_BLOCK)
        causal = key_pos[None, :] <= qpos[:, None]
        dots = jnp.einsum('bqhd,bsd->bqhs', qib.astype(jnp.float32),
                          ki.astype(jnp.float32)) * (IDX_DIM ** -0.5)
        score = jnp.einsum('bqhs,bqh->bqs', jax.nn.relu(dots), wib.astype(jnp.float32))
        score = jnp.where(causal[None], score, -jnp.inf)
        _, sel = lax.top_k(score, n_sel)
        kg = jax.vmap(lambda kb, ib: kb[ib])(k, sel)
        vg = jax.vmap(lambda vb, ib: vb[ib])(v, sel)
        qg = qb.reshape(B, Q_BLOCK, N_KV_HEADS, group, Dh)
        logits = jnp.einsum('bqcgd,bqncd->bqcgn', qg, kg).astype(jnp.float32) * (Dh ** -0.5)
        valid = sel <= qpos[None, :, None]
        logits = jnp.where(valid[:, :, None, None, :], logits, -jnp.inf)
        probs = jax.nn.softmax(logits, axis=-1).astype(v.dtype)
        o = jnp.einsum('bqcgn,bqncd->bqcgd', probs, vg)
        return o.reshape(B, Q_BLOCK, H * Dh)

    starts = jnp.arange(n_blk) * Q_BLOCK
    out = lax.map(one_block, (to_blocks(q), to_blocks(qi), to_blocks(wi), starts))
    return out.swapaxes(0, 1).reshape(B, L, H * Dh)


def _pool_mixer(u, pool_w, pool_scale):
    B, L, C = u.shape
    uf = u.astype(jnp.float32)
    csum = jnp.pad(jnp.cumsum(uf, axis=1), ((0, 0), (1, 0), (0, 0)))
    pos1 = jnp.arange(1, L + 1, dtype=jnp.float32)[None, :, None]
    parts = []
    for g, win in enumerate(POOL_WINDOWS):
        sl = slice(g * POOL_GROUP, (g + 1) * POOL_GROUP)
        cg = csum[..., sl]
        upper = cg[:, 1:]
        lower = jnp.pad(cg, ((0, 0), (win - 1, 0), (0, 0)))[:, :L]
        mean = (upper - lower) / jnp.minimum(pos1, float(win))
        parts.append(mean - uf[..., sl])
    d = jnp.stack(parts, axis=2).astype(u.dtype)
    y = jnp.einsum('blgc,gcd->blgd', d, pool_w).reshape(B, L, C)
    return y * pool_scale


def _mixer(h, cos, sin, w_in, pool_w, pool_scale, w_up_attn, w_up_pool, w_out):
    B, L, _ = h.shape
    z = h @ w_in
    offsets = [int(o) for o in np.cumsum(SPLIT_SIZES)[:-1]]
    q, k, v, qi, ki, wi, u, g_attn, g_pool = jnp.split(z, offsets, axis=-1)
    q = _partial_rope(q.reshape(B, L, N_HEADS, HEAD_DIM), cos, sin)
    k = _partial_rope(k.reshape(B, L, N_KV_HEADS, HEAD_DIM), cos, sin)
    v = v.reshape(B, L, N_KV_HEADS, HEAD_DIM)
    qi = _partial_rope(qi.reshape(B, L, IDX_HEADS, IDX_DIM), cos, sin)
    ki = _partial_rope(ki.reshape(B, L, 1, IDX_DIM), cos, sin)[:, :, 0]
    y_attn = _dsa_attention(q, k, v, qi, ki, wi)
    y_pool = _pool_mixer(u, pool_w, pool_scale)
    merged = jax.nn.sigmoid(g_attn) * (y_attn @ w_up_attn) + jax.nn.sigmoid(g_pool) * (y_pool @ w_up_pool)
    return merged @ w_out


def _moe(h, router_w, router_b, w_gu, b_gu, w_down, b_down):
    B, L, D = h.shape
    N = B * L
    hf = h.reshape(N, D)
    logits = (hf @ router_w + router_b).astype(jnp.float32)
    top_val, top_idx = lax.top_k(logits, TOP_K)
    gates = jax.nn.softmax(top_val, axis=-1)
    A = N * TOP_K
    e_flat = top_idx.reshape(A).astype(jnp.int32)
    tok_flat = jnp.repeat(jnp.arange(N, dtype=jnp.int32), TOP_K)
    g_flat = gates.reshape(A)
    order = jnp.argsort(e_flat)
    e_sorted = e_flat[order]
    counts = jnp.zeros((N_EXPERTS,), jnp.int32).at[e_flat].add(1)
    padded = (counts + EXPERT_BLOCK - 1) // EXPERT_BLOCK * EXPERT_BLOCK
    pend = jnp.cumsum(padded)
    pstart = pend - padded
    gstart = jnp.cumsum(counts) - counts
    dest = pstart[e_sorted] + (jnp.arange(A, dtype=jnp.int32) - gstart[e_sorted])
    n_blocks = -(-A // EXPERT_BLOCK) + N_EXPERTS
    R = n_blocks * EXPERT_BLOCK
    row_tok = jnp.full((R,), N, jnp.int32).at[dest].set(tok_flat[order])
    row_gate = jnp.zeros((R,), jnp.float32).at[dest].set(g_flat[order])
    blk_start = jnp.arange(n_blocks, dtype=jnp.int32) * EXPERT_BLOCK
    blk_exp = jnp.minimum(jnp.searchsorted(pend, blk_start, side='right'), N_EXPERTS - 1)
    h_pad = jnp.concatenate([hf, jnp.zeros((1, D), hf.dtype)], axis=0)
    xr = h_pad[row_tok].reshape(n_blocks, EXPERT_BLOCK, D)

    def expert_block(args):
        xb, e = args
        gu = xb @ w_gu[e] + b_gu[e]
        gt, up = gu[:, :D_FF], gu[:, D_FF:]
        gt = jnp.minimum(gt, SWIGLU_LIMIT)
        up = jnp.clip(up, -SWIGLU_LIMIT, SWIGLU_LIMIT)
        act = gt * jax.nn.sigmoid(SWIGLU_ALPHA * gt) * (up + 1.0)
        return act @ w_down[e] + b_down[e]

    yr = lax.map(expert_block, (xr, blk_exp)).reshape(R, D)
    y = jax.ops.segment_sum(yr.astype(jnp.float32) * row_gate[:, None], row_tok, num_segments=N + 1)[:N]
    return y.astype(h.dtype).reshape(B, L, D)


def setup_inputs(seed: int = 0) -> dict:
    key = jax.random.key(seed)
    ks = jax.random.split(key, 24)

    def nrm(k, shape, scale):
        return jax.random.normal(k, shape, jnp.float32) * scale

    Ld = DEPTH
    return {
        'x': nrm(ks[0], (BATCH, SEQ, D_MODEL), 1.0),
        'p': nrm(ks[1], (DEPTH, BATCH, SEQ, PLE_DIM), 1.0),
        'ln0_g': 1.0 + nrm(ks[2], (D_MODEL,), 0.1),
        'ln0_b': nrm(ks[3], (D_MODEL,), 0.01),
        'w_in': nrm(ks[4], (Ld, D_MODEL, D_IN), D_MODEL ** -0.5),
        'pool_w': nrm(ks[5], (Ld, 4, POOL_GROUP, POOL_GROUP), POOL_GROUP ** -0.5),
        'pool_scale': 1.0 + nrm(ks[6], (Ld, POOL_CH), 0.1),
        'w_up_attn': nrm(ks[7], (Ld, N_HEADS * HEAD_DIM, D_MODEL), (N_HEADS * HEAD_DIM) ** -0.5),
        'w_up_pool': nrm(ks[8], (Ld, POOL_CH, D_MODEL), POOL_CH ** -0.5),
        'w_out': nrm(ks[9], (Ld, D_MODEL, D_MODEL), DN_BETA * D_MODEL ** -0.5),
        'ln1_g': 1.0 + nrm(ks[10], (Ld, D_MODEL), 0.1),
        'ln1_b': nrm(ks[11], (Ld, D_MODEL), 0.01),
        'router_w': nrm(ks[12], (Ld, D_MODEL, N_EXPERTS), D_MODEL ** -0.5),
        'router_b': nrm(ks[13], (Ld, N_EXPERTS), 0.01),
        'exp_w_gu': nrm(ks[14], (Ld, N_EXPERTS, D_MODEL, 2 * D_FF), D_MODEL ** -0.5),
        'exp_b_gu': nrm(ks[15], (Ld, N_EXPERTS, 2 * D_FF), 0.01),
        'exp_w_down': nrm(ks[16], (Ld, N_EXPERTS, D_FF, D_MODEL), DN_BETA * D_FF ** -0.5),
        'exp_b_down': nrm(ks[17], (Ld, N_EXPERTS, D_MODEL), 0.01),
        'ple_w_gate': nrm(ks[18], (Ld, D_MODEL, D_MODEL), D_MODEL ** -0.5),
        'ple_w_proj': nrm(ks[19], (Ld, PLE_DIM, D_MODEL), DN_BETA * PLE_DIM ** -0.5),
        'ln2_g': 1.0 + nrm(ks[20], (Ld, D_MODEL), 0.1),
        'ln2_b': nrm(ks[21], (Ld, D_MODEL), 0.01),
    }


def reference(x, p, ln0_g, ln0_b, w_in, pool_w, pool_scale, w_up_attn, w_up_pool, w_out,
              ln1_g, ln1_b, router_w, router_b, exp_w_gu, exp_b_gu, exp_w_down, exp_b_down,
              ple_w_gate, ple_w_proj, ln2_g, ln2_b):
    L = x.shape[1]
    cos, sin = _rope_tables(L)
    x = _layer_norm(x, ln0_g, ln0_b)
    for i in range(DEPTH):
        mix = _mixer(x, cos, sin, w_in[i], pool_w[i], pool_scale[i], w_up_attn[i], w_up_pool[i], w_out[i])
        x = _layer_norm(DN_ALPHA * x + mix, ln1_g[i], ln1_b[i])
        ffn = _moe(x, router_w[i], router_b[i], exp_w_gu[i], exp_b_gu[i], exp_w_down[i], exp_b_down[i])
        ple = jax.nn.sigmoid(x @ ple_w_gate[i]) * (p[i].astype(x.dtype) @ ple_w_proj[i])
        x = _layer_norm(DN_ALPHA * x + ffn + ple, ln2_g[i], ln2_b[i])
    return x
```

```cpp
#include <hip/hip_runtime.h>
#ifndef ATT_PROBE
#define ATT_PROBE 0
#endif
#include <cstdio>
#include <cstdint>

#define LAS __attribute__((address_space(3)))
#define GAS __attribute__((address_space(1)))
typedef unsigned short bf16;
typedef short bf16x8 __attribute__((ext_vector_type(8)));
typedef float f32x4 __attribute__((ext_vector_type(4)));
typedef float f32x2 __attribute__((ext_vector_type(2)));
typedef float f32x16 __attribute__((ext_vector_type(16)));
typedef unsigned u32x4 __attribute__((ext_vector_type(4)));
typedef unsigned u32x2 __attribute__((ext_vector_type(2)));
typedef GAS unsigned gu32;

constexpr int D = 1024, BATCH = 4, SEQ = 4096, M = BATCH * SEQ, DEPTH = 2;
constexpr int NZ = 4096;
constexpr int D_IN = 3912;
constexpr int NE = 32, TOPK = 4, DFF = 1024, PLE = 256;
constexpr int NSEL = 256;
constexpr int RMAX = M * TOPK + NE * 256;
constexpr int TMAX = RMAX / 256;
constexpr float LN_EPS = 1e-5f;
constexpr float DN_ALPHA = 1.41421356237309515f;

__device__ __forceinline__ unsigned f2bf(float f) { unsigned u = __builtin_bit_cast(unsigned, f); return (u + 0x7fffu + ((u >> 16) & 1u)) >> 16; }
typedef __bf16 hwbf16x2 __attribute__((ext_vector_type(2)));
__device__ __forceinline__ unsigned pk2(float lo, float hi) { const f32x2 v = {lo, hi}; return __builtin_bit_cast(unsigned, __builtin_convertvector(v, hwbf16x2)); }
__device__ __forceinline__ float bf2f(unsigned short h) { return __builtin_bit_cast(float, (unsigned)h << 16); }
__device__ __forceinline__ float bflo(unsigned w) { return __builtin_bit_cast(float, w << 16); }
__device__ __forceinline__ float bfhi(unsigned w) { return __builtin_bit_cast(float, w & 0xffff0000u); }
__device__ __forceinline__ float sigmoidf_(float x) { return __builtin_amdgcn_rcpf(1.0f + __expf(-x)); }
constexpr float I8_WS_GU = 127.0f / (6.0f / 32.0f), I8_WS_DN = 127.0f / (6.0f / 64.0f), I8_AS = 127.0f / 10.0f;
__device__ __forceinline__ unsigned pack4_i8(float a, float b, float c, float d) {
    unsigned r = 0u;
    r = __builtin_amdgcn_cvt_pk_u8_f32(a + 128.0f, 0, r); r = __builtin_amdgcn_cvt_pk_u8_f32(b + 128.0f, 1, r);
    r = __builtin_amdgcn_cvt_pk_u8_f32(c + 128.0f, 2, r); r = __builtin_amdgcn_cvt_pk_u8_f32(d + 128.0f, 3, r);
    return r ^ 0x80808080u;
}
__device__ __forceinline__ unsigned pack4_fp8(float a, float b, float c, float d) { int r = __builtin_amdgcn_cvt_pk_fp8_f32(a, b, 0, false); r = __builtin_amdgcn_cvt_pk_fp8_f32(c, d, r, true); return (unsigned)r; }
#define LDS_WAIT() asm volatile("s_waitcnt lgkmcnt(0)" ::: "memory")
#define VM_WAIT() asm volatile("s_waitcnt vmcnt(0)" ::: "memory")
#define WAVE_FENCE() do { asm volatile("s_waitcnt lgkmcnt(0)" ::: "memory"); __builtin_amdgcn_wave_barrier(); } while (0)

template <int X> __device__ __forceinline__ float shx(float v) {
    static_assert(X == 1 || X == 2 || X == 4 || X == 8 || X == 16, "shx: xor distance below 32");
    return __builtin_bit_cast(float, __builtin_amdgcn_ds_swizzle(__builtin_bit_cast(int, v), (X << 10) | 0x1f));
}
template <int X> __device__ __forceinline__ int shxi(int v) { return __builtin_amdgcn_ds_swizzle(v, (X << 10) | 0x1f); }
struct SwapPair { unsigned a, b; };
__device__ __forceinline__ SwapPair swap32(float v) { unsigned a = __builtin_bit_cast(unsigned, v), b = a; asm volatile("" : "+v"(b)); const auto r = __builtin_amdgcn_permlane32_swap(a, b, false, false); return SwapPair{r[0], r[1]}; }
__device__ __forceinline__ float sum32(float v) { const SwapPair r = swap32(v); return __builtin_bit_cast(float, r.a) + __builtin_bit_cast(float, r.b); }
__device__ __forceinline__ float max32(float v) { const SwapPair r = swap32(v); return fmaxf(__builtin_bit_cast(float, r.a), __builtin_bit_cast(float, r.b)); }
__device__ __forceinline__ float min32(float v) { const SwapPair r = swap32(v); return fminf(__builtin_bit_cast(float, r.a), __builtin_bit_cast(float, r.b)); }
__device__ __forceinline__ float partner32(float v, bool upper_half) { const SwapPair r = swap32(v); return __builtin_bit_cast(float, upper_half ? r.a : r.b); }

namespace pg8 {
typedef int i32x4 __attribute__((ext_vector_type(4)));
typedef int i32x8 __attribute__((ext_vector_type(8)));
constexpr int BM = 256, BK = 64, HALF = 128, HTB = HALF * BK * 2  , STAGE_BYTES = 8 * HTB;

__host__ __device__ __forceinline__ int lds_byte(int r, int c) { const int st = (r >> 4) * 2 + (c >> 5), rr = r & 15, cc = c & 31, ob = rr * 64 + cc * 2; return st * 1024 + (ob ^ (((ob >> 9) & 1) << 5)); }
__host__ __device__ __forceinline__ void stage_rc(int b, int& R, int& C) { const int st = b / 1024, sb = b % 1024, swz = sb ^ (((sb >> 9) & 1) << 5); R = (st >> 1) * 16 + swz / 64; C = (st & 1) * 32 + (swz % 64) / 2; }
__host__ __device__ __forceinline__ int perm32(int rho) { const int n = rho >> 4, i = rho & 15; return 8 * (i >> 2) + 4 * n + (i & 3); }

struct Unit { int pm, pn, aux; const char* a; const char* b; };
struct Gemm { int lda, K; };

template <class Epi, class Sched, bool ALIGN_EPI, bool I8 = false>
__device__ __forceinline__ void gemm_phase(LAS unsigned char* lds, const int wave_id, const Gemm g, const Sched& S, const Epi& E) {
    int lane = (int)__builtin_amdgcn_mbcnt_hi(~0u, __builtin_amdgcn_mbcnt_lo(~0u, 0u)); asm volatile("" : "+v"(lane));
    const int wid = wave_id, tid = wave_id * 64 + lane, wr = wid >> 2, wc = wid & 3, fr = lane & 15, fq = lane >> 4;
    const int K = g.K, nt = K / BK, lda = g.lda;
    unsigned voffA[2], voffB[2];
#pragma unroll
    for (int i = 0; i < 2; ++i) { int R, C; stage_rc(tid * 16 + i * 8192, R, C); const int Rb = Epi::PERM ? ((R & ~31) + perm32(R & 31)) : R;
        voffA[i] = (unsigned)(R * lda + C) * 2u; voffB[i] = (unsigned)(Rb * K + C) * 2u; }
    const size_t kstep = (size_t)(BK * 2);
    const size_t hstepA = (size_t)HALF * lda * 2, hstepB = (size_t)HALF * K * 2;
    const unsigned ldsw = (unsigned)wid * 1024u;
    const int aoff = lds_byte(wr * 64 + fr, fq * 8), boff = lds_byte(wc * 32 + fr, fq * 8);
#define PG8_SA(b, h) (((b) * 2 + (h)) * HTB)
#define PG8_SB(b, h) ((4 + (b) * 2 + (h)) * HTB)
#define PG8_STAGE(bufoff, gbase, voff) do { _Pragma("unroll") for (int _i = 0; _i < 2; ++_i) \
        __builtin_amdgcn_global_load_lds((const unsigned*)((const char*)(gbase) + (voff)[_i]), (LAS unsigned*)(lds + (bufoff) + ldsw + _i * 8192), 16, 0, 0); } while (0)
#define PG8_LDA(dst, b, h) do { _Pragma("unroll") for (int m = 0; m < 4; ++m) dst[m] = __builtin_shufflevector(*(const LAS i32x4*)(lds + PG8_SA(b, h) + aoff + m * 2048), *(const LAS i32x4*)(lds + PG8_SA(b, h) + aoff + m * 2048 + 1024), 0, 1, 2, 3, 4, 5, 6, 7); } while (0)
#define PG8_LDB(dst, b, h) do { _Pragma("unroll") for (int n = 0; n < 2; ++n) dst[n] = __builtin_shufflevector(*(const LAS i32x4*)(lds + PG8_SB(b, h) + boff + n * 2048), *(const LAS i32x4*)(lds + PG8_SB(b, h) + boff + n * 2048 + 1024), 0, 1, 2, 3, 4, 5, 6, 7); } while (0)
#define PG8_HALFI(v, k) __builtin_shufflevector(v, v, 4 * (k), 4 * (k) + 1, 4 * (k) + 2, 4 * (k) + 3)
#define PG8_HALF(v, k) __builtin_bit_cast(bf16x8, __builtin_shufflevector(v, v, 4 * (k), 4 * (k) + 1, 4 * (k) + 2, 4 * (k) + 3))
#define PG8_MMA(ai, bj, At, Bt) do { __builtin_amdgcn_s_setprio(1); \
        if constexpr (I8) { _Pragma("unroll") for (int m = 0; m < 4; ++m) _Pragma("unroll") for (int n = 0; n < 2; ++n) { \
            acc[ai][bj][m][n] = __builtin_bit_cast(f32x4, __builtin_amdgcn_mfma_i32_16x16x64_i8(PG8_HALFI(Bt[n], 0), PG8_HALFI(At[m], 0), __builtin_bit_cast(i32x4, acc[ai][bj][m][n]), 0, 0, 0)); \
            acc[ai][bj][m][n] = __builtin_bit_cast(f32x4, __builtin_amdgcn_mfma_i32_16x16x64_i8(PG8_HALFI(Bt[n], 1), PG8_HALFI(At[m], 1), __builtin_bit_cast(i32x4, acc[ai][bj][m][n]), 0, 0, 0)); } } \
        else { _Pragma("unroll") for (int m = 0; m < 4; ++m) _Pragma("unroll") for (int n = 0; n < 2; ++n) { \
            acc[ai][bj][m][n] = __builtin_amdgcn_mfma_f32_16x16x32_bf16(PG8_HALF(Bt[n], 0), PG8_HALF(At[m], 0), acc[ai][bj][m][n], 0, 0, 0); \
            acc[ai][bj][m][n] = __builtin_amdgcn_mfma_f32_16x16x32_bf16(PG8_HALF(Bt[n], 1), PG8_HALF(At[m], 1), acc[ai][bj][m][n], 0, 0, 0); } } \
        __builtin_amdgcn_s_setprio(0); } while (0)
#define PG8_WAIT_V(n) asm volatile("s_waitcnt vmcnt(" #n ")" ::: "memory")
#define PG8_WAIT_L(n) asm volatile("s_waitcnt lgkmcnt(" #n ")" ::: "memory")
#define PG8_BAR __builtin_amdgcn_s_barrier()
#define PG8_SCHED __builtin_amdgcn_sched_barrier(0)
    Unit cur, nxt; int ui = 0;
    if (!S.next(0, cur)) return;
    f32x4 acc[2][2][4][2];
#pragma unroll
    for (int a = 0; a < 2; ++a)
#pragma unroll
        for (int b = 0; b < 2; ++b)
#pragma unroll
            for (int m = 0; m < 4; ++m)
#pragma unroll
                for (int n = 0; n < 2; ++n) acc[a][b][m][n] = (f32x4){0.f, 0.f, 0.f, 0.f};
    i32x8 At[4], B0[2], B1[2];
    const char* cA = cur.a; const char* cB = cur.b;
    PG8_STAGE(PG8_SB(0, 0), cB, voffB); PG8_STAGE(PG8_SB(0, 1), cB + hstepB, voffB); PG8_STAGE(PG8_SA(0, 0), cA, voffA); PG8_STAGE(PG8_SA(0, 1), cA + hstepA, voffA);
    if (wr == 1) PG8_BAR;
    PG8_WAIT_V(2); PG8_BAR;
    PG8_STAGE(PG8_SB(1, 0), cB + kstep, voffB); PG8_STAGE(PG8_SA(1, 0), cA + kstep, voffA); PG8_STAGE(PG8_SB(1, 1), cB + hstepB + kstep, voffB);
    PG8_WAIT_V(6); PG8_BAR;
    for (;;) {
        const bool has_next = S.next(ui + 1, nxt);
        const char* nA = has_next ? nxt.a : cA; const char* nB = has_next ? nxt.b : cB;
#pragma unroll 1
        for (int t = 0; t < nt; t += 2) {
            const bool last = (t == nt - 2);
            const char* a1 = cA + (size_t)(t + 1) * kstep;
            const char* a2 = last ? nA : cA + (size_t)(t + 2) * kstep; const char* b2 = last ? nB : cB + (size_t)(t + 2) * kstep;
            const char* a3 = a2 + kstep; const char* b3 = b2 + kstep;
            PG8_LDB(B0, 0, 0); PG8_LDB(B1, 0, 1); PG8_SCHED; PG8_LDA(At, 0, 0); PG8_STAGE(PG8_SA(1, 1), a1 + hstepA, voffA);
            PG8_WAIT_V(8); PG8_WAIT_L(0); PG8_BAR; PG8_MMA(0, 0, At, B0); PG8_MMA(0, 1, At, B1); PG8_BAR; PG8_SCHED;
            PG8_LDA(At, 0, 1); PG8_STAGE(PG8_SB(0, 0), b2, voffB); PG8_STAGE(PG8_SB(0, 1), b2 + hstepB, voffB); PG8_STAGE(PG8_SA(0, 0), a2, voffA);
            PG8_WAIT_V(8); PG8_WAIT_L(0); PG8_BAR; PG8_MMA(1, 0, At, B0); PG8_MMA(1, 1, At, B1); PG8_BAR; PG8_SCHED;
            PG8_LDB(B0, 1, 0); PG8_LDB(B1, 1, 1); PG8_SCHED; PG8_LDA(At, 1, 0); PG8_STAGE(PG8_SA(0, 1), a2 + hstepA, voffA);
            PG8_WAIT_V(8); PG8_WAIT_L(0); PG8_BAR; PG8_MMA(0, 0, At, B0); PG8_MMA(0, 1, At, B1); PG8_BAR; PG8_SCHED;
            PG8_LDA(At, 1, 1); PG8_STAGE(PG8_SB(1, 0), b3, voffB); PG8_STAGE(PG8_SB(1, 1), b3 + hstepB, voffB); PG8_STAGE(PG8_SA(1, 0), a3, voffA);
            PG8_WAIT_V(8); PG8_WAIT_L(0); PG8_BAR; PG8_MMA(1, 0, At, B0); PG8_MMA(1, 1, At, B1); PG8_BAR; PG8_SCHED;
            if constexpr (Epi::MID) { if (t + 2 == nt / 2) { int fr_m = fr, fq_m = fq; asm volatile("" : "+v"(fr_m), "+v"(fq_m)); E.mid(acc, cur, wr, wc, fr_m, fq_m); } }
        }
        if constexpr (ALIGN_EPI) { if (wr == 0) PG8_BAR; }
        { int fr_e = fr, fq_e = fq; asm volatile("" : "+v"(fr_e), "+v"(fq_e));
          E(acc, cur, wr, wc, fr_e, fq_e);
#if ATT_PROBE == 9
          if constexpr (I8) { asm volatile("" : "+v"(fr_e), "+v"(fq_e)); E(acc, cur, wr, wc, fr_e, fq_e); }
#endif
        }
        if (!has_next) break;
#pragma unroll
        for (int a = 0; a < 2; ++a)
#pragma unroll
            for (int b = 0; b < 2; ++b)
#pragma unroll
                for (int m = 0; m < 4; ++m)
#pragma unroll
                    for (int n = 0; n < 2; ++n) acc[a][b][m][n] = (f32x4){0.f, 0.f, 0.f, 0.f};
        cur = nxt; cA = nA; cB = nB; ++ui;
        if constexpr (ALIGN_EPI) { if (wr == 1) PG8_BAR; }
    }
    PG8_WAIT_V(0);
    if constexpr (!ALIGN_EPI) { if (wr == 0) PG8_BAR; }
    PG8_BAR;
#undef PG8_SA
#undef PG8_SB
#undef PG8_STAGE
#undef PG8_LDA
#undef PG8_LDB
#undef PG8_HALF
#undef PG8_HALFI
#undef PG8_MMA
#undef PG8_WAIT_V
#undef PG8_WAIT_L
#undef PG8_BAR
#undef PG8_SCHED
}
}

namespace pg8 {
constexpr int NXCD = 8, WGM = 8;
struct StaticSched {
    int nM, nN, nwg, G, c; const char* A; const char* B; size_t strideA, strideB;
    __device__ __forceinline__ void init(int M_, int N_, int G_, int c_, const void* A_, int lda, const void* B_, int K) {
        nM = M_ / BM; nN = N_ / BM; nwg = nM * nN; G = G_; c = c_; A = (const char*)A_; B = (const char*)B_; strideA = (size_t)BM * lda * 2; strideB = (size_t)BM * K * 2; }
    __device__ __forceinline__ bool next(int i, Unit& u) const {
        const long L = (long)i * G + c; if (L >= nwg) return false;
        int wgid = (int)L; { const int q = nwg / NXCD, r = nwg % NXCD, xcd = wgid % NXCD, off = wgid / NXCD; wgid = (xcd < r ? xcd * (q + 1) : r * (q + 1) + (xcd - r) * q) + off; }
        const int nig = WGM * nN, gid = wgid / nig, fm = gid * WGM, gsz = (nM - fm) < WGM ? (nM - fm) : WGM;
        u.pm = fm + ((wgid % nig) % gsz); u.pn = (wgid % nig) / gsz; u.aux = 0;
        u.a = A + (size_t)u.pm * strideA; u.b = B + (size_t)u.pn * strideB; return true;
    }
};
struct MoeSched {
    int ntiles, nN, G, v; const LAS int* tile_e; const char* A; const char* W; size_t strideA, strideE, strideB;
    int p0, np; const char* PA; const char* PW; size_t pstrideA, pstrideB;
    __device__ __forceinline__ bool next(int i, Unit& u) const {
        const int L = i * G + v, nmoe = ntiles * nN;
        if (L < nmoe) { const int tile = L / nN, pn = L - tile * nN; const int e = tile_e[tile];
            u.pm = tile; u.pn = pn; u.aux = e; u.a = A + (size_t)tile * strideA; u.b = W + (size_t)e * strideE + (size_t)pn * strideB; return true; }
        const int p = L - nmoe; if (p >= np) return false;
        const int q = p0 + p; u.pm = q >> 2; u.pn = q & 3; u.aux = -1; u.a = PA + (size_t)u.pm * pstrideA; u.b = PW + (size_t)u.pn * pstrideB; return true;
    }
};

#define EPI_LOOP_ROWS for (int ai = 0; ai < 2; ++ai) _Pragma("unroll") for (int m = 0; m < 4; ++m)
__device__ __forceinline__ u32x4 pack8(f32x4 v0, f32x4 v1) { u32x4 w; w.x = pk2(v0[0], v0[1]); w.y = pk2(v0[2], v0[3]); w.z = pk2(v1[0], v1[1]); w.w = pk2(v1[2], v1[3]); return w; }

__device__ __forceinline__ f32x4 i2f4(f32x4 a) { const i32x4 v = __builtin_bit_cast(i32x4, a); return (f32x4){(float)v[0], (float)v[1], (float)v[2], (float)v[3]}; }
__device__ __forceinline__ f32x4 sigmoid4(f32x4 x) {
    const f32x4 t = x * (-1.44269504088896341f); f32x4 e;
#pragma unroll
    for (int i = 0; i < 4; ++i) e[i] = __builtin_amdgcn_exp2f(t[i]);
    e = e + 1.0f;
#pragma unroll
    for (int i = 0; i < 4; ++i) e[i] = __builtin_amdgcn_rcpf(e[i]);
    return e;
}
template <bool I8IN> struct EpiZ {
    static constexpr bool PERM = true, MID = false;
    bf16 *Q, *KV, *QI, *KI; float* WI; bf16 *U, *SGA, *SGB; const float* rope; const float* rows;
    __device__ __forceinline__ void operator()(const f32x4 (&acc)[2][2][4][2], const Unit& u, int wr, int wc, int fr, int fq) const {
        const int pn = u.pn; bf16* dst; int ldc, cb; unsigned ropemask = 0u; int mode = 0;
        if (pn < 2) { dst = Q; ldc = 512; cb = 256 * pn; ropemask = 0xFu; }
        else if (pn == 2) { dst = KV; ldc = 256; cb = 0; ropemask = 0x3u; }
        else if (pn < 5) { dst = QI; ldc = 512; cb = 256 * (pn - 3); ropemask = 0xFu; }
        else if (pn == 5) { dst = KI; ldc = 64; cb = 0; ropemask = 0x1u; mode = 2; }
        else if (pn < 8) { dst = U; ldc = 512; cb = 256 * (pn - 6); }
        else if (pn < 12) { dst = SGA; ldc = 1024; cb = 256 * (pn - 8); mode = 1; }
        else { dst = SGB; ldc = 1024; cb = 256 * (pn - 12); mode = 1; }
        const int row0 = u.pm * BM + wr * 64 + fr;
#pragma unroll
        EPI_LOOP_ROWS {
            const int row = row0 + ai * HALF + m * 16; const int pos = row & (SEQ - 1);
            float rs = 1.0f; if constexpr (I8IN) rs = rows[row] * (1.0f / I8_WS_GU);
#pragma unroll
            for (int bj = 0; bj < 2; ++bj) {
                f32x4 v0 = acc[ai][bj][m][0], v1 = acc[ai][bj][m][1];
                if constexpr (I8IN) { v0 = i2f4(v0) * rs; v1 = i2f4(v1) * rs; }
                const int grp = 2 * bj + (wc >> 1);
                if (((ropemask >> grp) & 1u) && !(wc & 1)) {
                    f32x4 p0, p1;
#pragma unroll
                    for (int e = 0; e < 4; ++e) { p0[e] = shx<16>(v0[e]); p1[e] = shx<16>(v1[e]); }
                    if (fq < 2) {
                        const f32x4 c0 = *(const f32x4*)(rope + pos * 16), c1 = *(const f32x4*)(rope + pos * 16 + 4), s0 = *(const f32x4*)(rope + pos * 16 + 8), s1 = *(const f32x4*)(rope + pos * 16 + 12);
                        if (fq == 0) { v0 = v0 * c0 - p0 * s0; v1 = v1 * c1 - p1 * s1; }
                        else         { v0 = v0 * c0 + p0 * s0; v1 = v1 * c1 + p1 * s1; }
                    }
                }
                if (mode == 1) { v0 = sigmoid4(v0); v1 = sigmoid4(v1); }
                if (mode == 2) {
                    if (bj == 0) {
                        if (wc < 2) *(u32x4*)(KI + ((size_t)((row >> 5) * 4 + 2 * wc + (fq >> 1)) * 64 + (row & 31) + 32 * (fq & 1)) * 8) = pack8(v0, v1);
                        else if (wc == 2 && fq == 0) { *(f32x4*)(WI + (size_t)row * 8) = v0; *(f32x4*)(WI + (size_t)row * 8 + 4) = v1; }
                    }
                } else if (pn == 2) {
                    u32x2 w8; w8.x = pack4_fp8(v0[0], v0[1], v0[2], v0[3]); w8.y = pack4_fp8(v1[0], v1[1], v1[2], v1[3]);
                    *(u32x2*)((unsigned char*)KV + (size_t)row * 256 + 128 * bj + 32 * wc + 8 * fq) = w8;
                } else {
                    *(u32x4*)(dst + (size_t)row * ldc + cb + 128 * bj + 32 * wc + 8 * fq) = pack8(v0, v1);
                }
            }
        }
    }
};
struct EpiBf16 {
    static constexpr bool PERM = true, MID = false;
    bf16* O; int ldc, coff; const float* scale;
    __device__ __forceinline__ void operator()(const f32x4 (&acc)[2][2][4][2], const Unit& u, int wr, int wc, int fr, int fq) const {
        const int row0 = u.pm * BM + wr * 64 + fr, col0 = u.pn * BM + wc * 32 + 8 * fq;
        f32x4 sv[2][2];
#pragma unroll
        for (int bj = 0; bj < 2; ++bj)
#pragma unroll
            for (int n = 0; n < 2; ++n) sv[bj][n] = scale ? *(const f32x4*)(scale + col0 + bj * HALF + 4 * n) : (f32x4){1.f, 1.f, 1.f, 1.f};
#pragma unroll
        EPI_LOOP_ROWS {
            bf16* rowp = O + (size_t)(row0 + ai * HALF + m * 16) * ldc + coff + col0;
#pragma unroll
            for (int bj = 0; bj < 2; ++bj) *(u32x4*)(rowp + bj * HALF) = pack8(acc[ai][bj][m][0] * sv[bj][0], acc[ai][bj][m][1] * sv[bj][1]);
        }
    }
};
struct EpiGateMerge {
    static constexpr bool PERM = true, MID = true;
    const bf16* SGA; const bf16* SGB; bf16* O;
    __device__ __forceinline__ void mid(f32x4 (&acc)[2][2][4][2], const Unit& u, int wr, int wc, int fr, int fq) const {
        const int row0 = u.pm * BM + wr * 64 + fr, col0 = u.pn * BM + wc * 32 + 8 * fq;
#pragma unroll
        for (int aq = 0; aq < 4; ++aq) {
            const int ai = aq >> 1;
            u32x4 ga[2][2], gb[2][2];
#pragma unroll
            for (int mm = 0; mm < 2; ++mm)
#pragma unroll
                for (int bj = 0; bj < 2; ++bj) { const size_t off = (size_t)(row0 + ai * HALF + (2 * (aq & 1) + mm) * 16) * 1024 + col0 + bj * HALF; ga[mm][bj] = *(const u32x4*)(SGA + off); gb[mm][bj] = *(const u32x4*)(SGB + off); }
            asm volatile("" ::: "memory");
#pragma unroll
            for (int mm = 0; mm < 2; ++mm)
#pragma unroll
                for (int bj = 0; bj < 2; ++bj) {
                    const int m = 2 * (aq & 1) + mm;
                    const u32x4 a = ga[mm][bj], b = gb[mm][bj];
                    f32x4& v0 = acc[ai][bj][m][0]; f32x4& v1 = acc[ai][bj][m][1];
                    v0[0] *= bflo(a.x) * __builtin_amdgcn_rcpf(bflo(b.x)); v0[1] *= bfhi(a.x) * __builtin_amdgcn_rcpf(bfhi(b.x)); v0[2] *= bflo(a.y) * __builtin_amdgcn_rcpf(bflo(b.y)); v0[3] *= bfhi(a.y) * __builtin_amdgcn_rcpf(bfhi(b.y));
                    v1[0] *= bflo(a.z) * __builtin_amdgcn_rcpf(bflo(b.z)); v1[1] *= bfhi(a.z) * __builtin_amdgcn_rcpf(bfhi(b.z)); v1[2] *= bflo(a.w) * __builtin_amdgcn_rcpf(bflo(b.w)); v1[3] *= bfhi(a.w) * __builtin_amdgcn_rcpf(bfhi(b.w));
                }
            asm volatile("" ::: "memory");
        }
    }
    __device__ __forceinline__ void operator()(const f32x4 (&acc)[2][2][4][2], const Unit& u, int wr, int wc, int fr, int fq) const {
        const int row0 = u.pm * BM + wr * 64 + fr, col0 = u.pn * BM + wc * 32 + 8 * fq;
        u32x4 gq[2][4][2];
#pragma unroll
        EPI_LOOP_ROWS
#pragma unroll
            for (int bj = 0; bj < 2; ++bj) gq[ai][m][bj] = *(const u32x4*)(SGB + (size_t)(row0 + ai * HALF + m * 16) * 1024 + col0 + bj * HALF);
        asm volatile("" ::: "memory");
#pragma unroll
        EPI_LOOP_ROWS {
            const size_t off = (size_t)(row0 + ai * HALF + m * 16) * 1024 + col0;
#pragma unroll
            for (int bj = 0; bj < 2; ++bj) {
                const u32x4 g = gq[ai][m][bj];
                f32x4 v0 = acc[ai][bj][m][0], v1 = acc[ai][bj][m][1];
                v0[0] *= bflo(g.x); v0[1] *= bfhi(g.x); v0[2] *= bflo(g.y); v0[3] *= bfhi(g.y); v1[0] *= bflo(g.z); v1[1] *= bfhi(g.z); v1[2] *= bflo(g.w); v1[3] *= bfhi(g.w);
                *(u32x4*)(O + off + bj * HALF) = pack8(v0, v1);
            }
        }
        asm volatile("" ::: "memory");
    }
};
struct EpiResid {
    static constexpr bool PERM = false, MID = false;
    const float* X; float* V; float alpha;
    __device__ __forceinline__ void operator()(const f32x4 (&acc)[2][2][4][2], const Unit& u, int wr, int wc, int fr, int fq) const {
        const int row0 = u.pm * BM + wr * 64 + fr, col0 = u.pn * BM + wc * 32 + 4 * fq;
#pragma unroll
        for (int ai = 0; ai < 2; ++ai) {
            f32x4 xv[4][2][2];
#pragma unroll
            for (int m = 0; m < 4; ++m)
#pragma unroll
                for (int bj = 0; bj < 2; ++bj)
#pragma unroll
                    for (int n = 0; n < 2; ++n) xv[m][bj][n] = *(const f32x4*)(X + (size_t)(row0 + ai * HALF + m * 16) * 1024 + col0 + bj * HALF + n * 16);
            asm volatile("" ::: "memory");
#pragma unroll
            for (int m = 0; m < 4; ++m)
#pragma unroll
                for (int bj = 0; bj < 2; ++bj)
#pragma unroll
                    for (int n = 0; n < 2; ++n) *(f32x4*)(V + (size_t)(row0 + ai * HALF + m * 16) * 1024 + col0 + bj * HALF + n * 16) = xv[m][bj][n] * alpha + acc[ai][bj][m][n];
            asm volatile("" ::: "memory");
        }
    }
};
__device__ __forceinline__ f32x4 swiglu4(f32x4 g, f32x4 u) {
    f32x4 gt, up, sg;
#pragma unroll
    for (int e = 0; e < 4; ++e) { gt[e] = fminf(g[e], 7.0f); up[e] = fminf(fmaxf(u[e], -7.0f), 7.0f); }
    const f32x4 ea = gt * (-1.702f * 1.44269504088896341f);
#pragma unroll
    for (int e = 0; e < 4; ++e) sg[e] = __builtin_amdgcn_exp2f(ea[e]);
    sg = sg + 1.0f;
#pragma unroll
    for (int e = 0; e < 4; ++e) sg[e] = __builtin_amdgcn_rcpf(sg[e]);
    const f32x4 as4 = (f32x4){I8_AS, I8_AS, I8_AS, I8_AS};
    return (gt * sg) * __builtin_elementwise_fma(up, as4, as4);
}
struct EpiSwigluI8 {
    static constexpr bool PERM = true, MID = false;
    const float* bgu; const float* rows; unsigned char* ACT;
    __device__ __forceinline__ void operator()(const f32x4 (&acc)[2][2][4][2], const Unit& u, int wr, int wc, int fr, int fq) const {
        const int row0 = u.pm * BM + wr * 64 + fr, cin = wc * 32 + 8 * fq, col0 = u.pn * HALF + cin;
        const float* bb = bgu + (size_t)u.aux * 2048 + col0;
        const f32x4 bg0 = *(const f32x4*)(bb), bg1 = *(const f32x4*)(bb + 4), bu0 = *(const f32x4*)(bb + 1024), bu1 = *(const f32x4*)(bb + 1028);
        float rsv[2][4];
#pragma unroll
        EPI_LOOP_ROWS rsv[ai][m] = rows[row0 + ai * HALF + m * 16];
        asm volatile("" ::: "memory");
#pragma unroll
        EPI_LOOP_ROWS {
            const int row = row0 + ai * HALF + m * 16; const float rs = rsv[ai][m] * (1.0f / I8_WS_GU);
            const f32x4 rs4 = (f32x4){rs, rs, rs, rs};
            const f32x4 o0 = swiglu4(__builtin_elementwise_fma(i2f4(acc[ai][0][m][0]), rs4, bg0), __builtin_elementwise_fma(i2f4(acc[ai][1][m][0]), rs4, bu0));
            const f32x4 o1 = swiglu4(__builtin_elementwise_fma(i2f4(acc[ai][0][m][1]), rs4, bg1), __builtin_elementwise_fma(i2f4(acc[ai][1][m][1]), rs4, bu1));
            u32x2 w; w.x = pack4_i8(o0[0], o0[1], o0[2], o0[3]); w.y = pack4_i8(o1[0], o1[1], o1[2], o1[3]);
            *(u32x2*)(ACT + (size_t)row * 1024 + col0) = w;
        }
        asm volatile("" ::: "memory");
    }
};
struct EpiDownI8 {
    static constexpr bool PERM = true, MID = false;
    const float* bdn; const float* rowg; bf16* YR;
    __device__ __forceinline__ void operator()(const f32x4 (&acc)[2][2][4][2], const Unit& u, int wr, int wc, int fr, int fq) const {
        const int row0 = u.pm * BM + wr * 64 + fr, col0 = u.pn * BM + wc * 32 + 8 * fq;
        const float* bp = bdn + (size_t)u.aux * 1024 + col0;
        constexpr float rs = 1.0f / (I8_AS * I8_WS_DN);
        f32x4 bv[2][2]; float gv[2][4];
#pragma unroll
        for (int bj = 0; bj < 2; ++bj) { bv[bj][0] = *(const f32x4*)(bp + bj * HALF); bv[bj][1] = *(const f32x4*)(bp + bj * HALF + 4); }
#pragma unroll
        EPI_LOOP_ROWS gv[ai][m] = rowg[row0 + ai * HALF + m * 16];
        asm volatile("" ::: "memory");
#pragma unroll
        EPI_LOOP_ROWS {
            const int row = row0 + ai * HALF + m * 16; const float gt = gv[ai][m];
            const float rg = rs * gt; const f32x4 rg4 = (f32x4){rg, rg, rg, rg};
            f32x4 bg[2][2];
#pragma unroll
            for (int bj = 0; bj < 2; ++bj) { bg[bj][0] = bv[bj][0] * gt; bg[bj][1] = bv[bj][1] * gt; }
#pragma unroll
            for (int bj = 0; bj < 2; ++bj)
                *(u32x4*)(YR + (size_t)row * 1024 + col0 + bj * HALF) = pack8(__builtin_elementwise_fma(i2f4(acc[ai][bj][m][0]), rg4, bg[bj][0]), __builtin_elementwise_fma(i2f4(acc[ai][bj][m][1]), rg4, bg[bj][1]));
        }
        asm volatile("" ::: "memory");
    }
};
struct EpiPleGateI8 {
    static constexpr bool PERM = true, MID = false;
    const bf16* P; const float* rows; bf16* O;
    __device__ __forceinline__ void operator()(const f32x4 (&acc)[2][2][4][2], const Unit& u, int wr, int wc, int fr, int fq) const {
        const int row0 = u.pm * BM + wr * 64 + fr, col0 = u.pn * BM + wc * 32 + 8 * fq;
        float rsv[2][4];
#pragma unroll
        EPI_LOOP_ROWS rsv[ai][m] = rows[row0 + ai * HALF + m * 16];
#pragma unroll
        for (int ai = 0; ai < 2; ++ai) {
            u32x4 gq[4][2];
#pragma unroll
            for (int m = 0; m < 4; ++m)
#pragma unroll
                for (int bj = 0; bj < 2; ++bj) gq[m][bj] = *(const u32x4*)(P + (size_t)(row0 + ai * HALF + m * 16) * 1024 + col0 + bj * HALF);
            asm volatile("" ::: "memory");
#pragma unroll
            for (int m = 0; m < 4; ++m) {
                const int row = row0 + ai * HALF + m * 16; const size_t off = (size_t)row * 1024 + col0; const float rs = rsv[ai][m] * (1.0f / I8_WS_GU);
#pragma unroll
                for (int bj = 0; bj < 2; ++bj) {
                    const u32x4 g = gq[m][bj];
                    f32x4 v0 = i2f4(acc[ai][bj][m][0]) * rs, v1 = i2f4(acc[ai][bj][m][1]) * rs;
                    v0 = sigmoid4(v0) * (f32x4){bflo(g.x), bfhi(g.x), bflo(g.y), bfhi(g.y)};
                    v1 = sigmoid4(v1) * (f32x4){bflo(g.z), bfhi(g.z), bflo(g.w), bfhi(g.w)};
                    *(u32x4*)(O + off + bj * HALF) = pack8(v0, v1);
                }
            }
            asm volatile("" ::: "memory");
        }
    }
};
struct EpiSwigluPle {
    static constexpr bool PERM = true, MID = false;
    EpiSwigluI8 moe; EpiPleGateI8 ple;
    __device__ __forceinline__ void operator()(const f32x4 (&acc)[2][2][4][2], const Unit& u, int wr, int wc, int fr, int fq) const { if (u.aux >= 0) moe(acc, u, wr, wc, fr, fq); else ple(acc, u, wr, wc, fr, fq); }
};
struct EpiDownPle {
    static constexpr bool PERM = true, MID = false;
    EpiDownI8 moe; EpiPleGateI8 ple;
    __device__ __forceinline__ void operator()(const f32x4 (&acc)[2][2][4][2], const Unit& u, int wr, int wc, int fr, int fq) const { if (u.aux >= 0) moe(acc, u, wr, wc, fr, fq); else ple(acc, u, wr, wc, fr, fq); }
};
#undef EPI_LOOP_ROWS
}

constexpr size_t MiB = 1u << 20;
constexpr size_t WS_CTL = 0, CTL_ZERO_BYTES = 1 * MiB;
constexpr int CW_BAR = 4096;
constexpr size_t LW_WIN = 0, LW_WUPA = 8 * MiB, LW_WUPB = 9 * MiB, LW_POOL = 10 * MiB, LW_WOUT = 11 * MiB, LW_PLEG = 13 * MiB, LW_PLEP = 15 * MiB, LW_WGU = 16 * MiB, LW_WDN = 144 * MiB, LW_SIZE = 208 * MiB;
constexpr size_t WS_W = 1 * MiB;
constexpr size_t WS_ROPE = WS_W + DEPTH * LW_SIZE;
constexpr size_t WS_PB16 = WS_ROPE + 1 * MiB;
constexpr size_t WS_XF = WS_PB16 + 16 * MiB;
constexpr size_t WS_XB = WS_XF + 64 * MiB;
constexpr size_t WS_Q = WS_XB + 32 * MiB;
constexpr size_t WS_KV = WS_Q + 16 * MiB;
constexpr size_t WS_QI = WS_KV + 8 * MiB;
constexpr size_t WS_KI = WS_QI + 16 * MiB;
constexpr size_t WS_WI = WS_KI + 2 * MiB;
constexpr size_t WS_U = WS_WI + 1 * MiB;
constexpr size_t WS_SGA = WS_U + 16 * MiB;
constexpr size_t WS_SGB = WS_SGA + 32 * MiB;
constexpr size_t WS_YAYP = WS_SGB + 32 * MiB;
constexpr size_t WS_DP = WS_YAYP + 32 * MiB;
constexpr size_t WS_T1 = WS_DP + 16 * MiB;
constexpr size_t WS_MRG = WS_T1 + 64 * MiB;
constexpr size_t WS_X1F = WS_MRG + 32 * MiB;
constexpr size_t WS_X1B = WS_X1F + 64 * MiB;
constexpr size_t WS_XS = WS_X1B + 32 * MiB;
constexpr size_t WS_ACT = WS_XS + 144 * MiB;
constexpr size_t WS_YR = WS_ACT + 144 * MiB;
constexpr size_t WS_PLEP = WS_YR + 144 * MiB;
constexpr size_t WS_PLEV = WS_PLEP + 32 * MiB;
constexpr size_t WS_ROUTE = WS_PLEV + 32 * MiB;
constexpr size_t RT_TOPI = 0, RT_GATE = 256 * 1024, RT_LRANK = 512 * 1024, RT_TOKROW = 768 * 1024, RT_ROWG = 1024 * 1024, RT_HIST = 1536 * 1024, RT_TILE = 1664 * 1024, RT_ROWS = 1700 * 1024, RT_X1S = 1472 * 1024, RT_XQS = 1988 * 1024;
constexpr size_t WS_END = WS_ROUTE + 3 * MiB;
static_assert((size_t)RMAX * 1024 * 2 == 144 * MiB, "row buffers");
static_assert(RT_ROWG + (size_t)RMAX * 4 <= RT_X1S && RT_X1S + (size_t)M * 4 <= RT_HIST && RT_HIST + (size_t)DEPTH * 256 * 32 * 4 <= RT_TILE && RT_ROWS + (size_t)RMAX * 4 <= RT_XQS, "routing map");

constexpr int RING_BYTES = 131072;
constexpr int XTRA_OFF = RING_BYTES;
constexpr int XTRA_BYTES = 20480;
constexpr int MISC_OFF = XTRA_OFF + XTRA_BYTES;
constexpr int LDS_BYTES = MISC_OFF + 4096;
constexpr int NWAVES = 8;

#define XB_TMO      128
#define XB_XCNT(j)  (256  + 64 * (j))
#define XB_XSUB(j)  (1280 + 64 * (j))
#define XB_XGEN(j)  (2304 + 64 * (j))
#define XB_TOP      3328
#define XB_TOPGEN   3392
#define XCD_BAR_WORDS 3456
#define XB_SPIN_CAP (1u << 18)

__device__ __forceinline__ unsigned xb_ld(unsigned* p)              { return __hip_atomic_load(p, __ATOMIC_RELAXED, __HIP_MEMORY_SCOPE_AGENT); }
__device__ __forceinline__ unsigned xb_add(unsigned* p, unsigned v) { return __hip_atomic_fetch_add(p, v, __ATOMIC_RELAXED, __HIP_MEMORY_SCOPE_AGENT); }
__device__ __forceinline__ unsigned xb_xcc_id() { return (unsigned)__builtin_amdgcn_s_getreg((3 << 11) | 20) & 0xFu; }
#define XB_SPIN(cond, bar) do { unsigned _sp = 0; while (cond) { __builtin_amdgcn_s_sleep(1); \
    if ((++_sp & 255u) == 0u) { if (xb_ld(&(bar)[XB_TMO])) break; if (_sp > XB_SPIN_CAP) { atomicAdd(&(bar)[XB_TMO], 1u); break; } } } } while (0)

struct XcdBarrier {
    unsigned* bar; unsigned x;
    volatile LAS unsigned* st;
};

__device__ __forceinline__ XcdBarrier xcd_barrier_post(unsigned* bar, volatile LAS unsigned* st) {
    XcdBarrier b; b.bar = bar; b.x = xb_xcc_id(); b.st = st;
    if (threadIdx.x == 0) (void)xb_add(&bar[XB_XCNT(b.x)], 1u);
    return b;
}
__device__ __forceinline__ void xcd_barrier_complete(unsigned* bar, unsigned x, unsigned& nloc, unsigned& nx) {
    const unsigned G = gridDim.x * gridDim.y * gridDim.z;
    unsigned sum, cnt, mine, sp = 0u;
    for (;;) {
        sum = 0u; cnt = 0u; mine = 0u;
#pragma unroll
        for (unsigned j = 0; j < 16; ++j) { const unsigned c = xb_ld(&bar[XB_XCNT(j)]); sum += c; cnt += (c > 0u) ? 1u : 0u; mine = (j == x) ? c : mine; }
        if (sum == G) break;
        __builtin_amdgcn_s_sleep(1);
        if ((++sp & 255u) == 0u) { if (xb_ld(&bar[XB_TMO])) break; if (sp > XB_SPIN_CAP) { atomicAdd(&bar[XB_TMO], 1u); break; } }
    }
    nloc = mine > 0u ? mine : 1u; nx = cnt > 0u ? cnt : 1u;
}

__device__ __forceinline__ void xcd_barrier(const XcdBarrier& b) {
    asm volatile("s_waitcnt vmcnt(0)" ::: "memory");
    __syncthreads();
    if (threadIdx.x == 0) {
        unsigned* bar = b.bar; { size_t zo_ = 0; asm volatile("" : "+s"(zo_)); bar += zo_; }
        __builtin_amdgcn_s_waitcnt(0);
        unsigned bx = b.x; asm volatile("" : "+s"(bx));
        unsigned nloc = b.st[0], nx = b.st[1];
        if (nloc == 0u) { xcd_barrier_complete(bar, bx, nloc, nx); b.st[0] = nloc; b.st[1] = nx; }
        const unsigned old = xb_add(&bar[XB_XSUB(bx)], 1u);
        const unsigned gen = old / nloc;
        if (old + 1u == (gen + 1u) * nloc) {
            __builtin_amdgcn_fence(__ATOMIC_RELEASE, "agent");
            asm volatile("s_waitcnt vmcnt(0)" ::: "memory");
            const unsigned og = xb_add(&bar[XB_TOP], 1u);
            const unsigned tg = og / nx;
            if (og + 1u == (tg + 1u) * nx) xb_add(&bar[XB_TOPGEN], 1u);
            else XB_SPIN(xb_ld(&bar[XB_TOPGEN]) == tg, bar);
            __builtin_amdgcn_fence(__ATOMIC_ACQUIRE, "agent");
            xb_add(&bar[XB_XGEN(bx)], 1u);
            asm volatile("s_waitcnt vmcnt(0)" ::: "memory");
        } else {
            XB_SPIN(xb_ld(&bar[XB_XGEN(bx)]) == gen, bar);
            __builtin_amdgcn_fence(__ATOMIC_ACQUIRE, "agent");
            asm volatile("s_waitcnt vmcnt(0)" ::: "memory");
        }
    }
    __syncthreads();
}


template <int CTRL> __device__ __forceinline__ float dppx(float v) { return __builtin_bit_cast(float, __builtin_amdgcn_update_dpp(0, __builtin_bit_cast(int, v), CTRL, 0xf, 0xf, false)); }
__device__ __forceinline__ float wave_sum(float v, int) { v += dppx<0xB1>(v); v += dppx<0x4E>(v); v += dppx<0x141>(v); v += dppx<0x140>(v); v += shx<16>(v); return sum32(v); }
__device__ __forceinline__ float wave_max(float v, int) { v = fmaxf(v, dppx<0xB1>(v)); v = fmaxf(v, dppx<0x4E>(v)); v = fmaxf(v, dppx<0x141>(v)); v = fmaxf(v, dppx<0x140>(v)); v = fmaxf(v, shx<16>(v)); return max32(v); }
__device__ __forceinline__ float wave_min(float v, int) { v = fminf(v, dppx<0xB1>(v)); v = fminf(v, dppx<0x4E>(v)); v = fminf(v, dppx<0x141>(v)); v = fminf(v, dppx<0x140>(v)); v = fminf(v, shx<16>(v)); return min32(v); }
struct MapId { __device__ __forceinline__ int operator()(int n) const { return n; } };
struct MapWin { __device__ __forceinline__ int operator()(int n) const {
    if (n < 512) return n;
    if (n < 768) return n;
    if (n < 1352) return n;
    if (n < 1536) return -1;
    if (n < 2048) return 1352 + (n - 1536);
    if (n < 3072) return 1864 + (n - 2048);
    return 2888 + (n - 3072); } };
struct MapGU { __device__ __forceinline__ int operator()(int n) const { const int t = n >> 8, w = n & 255; return w < 128 ? t * 128 + w : 1024 + t * 128 + (w - 128); } };

__device__ __forceinline__ void ln_regs(f32x4 (&v)[4], const float* g, const float* b, int lane) {
    float s = 0.f;
#pragma unroll
    for (int j = 0; j < 4; ++j) s += (v[j].x + v[j].y) + (v[j].z + v[j].w);
    const float mean = wave_sum(s, lane) * (1.f / D); float s2 = 0.f;
#pragma unroll
    for (int j = 0; j < 4; ++j) { v[j] = v[j] - mean; s2 += (v[j].x * v[j].x + v[j].y * v[j].y) + (v[j].z * v[j].z + v[j].w * v[j].w); }
    const float rstd = 1.f / sqrtf(wave_sum(s2, lane) * (1.f / D) + LN_EPS);
#pragma unroll
    for (int j = 0; j < 4; ++j) { const f32x4 gg = *(const f32x4*)(g + 4 * lane + 256 * j), bb = *(const f32x4*)(b + 4 * lane + 256 * j); v[j] = v[j] * rstd * gg + bb; }
}
__device__ __forceinline__ void store_row_f32(float* row, const f32x4 (&v)[4], int lane) {
#pragma unroll
    for (int j = 0; j < 4; ++j) *(f32x4*)(row + 4 * lane + 256 * j) = v[j];
}
__device__ __forceinline__ void store_row_i8(unsigned char* row, float* scale_out, const f32x4 (&v)[4], int lane) {
    float mx = 0.f;
#pragma unroll
    for (int j = 0; j < 4; ++j) mx = fmaxf(fmaxf(mx, fmaxf(fabsf(v[j].x), fabsf(v[j].y))), fmaxf(fabsf(v[j].z), fabsf(v[j].w)));
    mx = fmaxf(wave_max(mx, lane), 1e-20f); const float inv = 127.0f / mx;
    if (lane == 0) *scale_out = mx * (1.0f / 127.0f);
#pragma unroll
    for (int j = 0; j < 4; ++j) *(unsigned*)(row + 4 * lane + 256 * j) = pack4_i8(v[j].x * inv, v[j].y * inv, v[j].z * inv, v[j].w * inv);
}
__device__ __forceinline__ void store_row_bf16(bf16* row, const f32x4 (&v)[4], int lane) {
#pragma unroll
    for (int j = 0; j < 4; ++j) { u32x2 w; w.x = pk2(v[j].x, v[j].y); w.y = pk2(v[j].z, v[j].w); *(u32x2*)(row + 4 * lane + 256 * j) = w; }
}

typedef __bf16 bf16x2_t __attribute__((ext_vector_type(2)));
typedef short v4i16_t __attribute__((ext_vector_type(4)));
typedef int v2i32_t __attribute__((ext_vector_type(2)));
typedef short s16x4_t __attribute__((ext_vector_type(4)));
__device__ __forceinline__ float dot2bf(unsigned a, unsigned b, float c) { return __builtin_amdgcn_fdot2_f32_bf16(__builtin_bit_cast(bf16x2_t, a), __builtin_bit_cast(bf16x2_t, b), c, false); }

__device__ __forceinline__ int score_bin(float v, float vmin, float scale) { const int b = (int)((v - vmin) * scale); return b > 511 ? 511 : b; }

__device__ __forceinline__ void attn_unit(LAS unsigned char* lds, const int wave, const int lane_in, const int b, const int t0,
                                          const bf16* QI, const bf16* KI, const float* WI, const bf16* Q, const bf16* KV, bf16* YAYP) {
    int lane = lane_in; asm volatile("" : "+v"(lane));
    const int m0 = b * SEQ + t0;
    LAS float* SC = (LAS float*)lds;
    const int r = lane & 31, h = lane >> 5;
    const int qit = 2 * ((r >> 2) & 1) + (r >> 4), hd = (r & 3) + 4 * ((r >> 3) & 1);
    bf16x8 Af[2][4];
#pragma unroll
    for (int mt = 0; mt < 2; ++mt)
#pragma unroll
        for (int ks = 0; ks < 4; ++ks) Af[mt][ks] = *(const bf16x8*)(QI + (size_t)(m0 + 4 * mt + qit) * 512 + hd * 64 + 16 * ks + 8 * h);
    f32x4 wv[2][2][2];
#pragma unroll
    for (int mt = 0; mt < 2; ++mt)
#pragma unroll
        for (int qq = 0; qq < 2; ++qq) { const float* wp = WI + (size_t)(m0 + 4 * mt + 2 * h + qq) * 8; wv[mt][qq][0] = *(const f32x4*)wp; wv[mt][qq][1] = *(const f32x4*)(wp + 4); }
    for (int rep2_ = 0; rep2_ < (ATT_PROBE == 1 ? 2 : 1); ++rep2_) {
    const int nkt = (t0 + 8 + 31) >> 5;
    const bf16* kib = KI + (size_t)b * SEQ * 64;
#pragma unroll 1
    for (int kt0 = wave; kt0 < nkt; kt0 += 32) {
        bf16x8 Bq[4][4];
#pragma unroll
        for (int u = 0; u < 4; ++u) {
            if (kt0 + 8 * u < nkt) {
#pragma unroll
                for (int ks = 0; ks < 4; ++ks) Bq[u][ks] = *(const bf16x8*)(kib + ((size_t)((kt0 + 8 * u) * 4 + ks) * 64 + lane) * 8);
            }
        }
#pragma unroll
        for (int u = 0; u < 4; ++u) {
            if (kt0 + 8 * u < nkt) {
                const int key = 32 * (kt0 + 8 * u) + r;
#pragma unroll
                for (int mt = 0; mt < 2; ++mt) {
                    f32x16 acc;
#pragma unroll
                    for (int i = 0; i < 16; ++i) acc[i] = 0.f;
#pragma unroll
                    for (int ks = 0; ks < 4; ++ks) acc = __builtin_amdgcn_mfma_f32_32x32x16_bf16(Af[mt][ks], Bq[u][ks], acc, 0, 0, 0);
                    float s0 = 0.f, s1 = 0.f;
#pragma unroll
                    for (int i = 0; i < 8; ++i) { s0 += fmaxf(acc[i], 0.f) * wv[mt][0][i >> 2][i & 3]; s1 += fmaxf(acc[8 + i], 0.f) * wv[mt][1][i >> 2][i & 3]; }
                    const int qa = 4 * mt + 2 * h;
                    SC[qa * 4096 + key] = s0; SC[(qa + 1) * 4096 + key] = s1;
                }
            }
        }
    }
    }
    __syncthreads();
    asm volatile("" : "+v"(lane));
    LAS float* SCw = SC + wave * 4096;
    LAS unsigned* HIST = (LAS unsigned*)(lds + XTRA_OFF + wave * 2048);
    LAS unsigned short* SEL = (LAS unsigned short*)(lds + XTRA_OFF + 16384 + wave * 512);
    const int n = t0 + wave + 1;
    const int cnt = n < NSEL ? n : NSEL;
    const unsigned long long ltmask = (1ull << lane) - 1ull;
    for (int rep3_ = 0; rep3_ < (ATT_PROBE == 2 ? 2 : 1); ++rep3_) {
    if (n <= NSEL) {
        for (int i = lane; i < NSEL; i += 64) SEL[i] = (unsigned short)(i < n ? i : 0);
    } else {
        const int nj = (n + 63) >> 6;
        float sv[64]; float vmax = -INFINITY, vmin = INFINITY;
#pragma unroll
        for (int gq = 0; gq < 8; ++gq) {
            if (512 * (gq + 1) <= n) {
#pragma unroll
                for (int jj = 0; jj < 8; ++jj) { const int j = 8 * gq + jj; const float v = SCw[64 * j + lane]; sv[j] = v; vmax = fmaxf(vmax, v); vmin = fminf(vmin, v); }
            } else if (512 * gq < n) {
#pragma unroll
                for (int jj = 0; jj < 8; ++jj) { const int j = 8 * gq + jj; const float v = SCw[64 * j + lane]; const bool in = 64 * j + lane < n;
                    sv[j] = in ? v : -INFINITY; vmax = fmaxf(vmax, sv[j]); vmin = fminf(vmin, in ? v : INFINITY); }
            } else {
#pragma unroll
                for (int jj = 0; jj < 8; ++jj) sv[8 * gq + jj] = -INFINITY;
            }
        }
        vmax = wave_max(vmax, lane); vmin = wave_min(vmin, lane);
        const float range = vmax - vmin, scale = range > 0.f ? 512.0f / range : 0.f;
#pragma unroll
        for (int i = 0; i < 8; ++i) HIST[lane * 8 + i] = 0u;
        WAVE_FENCE();
        int ba[64];
#pragma unroll
        for (int gq = 0; gq < 8; ++gq) {
            if (512 * (gq + 1) <= n) {
#pragma unroll
                for (int jj = 0; jj < 8; ++jj) { const int j = 8 * gq + jj; const int bq = score_bin(sv[j], vmin, scale); ba[j] = bq * 4;
                    __hip_atomic_fetch_add(HIST + bq, 1u, __ATOMIC_RELAXED, __HIP_MEMORY_SCOPE_WORKGROUP); }
            } else if (512 * gq < n) {
#pragma unroll
                for (int jj = 0; jj < 8; ++jj) { const int j = 8 * gq + jj; const bool in = 64 * j + lane < n; const int bq = in ? score_bin(sv[j], vmin, scale) : 0; ba[j] = in ? bq * 4 : -4;
                    if (in) __hip_atomic_fetch_add(HIST + bq, 1u, __ATOMIC_RELAXED, __HIP_MEMORY_SCOPE_WORKGROUP); }
            } else {
#pragma unroll
                for (int jj = 0; jj < 8; ++jj) ba[8 * gq + jj] = -4;
            }
        }
        WAVE_FENCE();
        unsigned wds[8]; unsigned sl = 0u;
#pragma unroll
        for (int i = 0; i < 8; ++i) { wds[i] = HIST[lane * 8 + i]; sl += wds[i]; }
        unsigned T = sl;
#pragma unroll
        for (int off = 1; off < 64; off <<= 1) { const unsigned o = (unsigned)__builtin_amdgcn_ds_bpermute((lane + off) << 2, (int)T); if (lane + off < 64) T += o; }
        const unsigned E = T - sl;
        int tb = 0; unsigned cab = 0u, ctb = 0u;
        { unsigned run = E; bool found = false;
#pragma unroll
          for (int bb = 7; bb >= 0; --bb) { const unsigned c = wds[bb];
              if (!found) { if (run + c >= (unsigned)NSEL) { found = true; tb = lane * 8 + bb; cab = run; ctb = c; } else run += c; } } }
        const unsigned long long bal = __ballot(E < (unsigned)NSEL && T >= (unsigned)NSEL);
        const int L = __ffsll((long long)bal) - 1;
        tb = __builtin_amdgcn_readlane(tb, L); cab = (unsigned)__builtin_amdgcn_readlane((int)cab, L); ctb = (unsigned)__builtin_amdgcn_readlane((int)ctb, L);
        const int need = NSEL - (int)cab;
        const int tb4 = tb * 4;
        WAVE_FENCE();
        LAS float* CVAL = (LAS float*)HIST; LAS int* CKEY = (LAS int*)(HIST + 256);
        unsigned pc = 0u;
#pragma unroll
        for (int j = 0; j < 64; ++j) pc += (ba[j] > tb4 ? 1u : 0u) + (ba[j] == tb4 ? 65536u : 0u);
        unsigned pi = pc;
#pragma unroll
        for (int off = 1; off < 64; off <<= 1) { const unsigned o = (unsigned)__builtin_amdgcn_ds_bpermute((lane - off) << 2, (int)pi); if (lane >= off) pi += o; }
        pi -= pc;
        const bool docand = ctb <= 256u;
        int tb4c = tb4; asm volatile("" : "+s"(tb4c));
        LAS unsigned char* dummy = lds + MISC_OFF + 1024 + wave * 256 + lane * 4;
        unsigned os = (pi & 0xffffu) * 2u, oc = (pi >> 16) * 4u;
        LAS unsigned char* selb = (LAS unsigned char*)SEL; LAS unsigned char* ckb = (LAS unsigned char*)CKEY;
#pragma unroll
        for (int gq = 0; gq < 8; ++gq) {
            if (512 * gq < n) {
#pragma unroll
                for (int jj = 0; jj < 8; ++jj) { const int j = 8 * gq + jj; const int key = 64 * j + lane;
                    const bool isel = ba[j] > tb4c;
                    *(LAS unsigned short*)(isel ? selb + os : dummy) = (unsigned short)key; os += isel ? 2u : 0u;
                    if (docand) { const bool ic = ba[j] == tb4c;
                        *(LAS int*)(ic ? ckb + oc : dummy) = key; oc += ic ? 4u : 0u; } }
            }
        }
        int nsel = (int)cab; const int ncand = (int)ctb;
        WAVE_FENCE();
        if (docand) for (int i = lane; i < ncand; i += 64) CVAL[i] = SCw[CKEY[i]];
        (void)nj;
        WAVE_FENCE();
        if (ncand <= 256) {
            for (int c0 = 0; c0 < ncand; c0 += 64) {
                const int i = c0 + lane; const bool act = i < ncand; const float vi = act ? CVAL[i] : 0.f; const int ki = act ? CKEY[i] : 0;
                int rank = 0;
                for (int jj = 0; jj < ncand; ++jj) { const float vj = CVAL[jj]; const int kj = CKEY[jj]; rank += (vj > vi || (vj == vi && kj < ki)) ? 1 : 0; }
                const bool take = act && rank < need; const unsigned long long ms = __ballot(take);
                if (take) SEL[nsel + __popcll(ms & ltmask)] = (unsigned short)ki;
                nsel += __popcll(ms);
            }
        } else {
            for (int j = 0; j < nj; ++j) {
                const int key = 64 * j + lane; const bool in = key < n; const float v = in ? SCw[key] : 0.f; const bool ic = in && score_bin(v, vmin, scale) == tb;
                if (__ballot(ic) == 0ull) continue;
                int rank = 0;
                for (int jj = 0; jj < n; ++jj) { const float vj = SCw[jj]; rank += (score_bin(vj, vmin, scale) == tb && (vj > v || (vj == v && jj < key))) ? 1 : 0; }
                const bool take = ic && rank < need; const unsigned long long ms = __ballot(take);
                if (take) SEL[nsel + __popcll(ms & ltmask)] = (unsigned short)key;
                nsel += __popcll(ms);
            }
        }
    }
    WAVE_FENCE();
    }
    asm volatile("" : "+v"(lane));
    for (int rep4_ = 0; rep4_ < (ATT_PROBE == 3 ? 2 : 1); ++rep4_) {
    const int m = m0 + wave;
    LAS unsigned char* RING = (LAS unsigned char*)SCw;
    const char* kvb = (const char*)KV + (size_t)b * SEQ * 256;
    const int li = lane & 15, kq = lane >> 4;
    long qb[2][2];
#pragma unroll
    for (int c = 0; c < 2; ++c)
#pragma unroll
        for (int ks = 0; ks < 2; ++ks) { qb[c][ks] = 0;
            if (li < 4) { const u32x4 w = *(const u32x4*)(Q + (size_t)m * 512 + (4 * c + li) * 64 + 32 * ks + 8 * kq);
                const unsigned lo = pack4_fp8(bflo(w.x), bfhi(w.x), bflo(w.y), bfhi(w.y)), hi = pack4_fp8(bflo(w.z), bfhi(w.z), bflo(w.w), bfhi(w.w));
                qb[c][ks] = (long)(((unsigned long long)hi << 32) | lo); } }
    int koff[2][2];
#pragma unroll
    for (int c = 0; c < 2; ++c)
#pragma unroll
        for (int ks = 0; ks < 2; ++ks) koff[c][ks] = li * 128 + (((4 * c + 2 * ks + (kq >> 1)) ^ ((li >> 1) & 7)) << 4) + 8 * (kq & 1);
    const int tq = li >> 1, tp = li & 1, rowv = 16 * (tq >> 2) + 4 * kq + (tq & 3);
    int voff[2][4];
#pragma unroll
    for (int c = 0; c < 2; ++c)
#pragma unroll
        for (int dt = 0; dt < 4; ++dt) voff[c][dt] = rowv * 128 + (((4 * c + dt) ^ ((rowv >> 1) & 7)) << 4) + 8 * tp;
    const int r8 = lane >> 3, c16 = lane & 7;
    unsigned dsw[4];
#pragma unroll
    for (int j = 0; j < 4; ++j) dsw[j] = (unsigned)((c16 ^ ((4 * j + (r8 >> 1)) & 7)) << 4);
#define ATT_KEYS(s_) (*(const LAS u32x2*)(SEL + 32 * ((s_) & 7) + 4 * r8))
#define ATT_ISSUE(s_, kk_) do { const unsigned part_ = (((s_) & 15) >> 3) * 128u; \
        _Pragma("unroll") for (int j_ = 0; j_ < 4; ++j_) { const unsigned key_ = (((j_ & 2) ? (kk_).y : (kk_).x) >> ((j_ & 1) * 16)) & 0xffffu; \
            __builtin_amdgcn_global_load_lds((const unsigned*)(kvb + (size_t)key_ * 256 + part_ + dsw[j_]), (LAS unsigned*)(RING + ((s_) & 3) * 4096 + j_ * 1024), 16, 0, 0); } } while (0)
    { const u32x2 k0 = ATT_KEYS(0), k1 = ATT_KEYS(1), k2 = ATT_KEYS(2); ATT_ISSUE(0, k0); ATT_ISSUE(1, k1); ATT_ISSUE(2, k2); }
    u32x2 kk = ATT_KEYS(3);
    f32x4 lgs[8][2][2];
#pragma unroll
    for (int s = 0; s < 8; ++s) {
        ATT_ISSUE(s + 3, kk);
        kk = ATT_KEYS(s + 4);
        asm volatile("s_waitcnt vmcnt(12)" ::: "memory");
        const LAS unsigned char* slot = RING + (s & 3) * 4096;
#pragma unroll
        for (int T = 0; T < 2; ++T)
#pragma unroll
            for (int c = 0; c < 2; ++c) {
                f32x4 acc = (f32x4){0.f, 0.f, 0.f, 0.f};
#pragma unroll
                for (int ks = 0; ks < 2; ++ks) acc = __builtin_amdgcn_mfma_f32_16x16x32_fp8_fp8(*(const LAS long*)(slot + T * 2048 + koff[c][ks]), qb[c][ks], acc, 0, 0, 0);
#pragma unroll
                for (int i = 0; i < 4; ++i) acc[i] = (32 * s + 16 * (kq & 1) + 4 * i + 2 * T + (kq >> 1) < cnt) ? acc[i] : -INFINITY;
                lgs[s][T][c] = acc;
            }
        asm volatile("s_waitcnt lgkmcnt(0)" ::: "memory");
    }
    float inv[2];
#pragma unroll
    for (int c = 0; c < 2; ++c) {
        float mx = -INFINITY;
#pragma unroll
        for (int s = 0; s < 8; ++s)
#pragma unroll
            for (int T = 0; T < 2; ++T) mx = fmaxf(fmaxf(mx, fmaxf(lgs[s][T][c][0], lgs[s][T][c][1])), fmaxf(lgs[s][T][c][2], lgs[s][T][c][3]));
        mx = fmaxf(mx, shx<16>(mx)); mx = max32(mx);
        const float mxs = mx * 0.18033688011112042f;
        float sm = 0.f;
#pragma unroll
        for (int s = 0; s < 8; ++s)
#pragma unroll
            for (int T = 0; T < 2; ++T)
#pragma unroll
                for (int i = 0; i < 4; ++i) { const float p = __builtin_amdgcn_exp2f(lgs[s][T][c][i] * 0.18033688011112042f - mxs); lgs[s][T][c][i] = p; sm += p; }
        sm += shx<16>(sm); sm = sum32(sm);
        inv[c] = 1.0f / sm;
    }
    f32x4 o[2][4];
#pragma unroll
    for (int c = 0; c < 2; ++c)
#pragma unroll
        for (int dt = 0; dt < 4; ++dt) o[c][dt] = (f32x4){0.f, 0.f, 0.f, 0.f};
#pragma unroll
    for (int s = 8; s < 16; ++s) {
        ATT_ISSUE(s + 3, kk);
        kk = ATT_KEYS(s + 4);
        asm volatile("s_waitcnt vmcnt(12)" ::: "memory");
        const LAS unsigned char* slot = RING + (s & 3) * 4096;
#pragma unroll
        for (int c = 0; c < 2; ++c) {
            const f32x4 t0 = lgs[s - 8][0][c], t1 = lgs[s - 8][1][c];
            const long pf = (long)(((unsigned long long)pack4_fp8(t1[0], t1[1], t1[2], t1[3]) << 32) | pack4_fp8(t0[0], t0[1], t0[2], t0[3]));
#pragma unroll
            for (int dt = 0; dt < 4; ++dt) {
                const v2i32_t va = __builtin_amdgcn_ds_read_tr8_b64_v2i32((LAS v2i32_t*)(slot + voff[c][dt]));
                const long vf = (long)(((unsigned long long)(unsigned)va.y << 32) | (unsigned)va.x);
                o[c][dt] = __builtin_amdgcn_mfma_f32_16x16x32_fp8_fp8(vf, pf, o[c][dt], 0, 0, 0);
            }
        }
        asm volatile("s_waitcnt lgkmcnt(0)" ::: "memory");
    }
#undef ATT_ISSUE
#undef ATT_KEYS
    if (li < 4) {
#pragma unroll
        for (int c = 0; c < 2; ++c)
#pragma unroll
            for (int dt = 0; dt < 4; ++dt) { const f32x4 v = o[c][dt] * inv[c]; u32x2 w; w.x = pk2(v[0], v[1]); w.y = pk2(v[2], v[3]);
                *(u32x2*)(YAYP + (size_t)m * 1024 + (4 * c + li) * 64 + 16 * dt + 4 * kq) = w; }
    }
    asm volatile("s_waitcnt vmcnt(0)" ::: "memory");
    }
}

template <int WIN> __device__ __forceinline__ void pool_item(const bf16* U, bf16* DP, const int mrow, const int ck) {
    const int t = mrow & (SEQ - 1), cw = WIN < t + 1 ? WIN : t + 1;
    u32x4 x[WIN];
#pragma unroll
    for (int i = 0; i < WIN; ++i) x[i] = *(const u32x4*)(U + (size_t)(mrow - (i < cw ? i : 0)) * 512 + 8 * ck);
    float s[8];
#pragma unroll
    for (int e = 0; e < 8; ++e) s[e] = 0.f;
#pragma unroll
    for (int i = 0; i < WIN; ++i) { const float w = i < cw ? 1.f : 0.f;
        s[0] += w * bflo(x[i].x); s[1] += w * bfhi(x[i].x); s[2] += w * bflo(x[i].y); s[3] += w * bfhi(x[i].y); s[4] += w * bflo(x[i].z); s[5] += w * bfhi(x[i].z); s[6] += w * bflo(x[i].w); s[7] += w * bfhi(x[i].w); }
    const float inv = 1.0f / (float)cw;
    u32x4 o; o.x = pk2(s[0] * inv - bflo(x[0].x), s[1] * inv - bfhi(x[0].x)); o.y = pk2(s[2] * inv - bflo(x[0].y), s[3] * inv - bfhi(x[0].y));
    o.z = pk2(s[4] * inv - bflo(x[0].z), s[5] * inv - bfhi(x[0].z)); o.w = pk2(s[6] * inv - bflo(x[0].w), s[7] * inv - bfhi(x[0].w));
    *(u32x4*)(DP + (size_t)mrow * 1024 + 8 * ck) = o;
}
__device__ __forceinline__ void pool_window(const bf16* U, bf16* DP, int gtid, int nthreads) {
    for (int it = gtid; it < M * 64; it += nthreads) {
        const int mrow = it >> 6, ck = it & 63, g = ck >> 4;
        if (g == 0) pool_item<2>(U, DP, mrow, ck); else if (g == 1) pool_item<4>(U, DP, mrow, ck); else if (g == 2) pool_item<8>(U, DP, mrow, ck); else pool_item<16>(U, DP, mrow, ck);
    }
}

__device__ __forceinline__ void butterfly32(const float (&lg)[32], const int lane, float& out) {
    float r16[16], r8[8], r4[4], r2[2], r1;
    { const bool hi = (lane & 32) != 0;
#pragma unroll
      for (int q = 0; q < 16; ++q) { const float mine = hi ? lg[16 + q] : lg[q], oth = hi ? lg[q] : lg[16 + q]; r16[q] = mine + partner32(oth, hi); } }
    { const bool hi = (lane & 16) != 0;
#pragma unroll
      for (int q = 0; q < 8; ++q) { const float mine = hi ? r16[8 + q] : r16[q], oth = hi ? r16[q] : r16[8 + q]; r8[q] = mine + shx<16>(oth); } }
    { const bool hi = (lane & 8) != 0;
#pragma unroll
      for (int q = 0; q < 4; ++q) { const float mine = hi ? r8[4 + q] : r8[q], oth = hi ? r8[q] : r8[4 + q]; r4[q] = mine + shx<8>(oth); } }
    { const bool hi = (lane & 4) != 0;
#pragma unroll
      for (int q = 0; q < 2; ++q) { const float mine = hi ? r4[2 + q] : r4[q], oth = hi ? r4[q] : r4[2 + q]; r2[q] = mine + shx<4>(oth); } }
    { const bool hi = (lane & 2) != 0; const float mine = hi ? r2[1] : r2[0], oth = hi ? r2[0] : r2[1]; r1 = mine + shx<2>(oth); }
    out = r1 + shx<1>(r1);
}
__device__ __forceinline__ void ln1_router_phase(LAS unsigned char* lds, const int tid, const int wave, const int lane_in, const int blk,
                                                 const float* V, const float* g1, const float* b1, const float* Wr, const float* br,
                                                 float* X1F, unsigned char* X1Q, float* X1S, int* TOPI, float* GATE, int* LRANK, int* HISTL) {
    LAS float* WL = (LAS float*)lds;
#pragma unroll 2
    for (int i = tid; i < 8192; i += NWAVES * 64) {
        const f32x4 w = *(const f32x4*)(Wr + 4 * i); const int k = i >> 3, e4 = (i & 7) * 4;
        WL[(e4 + 0) * 1024 + k] = w.x; WL[(e4 + 1) * 1024 + k] = w.y; WL[(e4 + 2) * 1024 + k] = w.z; WL[(e4 + 3) * 1024 + k] = w.w;
    }
    LAS int* EL = (LAS int*)(lds + XTRA_OFF);
    LAS float* LG = (LAS float*)(lds + XTRA_OFF + 2048 + wave * 512);
    LAS float* TV = LG + 64; LAS int* TE = (LAS int*)(LG + 72);
    __syncthreads();
    const int lane = lane_in, row0 = blk * 64 + wave * 8;
    f32x4 va[4], vb[4];
#pragma unroll
    for (int j = 0; j < 4; ++j) { va[j] = *(const f32x4*)(V + (size_t)row0 * D + 4 * lane + 256 * j); vb[j] = *(const f32x4*)(V + (size_t)(row0 + 1) * D + 4 * lane + 256 * j); }
#pragma unroll 1
    for (int pr = 0; pr < 4; ++pr) {
        const int rowA = row0 + 2 * pr;
        ln_regs(va, g1, b1, lane); ln_regs(vb, g1, b1, lane);
        store_row_f32(X1F + (size_t)rowA * D, va, lane); store_row_f32(X1F + (size_t)(rowA + 1) * D, vb, lane);
        store_row_i8(X1Q + (size_t)rowA * D, X1S + rowA, va, lane); store_row_i8(X1Q + (size_t)(rowA + 1) * D, X1S + rowA + 1, vb, lane);
        f32x2 l2[32];
#pragma unroll
        for (int e = 0; e < 32; ++e) l2[e] = (f32x2){0.f, 0.f};
#pragma unroll
        for (int j = 0; j < 4; ++j) {
            const f32x2 p0 = (f32x2){va[j].x, vb[j].x}, p1 = (f32x2){va[j].y, vb[j].y}, p2 = (f32x2){va[j].z, vb[j].z}, p3 = (f32x2){va[j].w, vb[j].w};
#pragma unroll
            for (int e = 0; e < 32; ++e) { const f32x4 w4 = *(const LAS f32x4*)(WL + e * 1024 + 4 * lane + 256 * j);
                l2[e] = __builtin_elementwise_fma(p0, (f32x2){w4.x, w4.x}, l2[e]); l2[e] = __builtin_elementwise_fma(p1, (f32x2){w4.y, w4.y}, l2[e]);
                l2[e] = __builtin_elementwise_fma(p2, (f32x2){w4.z, w4.z}, l2[e]); l2[e] = __builtin_elementwise_fma(p3, (f32x2){w4.w, w4.w}, l2[e]); }
        }
        float la[32], lb[32];
#pragma unroll
        for (int e = 0; e < 32; ++e) { la[e] = l2[e].x; lb[e] = l2[e].y; }
        { const int rowN = row0 + 2 * (pr < 3 ? pr + 1 : pr);
#pragma unroll
          for (int j = 0; j < 4; ++j) { va[j] = *(const f32x4*)(V + (size_t)rowN * D + 4 * lane + 256 * j); vb[j] = *(const f32x4*)(V + (size_t)(rowN + 1) * D + 4 * lane + 256 * j); }
          asm volatile("" ::: "memory"); }
        float vala, valb; butterfly32(la, lane, vala); butterfly32(lb, lane, valb);
        int em = lane >> 1; asm volatile("" : "+v"(em));
        const int myrow = lane & 1; const float bias = br[em];
        vala += bias; valb += bias;
        if (myrow == 0) LG[em] = vala; else LG[32 + em] = valb;
        WAVE_FENCE();
        const float mine = myrow ? valb : vala; int rank = 0;
#pragma unroll
        for (int q = 0; q < 8; ++q) { const f32x4 o4 = *(const LAS f32x4*)(LG + 32 * myrow + 4 * q);
#pragma unroll
            for (int u = 0; u < 4; ++u) rank += (o4[u] > mine || (o4[u] == mine && 4 * q + u < em)) ? 1 : 0; }
        if (rank < 4) { TV[4 * myrow + rank] = mine; TE[4 * myrow + rank] = em; }
        WAVE_FENCE();
        if (lane < 2) {
            const f32x4 tv = *(const LAS f32x4*)(TV + 4 * lane); const int t0 = TE[4 * lane], t1 = TE[4 * lane + 1], t2 = TE[4 * lane + 2], t3 = TE[4 * lane + 3];
            const float e1 = __expf(tv[1] - tv[0]), e2 = __expf(tv[2] - tv[0]), e3 = __expf(tv[3] - tv[0]); const float inv = 1.0f / (1.0f + e1 + e2 + e3);
            const int row = rowA + lane, gi = row * 4, rl = row - blk * 64;
            *(int4*)(TOPI + gi) = make_int4(t0, t1, t2, t3);
            *(f32x4*)(GATE + gi) = (f32x4){inv, e1 * inv, e2 * inv, e3 * inv};
            EL[rl * 4] = t0; EL[rl * 4 + 1] = t1; EL[rl * 4 + 2] = t2; EL[rl * 4 + 3] = t3;
        }
        WAVE_FENCE();
    }
    __syncthreads();
    LAS int* CNT = (LAS int*)(lds + XTRA_OFF + 1024);
    if (wave < 4) {
        const int e = EL[tid]; int rk = 0;
#pragma unroll 4
        for (int q = 0; q < 32; ++q) { const unsigned long long mq = __ballot(e == q); if (e == q) rk = __popcll(mq & ((1ull << lane_in) - 1ull)); if (lane_in == q) CNT[wave * 32 + q] = __popcll(mq); }
        __syncthreads();
        for (int w2 = 0; w2 < wave; ++w2) rk += CNT[w2 * 32 + e];
        LRANK[blk * 256 + tid] = rk;
        if (tid < 32) HISTL[blk * 32 + tid] = CNT[tid] + CNT[32 + tid] + CNT[64 + tid] + CNT[96 + tid];
    } else {
        __syncthreads();
    }
    __syncthreads();
}

__device__ __forceinline__ void scatter_phase(LAS unsigned char* lds, const int tid, const int wave, const int lane, const int blk,
                                              const int* HISTL, const int* TOPI, const float* GATE, const int* LRANK, const unsigned char* X1Q, const float* X1S,
                                              unsigned char* XS8, float* ROWG, float* ROWS, int* TOKROW, int* TILE) {
    LAS int* TOT = (LAS int*)lds; LAS int* BEF = TOT + 32; LAS int* OFFS = TOT + 64; LAS int* PT = TOT + 128; LAS int* PBF = TOT + 640;
    { const int e = tid & 31, part = tid >> 5; int hv[16];
#pragma unroll
      for (int q = 0; q < 16; ++q) hv[q] = HISTL[(part * 16 + q) * 32 + e];
      int tot = 0, bef = 0;
#pragma unroll
      for (int q = 0; q < 16; ++q) { tot += hv[q]; bef += (part * 16 + q < blk) ? hv[q] : 0; }
      PT[part * 32 + e] = tot; PBF[part * 32 + e] = bef; }
    __syncthreads();
    if (tid < 32) { int tot = 0, bef = 0;
#pragma unroll
        for (int q = 0; q < 16; ++q) { tot += PT[q * 32 + tid]; bef += PBF[q * 32 + tid]; }
        TOT[tid] = tot; BEF[tid] = bef; }
    __syncthreads();
    if (tid == 0) {
        int off = 0;
#pragma unroll 1
        for (int e = 0; e < 32; ++e) { OFFS[e] = off + BEF[e]; const int nt = (TOT[e] + 255) >> 8;
            if (blk == 0) {
#pragma unroll 1
                for (int k = 0; k < nt; ++k) TILE[1 + (off >> 8) + k] = e; }
            off += nt << 8; }
        if (blk == 0) TILE[0] = off >> 8;
    }
    __syncthreads();
#pragma unroll 1
    for (int i0 = 0; i0 < 32; i0 += 8) {
        int rowv[8]; u32x4 d[8]; float gv[8], sv[8];
#pragma unroll
        for (int u = 0; u < 8; ++u) { const int gi = blk * 256 + wave * 32 + i0 + u; const int e = TOPI[gi]; rowv[u] = OFFS[e] + LRANK[gi]; gv[u] = GATE[gi]; sv[u] = X1S[gi >> 2];
            d[u] = *(const u32x4*)(X1Q + (size_t)(gi >> 2) * D + 16 * lane); }
#pragma unroll
        for (int u = 0; u < 8; ++u) { const int gi = blk * 256 + wave * 32 + i0 + u;
            if (lane == 0) { TOKROW[gi] = rowv[u]; ROWG[rowv[u]] = gv[u]; ROWS[rowv[u]] = sv[u]; }
            *(u32x4*)(XS8 + (size_t)rowv[u] * D + 16 * lane) = d[u]; }
    }
    __syncthreads();
}

__device__ __forceinline__ void add_bf16_row(f32x4 (&v)[4], const bf16* row, int lane) {
#pragma unroll
    for (int j = 0; j < 4; ++j) { const u32x2 w = *(const u32x2*)(row + 4 * lane + 256 * j); v[j].x += bflo(w.x); v[j].y += bfhi(w.x); v[j].z += bflo(w.y); v[j].w += bfhi(w.y); }
}
__device__ __forceinline__ void combine_ln2_phase(const int gw, const int ngw, const int lane, const float* X1F, const bf16* PLEV, const bf16* YR, const int* TOKROW,
                                                  const float* g2, const float* b2, float* XF, unsigned char* XQ, float* XQS, float* OUT) {
#pragma unroll 1
    for (int row = gw; row < M; row += 2 * ngw) {
        const int rowb = row + ngw;
        const int4 ra = *(const int4*)(TOKROW + row * 4), rb = *(const int4*)(TOKROW + rowb * 4);
        f32x4 va[4], vb[4];
#pragma unroll
        for (int j = 0; j < 4; ++j) { va[j] = *(const f32x4*)(X1F + (size_t)row * D + 4 * lane + 256 * j) * DN_ALPHA; vb[j] = *(const f32x4*)(X1F + (size_t)rowb * D + 4 * lane + 256 * j) * DN_ALPHA; }
        add_bf16_row(va, PLEV + (size_t)row * D, lane); add_bf16_row(vb, PLEV + (size_t)rowb * D, lane);
        add_bf16_row(va, YR + (size_t)ra.x * D, lane); add_bf16_row(vb, YR + (size_t)rb.x * D, lane);
        add_bf16_row(va, YR + (size_t)ra.y * D, lane); add_bf16_row(vb, YR + (size_t)rb.y * D, lane);
        add_bf16_row(va, YR + (size_t)ra.z * D, lane); add_bf16_row(vb, YR + (size_t)rb.z * D, lane);
        add_bf16_row(va, YR + (size_t)ra.w * D, lane); add_bf16_row(vb, YR + (size_t)rb.w * D, lane);
        ln_regs(va, g2, b2, lane); ln_regs(vb, g2, b2, lane);
        if (OUT) { store_row_f32(OUT + (size_t)row * D, va, lane); store_row_f32(OUT + (size_t)rowb * D, vb, lane); }
        else { store_row_f32(XF + (size_t)row * D, va, lane); store_row_i8(XQ + (size_t)row * D, XQS + row, va, lane); store_row_f32(XF + (size_t)rowb * D, vb, lane); store_row_i8(XQ + (size_t)rowb * D, XQS + rowb, vb, lane); }
    }
}

#ifndef MK_N_LAUNCHES
#define MK_N_LAUNCHES 1
#endif
constexpr int PH_PER_LAYER = 10, N_PHASES = 1 + DEPTH * PH_PER_LAYER;
constexpr double ROPE_TURNS[8] = {0.15915494309189535, 0.03086376340470123, 0.005985185712713705, 0.001160663641240061, 0.00022507907903927653, 4.364795279280289e-05, 8.464330808241401e-06, 1.6414262627950345e-06};

#define ARGP(i) ((const float*)(const GAS float*)kargs_[i])
constexpr int B_WIN = 8 * 16, B_UP = 4 * 4, B_OUT = 8 * 4, B_PLEP = 2 * 4, B_GU1 = 8 * 8, B_DN1 = 8 * 4;
constexpr int B_LAYER = B_WIN + B_UP + 2 * B_OUT + B_PLEP + NE * B_GU1 + NE * B_DN1;
struct P0D { const float* src; int nsrc; unsigned char* dst; int ldtb; int i8; float ws; int valid; };
__device__ __forceinline__ void p0_decode(P0D& d, const int it_in, const int wave, unsigned char* ws, const __attribute__((address_space(4))) unsigned long long* kargs_, const int lane) {
    int it = __builtin_amdgcn_readfirstlane(it_in); asm volatile("" : "+s"(it));
    const int ll = it / B_LAYER; int r = it - ll * B_LAYER; unsigned char* lw2 = ws + WS_W + (size_t)ll * LW_SIZE;
    const float* W; int nsrc, nblk, ldt, kind = 0; unsigned char* wt; d.i8 = 0; d.ws = 1.0f;
    if (r < B_WIN) { W = ARGP(4) + (size_t)ll * D * D_IN; nsrc = D_IN; wt = lw2 + LW_WIN; ldt = D; nblk = 16; kind = 1; d.i8 = 1; d.ws = I8_WS_GU; }
    else if ((r -= B_WIN) < B_UP) { W = ARGP(7) + (size_t)ll * 512 * D; nsrc = D; wt = lw2 + LW_WUPA; ldt = 1024; nblk = 4; }
    else if ((r -= B_UP) < B_OUT) { W = ARGP(9) + (size_t)ll * D * D; nsrc = D; wt = lw2 + LW_WOUT; ldt = D; nblk = 4; }
    else if ((r -= B_OUT) < B_OUT) { W = ARGP(18) + (size_t)ll * D * D; nsrc = D; wt = lw2 + LW_PLEG; ldt = D; nblk = 4; d.i8 = 1; d.ws = I8_WS_GU; }
    else if ((r -= B_OUT) < B_PLEP) { W = ARGP(19) + (size_t)ll * PLE * D; nsrc = D; wt = lw2 + LW_PLEP; ldt = PLE; nblk = 4; }
    else if ((r -= B_PLEP) < NE * B_GU1) { const int e = r / B_GU1; r -= e * B_GU1; W = ARGP(14) + ((size_t)ll * NE + e) * D * 2048; nsrc = 2048; wt = lw2 + LW_WGU + (size_t)e * 2048 * D; ldt = D; nblk = 8; kind = 2; d.i8 = 1; d.ws = I8_WS_GU; }
    else { r -= NE * B_GU1; const int e = r / B_DN1; r -= e * B_DN1; W = ARGP(16) + ((size_t)ll * NE + e) * DFF * D; nsrc = D; wt = lw2 + LW_WDN + (size_t)e * D * DFF; ldt = DFF; nblk = 4; d.i8 = 1; d.ws = I8_WS_DN; }
    const int kb = r / nblk, nb = r - kb * nblk, k0 = 128 * kb + 16 * wave, np = 256 * nb + 4 * lane;
    const int sc = kind == 1 ? MapWin()(np) : (kind == 2 ? MapGU()(np) : np);
    d.valid = sc >= 0; d.nsrc = nsrc; d.src = W + (size_t)k0 * nsrc + (sc < 0 ? 0 : sc);
    const int esz = d.i8 ? 1 : 2; d.ldtb = ldt * esz; d.dst = wt + (size_t)(256 * nb) * d.ldtb + (size_t)(128 * kb) * esz;
}
struct Args { const float* in[22]; float* out; unsigned char* ws; int ph_lo, ph_hi; };

template <unsigned PMASK>
__global__ void __launch_bounds__(NWAVES * 64, 2) mega_fwd(Args args) {
    extern __shared__ __attribute__((aligned(16))) unsigned char lds_raw[];
    LAS unsigned char* lds = (LAS unsigned char*)lds_raw;
    volatile LAS unsigned* MISC = (volatile LAS unsigned*)(lds + MISC_OFF);
    const int G = gridDim.x, blk = blockIdx.x;
    const int wave_s_ = __builtin_amdgcn_readfirstlane(threadIdx.x >> 6);
    for (int u = threadIdx.x; u < (LDS_BYTES - MISC_OFF) / 4; u += NWAVES * 64) ((LAS unsigned*)(lds + MISC_OFF))[u] = 0u;
    __syncthreads();
    XcdBarrier bar; bar.bar = (unsigned*)(args.ws + WS_CTL) + CW_BAR; bar.x = 0; bar.st = nullptr;
#if MK_N_LAUNCHES == 1
    bar = xcd_barrier_post((unsigned*)(args.ws + WS_CTL) + CW_BAR, MISC + 8);
#define GRID_BAR() xcd_barrier(bar)
#else
#define GRID_BAR() do { } while (0)
#endif
    const int lo = args.ph_lo, hi = args.ph_hi;
#ifndef PROBE_MASK
#define PROBE_MASK 0u
#endif
#define PH_KIND(k) ((k) == 0 ? 0 : 1 + ((k) - 1) % PH_PER_LAYER)
#define REPS(kk) for (int rep_ = 0; rep_ < (((PROBE_MASK >> (kk)) & 1u) ? 2 : 1); ++rep_)
#define HASK(kk) (((PMASK >> (kk)) & 1u) != 0u)

#define PHASE_VARS \
    const __attribute__((address_space(4))) unsigned long long* kargs_ = (const __attribute__((address_space(4))) unsigned long long*)__builtin_amdgcn_kernarg_segment_ptr(); \
    __builtin_amdgcn_s_waitcnt(0);       \
    asm volatile("" : "+s"(kargs_));     \
    unsigned char* ws = (unsigned char*)(GAS unsigned char*)kargs_[23]; \
    int lane_o_ = (int)__builtin_amdgcn_mbcnt_hi(~0u, __builtin_amdgcn_mbcnt_lo(~0u, 0u)); asm volatile("" : "+v"(lane_o_));     \
    const int lane = lane_o_, wave = wave_s_, tid = wave_s_ * 64 + lane_o_; \
    const int gw = blk * NWAVES + wave, NGW = G * NWAVES, gtid = blk * (NWAVES * 64) + tid, NT = G * NWAVES * 64; \
    (void)lane; (void)wave; (void)gw; (void)NGW; (void)gtid; (void)NT; \
    float* XF = (float*)(ws + WS_XF); bf16* XB = (bf16*)(ws + WS_XB); \
    float* ROPE = (float*)(ws + WS_ROPE); bf16* PB16 = (bf16*)(ws + WS_PB16); \
    bf16* Qb = (bf16*)(ws + WS_Q); bf16* KVb = (bf16*)(ws + WS_KV); bf16* QIb = (bf16*)(ws + WS_QI); bf16* KIb = (bf16*)(ws + WS_KI); float* WIb = (float*)(ws + WS_WI); \
    bf16* Ub = (bf16*)(ws + WS_U); bf16* SGA = (bf16*)(ws + WS_SGA); bf16* SGB = (bf16*)(ws + WS_SGB); bf16* YAYP = (bf16*)(ws + WS_YAYP); bf16* DP = (bf16*)(ws + WS_DP); \
    float* T1 = (float*)(ws + WS_T1); bf16* MRG = (bf16*)(ws + WS_MRG); float* X1F = (float*)(ws + WS_X1F); bf16* X1B = (bf16*)(ws + WS_X1B); \
    bf16* XS = (bf16*)(ws + WS_XS); bf16* ACT = (bf16*)(ws + WS_ACT); bf16* YR = (bf16*)(ws + WS_YR); bf16* PLEPb = (bf16*)(ws + WS_PLEP); bf16* PLEV = (bf16*)(ws + WS_PLEV); \
    int* TOPI = (int*)(ws + WS_ROUTE + RT_TOPI); float* GATE = (float*)(ws + WS_ROUTE + RT_GATE); int* LRANK = (int*)(ws + WS_ROUTE + RT_LRANK); \
    int* TOKROW = (int*)(ws + WS_ROUTE + RT_TOKROW); float* ROWG = (float*)(ws + WS_ROUTE + RT_ROWG); float* ROWS = (float*)(ws + WS_ROUTE + RT_ROWS); (void)ROWS; float* X1S = (float*)(ws + WS_ROUTE + RT_X1S); (void)X1S; unsigned char* X1Q = (unsigned char*)(ws + WS_X1B); (void)X1Q; unsigned char* XQ = (unsigned char*)(ws + WS_XB); (void)XQ; float* XQS = (float*)(ws + WS_ROUTE + RT_XQS); (void)XQS; \
    unsigned char* lw = ws + WS_W + (size_t)l * LW_SIZE; \
    int* HISTL = (int*)(ws + WS_ROUTE + RT_HIST) + l * 256 * 32; int* TILE = (int*)(ws + WS_ROUTE + RT_TILE) + l * 512; \
    (void)XF; (void)XB; (void)ROPE; (void)PB16; (void)Qb; (void)KVb; (void)QIb; (void)KIb; (void)WIb; (void)Ub; (void)SGA; (void)SGB; (void)YAYP; (void)DP; (void)T1; (void)MRG; (void)X1F; (void)X1B; \
    (void)XS; (void)ACT; (void)YR; (void)PLEPb; (void)PLEV; (void)TOPI; (void)GATE; (void)LRANK; (void)TOKROW; (void)ROWG; (void)lw; (void)HISTL; (void)TILE;

#pragma unroll 1
    for (int ph = lo; ph < hi; ++ph) {
    const int kind = PH_KIND(ph), l = (ph - 1) / PH_PER_LAYER;
    if (kind == 0 && HASK(0)) REPS(0) {
        PHASE_VARS
        const float* x_in = ARGP(0); const float* p_in = ARGP(1);
        if (blk < DEPTH * B_LAYER) {
            P0D cur; p0_decode(cur, blk, wave, ws, kargs_, lane); f32x4 tv[16]; int par = 0;
#pragma unroll
            for (int i = 0; i < 16; ++i) tv[i] = __builtin_nontemporal_load((const f32x4*)(cur.src + (size_t)i * cur.nsrc));
#pragma unroll 1
            for (int it = blk;; it += G) {
                const bool has = it + G < DEPTH * B_LAYER; P0D nx; f32x4 tn[16];
                p0_decode(nx, has ? it + G : it, wave, ws, kargs_, lane);
#pragma unroll
                for (int i = 0; i < 16; ++i) tn[i] = __builtin_nontemporal_load((const f32x4*)(nx.src + (size_t)i * nx.nsrc));
                asm volatile("" ::: "memory");
                const float sc_ = cur.valid ? cur.ws : 0.f;
                LAS unsigned char* tile = lds + par * 65536; par ^= 1;
                if (cur.i8) {
#pragma unroll
                    for (int c = 0; c < 4; ++c) { u32x4 o;
                        o.x = pack4_i8(tv[0][c] * sc_, tv[1][c] * sc_, tv[2][c] * sc_, tv[3][c] * sc_); o.y = pack4_i8(tv[4][c] * sc_, tv[5][c] * sc_, tv[6][c] * sc_, tv[7][c] * sc_);
                        o.z = pack4_i8(tv[8][c] * sc_, tv[9][c] * sc_, tv[10][c] * sc_, tv[11][c] * sc_); o.w = pack4_i8(tv[12][c] * sc_, tv[13][c] * sc_, tv[14][c] * sc_, tv[15][c] * sc_);
                        *(LAS u32x4*)(tile + (4 * lane + c) * 128 + 16 * (wave ^ (lane & 7))) = o; }
                    LDS_WAIT(); __builtin_amdgcn_s_barrier();
#pragma unroll
                    for (int j = 0; j < 4; ++j) { const int ci = j * 512 + tid, n = ci >> 3, q = ci & 7;
                        *(GAS u32x4*)(cur.dst + (size_t)n * cur.ldtb + 16 * q) = *(const LAS u32x4*)(tile + n * 128 + 16 * (q ^ ((n >> 2) & 7))); }
                } else {
#pragma unroll
                    for (int c = 0; c < 4; ++c) { u32x4 o0, o1;
                        o0.x = pk2(tv[0][c] * sc_, tv[1][c] * sc_); o0.y = pk2(tv[2][c] * sc_, tv[3][c] * sc_); o0.z = pk2(tv[4][c] * sc_, tv[5][c] * sc_); o0.w = pk2(tv[6][c] * sc_, tv[7][c] * sc_);
                        o1.x = pk2(tv[8][c] * sc_, tv[9][c] * sc_); o1.y = pk2(tv[10][c] * sc_, tv[11][c] * sc_); o1.z = pk2(tv[12][c] * sc_, tv[13][c] * sc_); o1.w = pk2(tv[14][c] * sc_, tv[15][c] * sc_);
                        *(LAS u32x4*)(tile + (4 * lane + c) * 256 + 16 * ((2 * wave) ^ (lane & 7))) = o0; *(LAS u32x4*)(tile + (4 * lane + c) * 256 + 16 * ((2 * wave + 1) ^ (lane & 7))) = o1; }
                    LDS_WAIT(); __builtin_amdgcn_s_barrier();
#pragma unroll
                    for (int j = 0; j < 8; ++j) { const int ci = j * 512 + tid, n = ci >> 4, q = ci & 15;
                        *(GAS u32x4*)(cur.dst + (size_t)n * cur.ldtb + 16 * q) = *(const LAS u32x4*)(tile + n * 256 + 16 * (q ^ ((n >> 2) & 7))); }
                }
                if (!has) break;
                cur = nx;
#pragma unroll
                for (int i = 0; i < 16; ++i) tv[i] = tn[i];
            }
        }
        for (int it = gtid; it < DEPTH * 64 * 1024; it += NT) {
            const int n = it & 1023, kc = (it >> 10) & 63, ll = it >> 16, g = kc >> 4, c0 = (kc & 15) * 8;
            const float* pw = ARGP(5) + ((size_t)(ll * 4 + g) * 128 + c0) * 128;
            const float* sc = ARGP(6) + (size_t)ll * 512 + g * 128;
            const float* wp = ARGP(8) + ((size_t)ll * 512 + g * 128) * D + n;
            float a8[8];
#pragma unroll
            for (int j = 0; j < 8; ++j) a8[j] = 0.f;
#pragma unroll 2
            for (int d = 0; d < 128; d += 4) {
                const f32x4 s4 = *(const f32x4*)(sc + d);
                const f32x4 w4 = (f32x4){wp[(size_t)d * D] * s4[0], wp[(size_t)(d + 1) * D] * s4[1], wp[(size_t)(d + 2) * D] * s4[2], wp[(size_t)(d + 3) * D] * s4[3]};
#pragma unroll
                for (int j = 0; j < 8; ++j) { const f32x4 p4 = *(const f32x4*)(pw + j * 128 + d); a8[j] += (p4[0] * w4[0] + p4[1] * w4[1]) + (p4[2] * w4[2] + p4[3] * w4[3]); }
            }
            u32x4 o; o.x = pk2(a8[0], a8[1]); o.y = pk2(a8[2], a8[3]); o.z = pk2(a8[4], a8[5]); o.w = pk2(a8[6], a8[7]);
            *(u32x4*)((bf16*)(ws + WS_W + (size_t)ll * LW_SIZE + LW_WUPA) + (size_t)n * 1024 + 512 + 8 * kc) = o;
        }
        for (int it = gtid; it < SEQ * 8; it += NT) {
            const int pos = it >> 3, i = it & 7; const double tr = (double)pos * ROPE_TURNS[i]; const float fr = (float)(tr - __builtin_rint(tr));
            ROPE[pos * 16 + i] = __builtin_amdgcn_cosf(fr); ROPE[pos * 16 + 8 + i] = __builtin_amdgcn_sinf(fr);
        }
        { f32x4 pa[8], pc[8];
#pragma unroll
          for (int q = 0; q < 8; ++q) { const size_t it = (size_t)gtid + (size_t)q * NT; pa[q] = __builtin_nontemporal_load((const f32x4*)(p_in + it * 8)); pc[q] = __builtin_nontemporal_load((const f32x4*)(p_in + it * 8 + 4)); }
#pragma unroll
          for (int q = 0; q < 8; ++q) { const size_t it = (size_t)gtid + (size_t)q * NT; *(u32x4*)(PB16 + it * 8) = pg8::pack8(pa[q], pc[q]); } }
#pragma unroll 1
        for (int m = gw; m < M; m += 4 * NGW) {
            f32x4 v[4][4];
#pragma unroll
            for (int u = 0; u < 4; ++u)
#pragma unroll
                for (int j = 0; j < 4; ++j) v[u][j] = __builtin_nontemporal_load((const f32x4*)(x_in + (size_t)(m + u * NGW) * D + 4 * lane + 256 * j));
#pragma unroll
            for (int u = 0; u < 4; ++u) { const int mr = m + u * NGW; ln_regs(v[u], ARGP(2), ARGP(3), lane);
                store_row_f32(XF + (size_t)mr * D, v[u], lane); store_row_i8(XQ + (size_t)mr * D, XQS + mr, v[u], lane); }
        }
    }
        else if (kind == 1 && HASK(1)) REPS(1) {
            PHASE_VARS
            pg8::StaticSched S; S.init(M, NZ, G, blk, XQ, D / 2, lw + LW_WIN, D / 2);
            pg8::EpiZ<true> E{Qb, KVb, QIb, KIb, WIb, Ub, SGA, SGB, ROPE, XQS};
            pg8::gemm_phase<pg8::EpiZ<true>, pg8::StaticSched, true, true>(lds, wave, pg8::Gemm{D / 2, D / 2}, S, E);
        }
        else if (kind == 2 && HASK(2)) REPS(2) {
            PHASE_VARS
            if (G == 256) {
                const int bb = (blk & 7) >> 1, cb = ((blk & 7) & 1) * 32 + (blk >> 3);
                for (int j = 0; j < 8; ++j) {
                    const int tq = 64 * j + ((j & 1) ? (63 - cb) : cb);
                    attn_unit(lds, wave, lane, bb, 8 * tq, QIb, KIb, WIb, Qb, KVb, YAYP);
                    __syncthreads();
                }
            } else {
                for (int j = 0; j < (2048 + G - 1) / G; ++j) {
                    const int id = G * j + ((j & 1) ? (G - 1 - blk) : blk);
                    if (id < 2048) attn_unit(lds, wave, lane, id & 3, 8 * (id >> 2), QIb, KIb, WIb, Qb, KVb, YAYP);
                    __syncthreads();
                }
            }
            for (int repw_ = 0; repw_ < (ATT_PROBE == 4 ? 2 : 1); ++repw_) pool_window(Ub, YAYP + 512, gtid, NT);
            __syncthreads();
            { pg8::StaticSched S; S.init(M, D, G, blk, PB16 + (size_t)l * M * PLE, PLE, lw + LW_PLEP, PLE);
              pg8::EpiBf16 E{PLEPb, 1024, 0, nullptr};
              pg8::gemm_phase<pg8::EpiBf16, pg8::StaticSched, true>(lds, wave, pg8::Gemm{PLE, PLE}, S, E); }
        }
        else if (kind == 3) { }
        else if (kind == 4 && HASK(4)) REPS(4) {
            PHASE_VARS
            { pg8::StaticSched S; S.init(M, D, G, blk, YAYP, 1024, lw + LW_WUPA, 1024);
              pg8::EpiGateMerge E{SGA, SGB, MRG};
              pg8::gemm_phase<pg8::EpiGateMerge, pg8::StaticSched, true>(lds, wave, pg8::Gemm{1024, 1024}, S, E); }
        }
        else if (kind == 5 && HASK(5)) REPS(5) {
            PHASE_VARS
            pg8::StaticSched S; S.init(M, D, G, blk, MRG, D, lw + LW_WOUT, D);
            pg8::EpiResid E{XF, T1, DN_ALPHA};
            pg8::gemm_phase<pg8::EpiResid, pg8::StaticSched, true>(lds, wave, pg8::Gemm{D, D}, S, E);
        }
        else if (kind == 6 && HASK(6)) REPS(6) {
            PHASE_VARS
            if (blk < 256) ln1_router_phase(lds, tid, wave, lane, blk, T1, ARGP(10) + (size_t)l * D, ARGP(11) + (size_t)l * D, ARGP(12) + (size_t)l * D * NE, ARGP(13) + (size_t)l * NE,
                                            X1F, X1Q, X1S, TOPI, GATE, LRANK, HISTL);
        }
        else if (kind == 7 && HASK(7)) REPS(7) {
            PHASE_VARS
            if (blk < 256) scatter_phase(lds, tid, wave, lane, blk, HISTL, TOPI, GATE, LRANK, X1Q, X1S, (unsigned char*)XS, ROWG, ROWS, TOKROW, TILE);
        }
        else if (kind == 8 && HASK(8)) REPS(8) {
            PHASE_VARS
            LAS int* TL = (LAS int*)(lds + XTRA_OFF);
            for (int i = tid; i < 512; i += NWAVES * 64) TL[i] = __hip_atomic_load(TILE + i, __ATOMIC_RELAXED, __HIP_MEMORY_SCOPE_AGENT);
            __syncthreads();
            const int ntiles = TL[0];
            const int slotsH = ((ntiles * 8 + G - 1) / G) * G - ntiles * 8, pleH = slotsH < 256 ? slotsH : 256;
            { pg8::MoeSched S{ntiles, 8, G, (blk & 7) * (G >> 3) + (blk >> 3), TL + 1, (const char*)XS, (const char*)(lw + LW_WGU), (size_t)256 * D, (size_t)2048 * D, (size_t)256 * D,
                              0, pleH, (const char*)X1Q, (const char*)(lw + LW_PLEG), (size_t)256 * D, (size_t)256 * D};
              pg8::EpiSwigluPle E{{ARGP(15) + (size_t)l * NE * 2048, ROWS, (unsigned char*)ACT}, {PLEPb, X1S, PLEV}};
              pg8::gemm_phase<pg8::EpiSwigluPle, pg8::MoeSched, true, true>(lds, wave, pg8::Gemm{D / 2, D / 2}, S, E); }
        }
        else if (kind == 9 && HASK(9)) REPS(9) {
            PHASE_VARS
            LAS int* TL = (LAS int*)(lds + XTRA_OFF);
            for (int i = tid; i < 512; i += NWAVES * 64) TL[i] = __hip_atomic_load(TILE + i, __ATOMIC_RELAXED, __HIP_MEMORY_SCOPE_AGENT);
            __syncthreads();
            const int ntiles = TL[0];
            const int slotsH = ((ntiles * 8 + G - 1) / G) * G - ntiles * 8, pleH = slotsH < 256 ? slotsH : 256;
            { pg8::MoeSched S{ntiles, 4, G, (blk & 7) * (G >> 3) + (blk >> 3), TL + 1, (const char*)ACT, (const char*)(lw + LW_WDN), (size_t)256 * DFF, (size_t)D * DFF, (size_t)256 * DFF,
                              pleH, 256 - pleH, (const char*)X1Q, (const char*)(lw + LW_PLEG), (size_t)256 * D, (size_t)256 * D};
              pg8::EpiDownPle E{{ARGP(17) + (size_t)l * NE * D, ROWG, YR}, {PLEPb, X1S, PLEV}};
              pg8::gemm_phase<pg8::EpiDownPle, pg8::MoeSched, true, true>(lds, wave, pg8::Gemm{DFF / 2, DFF / 2}, S, E); }
        }
        else if (kind == 10 && HASK(10)) REPS(10) {
            PHASE_VARS
            combine_ln2_phase(gw, NGW, lane, X1F, PLEV, YR, TOKROW, ARGP(20) + (size_t)l * D, ARGP(21) + (size_t)l * D, XF, XQ, XQS, (l == DEPTH - 1) ? (float*)(GAS float*)kargs_[22] : nullptr);
        }
    if (ph + 1 < hi && kind != 3) { GRID_BAR(); if (ATT_PROBE == 5) GRID_BAR(); }
    }
}

#if MK_N_LAUNCHES == 1
#define MEGA_ALL mega_fwd<0x7ffu>
#else
typedef void (*kern_t)(Args);
static kern_t phase_kernel(int kind) {
    switch (kind) { case 0: return mega_fwd<1u>; case 1: return mega_fwd<2u>; case 2: return mega_fwd<4u>; case 3: return mega_fwd<8u>; case 4: return mega_fwd<16u>; case 5: return mega_fwd<32u>;
                    case 6: return mega_fwd<64u>; case 7: return mega_fwd<128u>; case 8: return mega_fwd<256u>; case 9: return mega_fwd<512u>; default: return mega_fwd<1024u>; }
}
#endif
extern "C" void kernel_launch(void* const* d_in, const int* in_sizes, int n_in, void* d_out, int out_size, void* d_ws, size_t ws_size, hipStream_t stream) {
    static int grid = 0;
    if (grid == 0) {
        if (n_in != 22 || out_size != M * D || ws_size < WS_END) { fprintf(stderr, "kernel_launch: unexpected shapes (n_in %d out %d ws %zu need %zu)\n", n_in, out_size, ws_size, (size_t)WS_END); grid = -1; return; }
        int dev = 0, cus = 0, per_cu = 0;
        if (hipGetDevice(&dev) != hipSuccess || hipDeviceGetAttribute(&cus, hipDeviceAttributeMultiprocessorCount, dev) != hipSuccess) { grid = -1; return; }
#if MK_N_LAUNCHES == 1
        if (hipFuncSetAttribute((const void*)MEGA_ALL, hipFuncAttributeMaxDynamicSharedMemorySize, LDS_BYTES) != hipSuccess) { fprintf(stderr, "kernel_launch: hipFuncSetAttribute failed\n"); grid = -1; return; }
        if (hipOccupancyMaxActiveBlocksPerMultiprocessor(&per_cu, (const void*)MEGA_ALL, NWAVES * 64, LDS_BYTES) != hipSuccess || per_cu < 1) { fprintf(stderr, "kernel_launch: occupancy query says %d blocks per CU\n", per_cu); grid = -1; return; }
#else
        for (int k = 0; k <= PH_PER_LAYER; ++k) if (hipFuncSetAttribute((const void*)phase_kernel(k), hipFuncAttributeMaxDynamicSharedMemorySize, LDS_BYTES) != hipSuccess) { fprintf(stderr, "kernel_launch: hipFuncSetAttribute failed\n"); grid = -1; return; }
        per_cu = 1;
#endif
        (void)hipGetLastError();
        grid = cus < 256 ? cus : 256;
    }
    if (grid < 0) return;
    (void)hipMemsetAsync((char*)d_ws + WS_CTL, 0, CTL_ZERO_BYTES, stream);
    Args a{};
    for (int i = 0; i < 22; ++i) a.in[i] = (const float*)d_in[i];
    a.out = (float*)d_out; a.ws = (unsigned char*)d_ws;
#if MK_N_LAUNCHES == 1
    a.ph_lo = 0; a.ph_hi = N_PHASES;
    hipLaunchKernelGGL(MEGA_ALL, dim3(grid), dim3(NWAVES * 64), LDS_BYTES, stream, a);
#else
    for (int ph = 0; ph < N_PHASES; ++ph) { a.ph_lo = ph; a.ph_hi = ph + 1; hipLaunchKernelGGL(phase_kernel(PH_KIND(ph)), dim3(grid), dim3(NWAVES * 64), LDS_BYTES, stream, a); }
#endif
}
```

```cpp
#include <hip/hip_runtime.h>
#ifndef ATT_PROBE
#define ATT_PROBE 0
#endif
#include <cstdio>
#include <cstdint>

#define LAS __attribute__((address_space(3)))
#define GAS __attribute__((address_space(1)))
typedef unsigned short bf16;
typedef short bf16x8 __attribute__((ext_vector_type(8)));
typedef float f32x4 __attribute__((ext_vector_type(4)));
typedef float f32x2 __attribute__((ext_vector_type(2)));
typedef float f32x16 __attribute__((ext_vector_type(16)));
typedef unsigned u32x4 __attribute__((ext_vector_type(4)));
typedef unsigned u32x2 __attribute__((ext_vector_type(2)));
typedef GAS unsigned gu32;

constexpr int D = 1024, BATCH = 4, SEQ = 4096, M = BATCH * SEQ, DEPTH = 2;
constexpr int NZ = 4096;
constexpr int D_IN = 3912;
constexpr int NE = 32, TOPK = 4, DFF = 1024, PLE = 256;
constexpr int NSEL = 256;
constexpr int RMAX = M * TOPK + NE * 256;
constexpr int TMAX = RMAX / 256;
constexpr float LN_EPS = 1e-5f;
constexpr float DN_ALPHA = 1.41421356237309515f;

__device__ __forceinline__ unsigned f2bf(float f) { unsigned u = __builtin_bit_cast(unsigned, f); return (u + 0x7fffu + ((u >> 16) & 1u)) >> 16; }
typedef __bf16 hwbf16x2 __attribute__((ext_vector_type(2)));
__device__ __forceinline__ unsigned pk2(float lo, float hi) { const f32x2 v = {lo, hi}; return __builtin_bit_cast(unsigned, __builtin_convertvector(v, hwbf16x2)); }
__device__ __forceinline__ float bf2f(unsigned short h) { return __builtin_bit_cast(float, (unsigned)h << 16); }
__device__ __forceinline__ float bflo(unsigned w) { return __builtin_bit_cast(float, w << 16); }
__device__ __forceinline__ float bfhi(unsigned w) { return __builtin_bit_cast(float, w & 0xffff0000u); }
__device__ __forceinline__ float sigmoidf_(float x) { return __builtin_amdgcn_rcpf(1.0f + __expf(-x)); }
constexpr float I8_WS_GU = 127.0f / (6.0f / 32.0f), I8_WS_DN = 127.0f / (6.0f / 64.0f), I8_AS = 127.0f / 10.0f;
__device__ __forceinline__ unsigned pack4_i8(float a, float b, float c, float d) {
    unsigned r = 0u;
    r = __builtin_amdgcn_cvt_pk_u8_f32(a + 128.0f, 0, r); r = __builtin_amdgcn_cvt_pk_u8_f32(b + 128.0f, 1, r);
    r = __builtin_amdgcn_cvt_pk_u8_f32(c + 128.0f, 2, r); r = __builtin_amdgcn_cvt_pk_u8_f32(d + 128.0f, 3, r);
    return r ^ 0x80808080u;
}
__device__ __forceinline__ unsigned pack4_fp8(float a, float b, float c, float d) { int r = __builtin_amdgcn_cvt_pk_fp8_f32(a, b, 0, false); r = __builtin_amdgcn_cvt_pk_fp8_f32(c, d, r, true); return (unsigned)r; }
#define LDS_WAIT() asm volatile("s_waitcnt lgkmcnt(0)" ::: "memory")
#define VM_WAIT() asm volatile("s_waitcnt vmcnt(0)" ::: "memory")
#define WAVE_FENCE() do { asm volatile("s_waitcnt lgkmcnt(0)" ::: "memory"); __builtin_amdgcn_wave_barrier(); } while (0)

template <int X> __device__ __forceinline__ float shx(float v) {
    static_assert(X == 1 || X == 2 || X == 4 || X == 8 || X == 16, "shx: xor distance below 32");
    return __builtin_bit_cast(float, __builtin_amdgcn_ds_swizzle(__builtin_bit_cast(int, v), (X << 10) | 0x1f));
}
template <int X> __device__ __forceinline__ int shxi(int v) { return __builtin_amdgcn_ds_swizzle(v, (X << 10) | 0x1f); }
struct SwapPair { unsigned a, b; };
__device__ __forceinline__ SwapPair swap32(float v) { unsigned a = __builtin_bit_cast(unsigned, v), b = a; asm volatile("" : "+v"(b)); const auto r = __builtin_amdgcn_permlane32_swap(a, b, false, false); return SwapPair{r[0], r[1]}; }
__device__ __forceinline__ float sum32(float v) { const SwapPair r = swap32(v); return __builtin_bit_cast(float, r.a) + __builtin_bit_cast(float, r.b); }
__device__ __forceinline__ float max32(float v) { const SwapPair r = swap32(v); return fmaxf(__builtin_bit_cast(float, r.a), __builtin_bit_cast(float, r.b)); }
__device__ __forceinline__ float min32(float v) { const SwapPair r = swap32(v); return fminf(__builtin_bit_cast(float, r.a), __builtin_bit_cast(float, r.b)); }
__device__ __forceinline__ float partner32(float v, bool upper_half) { const SwapPair r = swap32(v); return __builtin_bit_cast(float, upper_half ? r.a : r.b); }

namespace pg8 {
typedef int i32x4 __attribute__((ext_vector_type(4)));
typedef int i32x8 __attribute__((ext_vector_type(8)));
constexpr int BM = 256, BK = 64, HALF = 128, HTB = HALF * BK * 2  , STAGE_BYTES = 8 * HTB;

__host__ __device__ __forceinline__ int lds_byte(int r, int c) { const int st = (r >> 4) * 2 + (c >> 5), rr = r & 15, cc = c & 31, ob = rr * 64 + cc * 2; return st * 1024 + (ob ^ (((ob >> 9) & 1) << 5)); }
__host__ __device__ __forceinline__ void stage_rc(int b, int& R, int& C) { const int st = b / 1024, sb = b % 1024, swz = sb ^ (((sb >> 9) & 1) << 5); R = (st >> 1) * 16 + swz / 64; C = (st & 1) * 32 + (swz % 64) / 2; }
__host__ __device__ __forceinline__ int perm32(int rho) { const int n = rho >> 4, i = rho & 15; return 8 * (i >> 2) + 4 * n + (i & 3); }

struct Unit { int pm, pn, aux; const char* a; const char* b; };
struct Gemm { int lda, K; };

template <class Epi, class Sched, bool ALIGN_EPI, bool I8 = false>
__device__ __forceinline__ void gemm_phase(LAS unsigned char* lds, const int wave_id, const Gemm g, const Sched& S, const Epi& E) {
    int lane = (int)__builtin_amdgcn_mbcnt_hi(~0u, __builtin_amdgcn_mbcnt_lo(~0u, 0u)); asm volatile("" : "+v"(lane));
    const int wid = wave_id, tid = wave_id * 64 + lane, wr = wid >> 2, wc = wid & 3, fr = lane & 15, fq = lane >> 4;
    const int K = g.K, nt = K / BK, lda = g.lda;
    unsigned voffA[2], voffB[2];
#pragma unroll
    for (int i = 0; i < 2; ++i) { int R, C; stage_rc(tid * 16 + i * 8192, R, C); const int Rb = Epi::PERM ? ((R & ~31) + perm32(R & 31)) : R;
        voffA[i] = (unsigned)(R * lda + C) * 2u; voffB[i] = (unsigned)(Rb * K + C) * 2u; }
    const size_t kstep = (size_t)(BK * 2);
    const size_t hstepA = (size_t)HALF * lda * 2, hstepB = (size_t)HALF * K * 2;
    const unsigned ldsw = (unsigned)wid * 1024u;
    const int aoff = lds_byte(wr * 64 + fr, fq * 8), boff = lds_byte(wc * 32 + fr, fq * 8);
#define PG8_SA(b, h) (((b) * 2 + (h)) * HTB)
#define PG8_SB(b, h) ((4 + (b) * 2 + (h)) * HTB)
#define PG8_STAGE(bufoff, gbase, voff) do { _Pragma("unroll") for (int _i = 0; _i < 2; ++_i) \
        __builtin_amdgcn_global_load_lds((const unsigned*)((const char*)(gbase) + (voff)[_i]), (LAS unsigned*)(lds + (bufoff) + ldsw + _i * 8192), 16, 0, 0); } while (0)
#define PG8_LDA(dst, b, h) do { _Pragma("unroll") for (int m = 0; m < 4; ++m) dst[m] = __builtin_shufflevector(*(const LAS i32x4*)(lds + PG8_SA(b, h) + aoff + m * 2048), *(const LAS i32x4*)(lds + PG8_SA(b, h) + aoff + m * 2048 + 1024), 0, 1, 2, 3, 4, 5, 6, 7); } while (0)
#define PG8_LDB(dst, b, h) do { _Pragma("unroll") for (int n = 0; n < 2; ++n) dst[n] = __builtin_shufflevector(*(const LAS i32x4*)(lds + PG8_SB(b, h) + boff + n * 2048), *(const LAS i32x4*)(lds + PG8_SB(b, h) + boff + n * 2048 + 1024), 0, 1, 2, 3, 4, 5, 6, 7); } while (0)
#define PG8_HALFI(v, k) __builtin_shufflevector(v, v, 4 * (k), 4 * (k) + 1, 4 * (k) + 2, 4 * (k) + 3)
#define PG8_HALF(v, k) __builtin_bit_cast(bf16x8, __builtin_shufflevector(v, v, 4 * (k), 4 * (k) + 1, 4 * (k) + 2, 4 * (k) + 3))
#define PG8_MMA(ai, bj, At, Bt) do { __builtin_amdgcn_s_setprio(1); \
        if constexpr (I8) { _Pragma("unroll") for (int m = 0; m < 4; ++m) _Pragma("unroll") for (int n = 0; n < 2; ++n) { \
            acc[ai][bj][m][n] = __builtin_bit_cast(f32x4, __builtin_amdgcn_mfma_i32_16x16x64_i8(PG8_HALFI(Bt[n], 0), PG8_HALFI(At[m], 0), __builtin_bit_cast(i32x4, acc[ai][bj][m][n]), 0, 0, 0)); \
            acc[ai][bj][m][n] = __builtin_bit_cast(f32x4, __builtin_amdgcn_mfma_i32_16x16x64_i8(PG8_HALFI(Bt[n], 1), PG8_HALFI(At[m], 1), __builtin_bit_cast(i32x4, acc[ai][bj][m][n]), 0, 0, 0)); } } \
        else { _Pragma("unroll") for (int m = 0; m < 4; ++m) _Pragma("unroll") for (int n = 0; n < 2; ++n) { \
            acc[ai][bj][m][n] = __builtin_amdgcn_mfma_f32_16x16x32_bf16(PG8_HALF(Bt[n], 0), PG8_HALF(At[m], 0), acc[ai][bj][m][n], 0, 0, 0); \
            acc[ai][bj][m][n] = __builtin_amdgcn_mfma_f32_16x16x32_bf16(PG8_HALF(Bt[n], 1), PG8_HALF(At[m], 1), acc[ai][bj][m][n], 0, 0, 0); } } \
        __builtin_amdgcn_s_setprio(0); } while (0)
#define PG8_WAIT_V(n) asm volatile("s_waitcnt vmcnt(" #n ")" ::: "memory")
#define PG8_WAIT_L(n) asm volatile("s_waitcnt lgkmcnt(" #n ")" ::: "memory")
#define PG8_BAR __builtin_amdgcn_s_barrier()
#define PG8_SCHED __builtin_amdgcn_sched_barrier(0)
    Unit cur, nxt; int ui = 0;
    if (!S.next(0, cur)) return;
    f32x4 acc[2][2][4][2];
#pragma unroll
    for (int a = 0; a < 2; ++a)
#pragma unroll
        for (int b = 0; b < 2; ++b)
#pragma unroll
            for (int m = 0; m < 4; ++m)
#pragma unroll
                for (int n = 0; n < 2; ++n) acc[a][b][m][n] = (f32x4){0.f, 0.f, 0.f, 0.f};
    i32x8 At[4], B0[2], B1[2];
    const char* cA = cur.a; const char* cB = cur.b;
    PG8_STAGE(PG8_SB(0, 0), cB, voffB); PG8_STAGE(PG8_SB(0, 1), cB + hstepB, voffB); PG8_STAGE(PG8_SA(0, 0), cA, voffA); PG8_STAGE(PG8_SA(0, 1), cA + hstepA, voffA);
    if (wr == 1) PG8_BAR;
    PG8_WAIT_V(2); PG8_BAR;
    PG8_STAGE(PG8_SB(1, 0), cB + kstep, voffB); PG8_STAGE(PG8_SA(1, 0), cA + kstep, voffA); PG8_STAGE(PG8_SB(1, 1), cB + hstepB + kstep, voffB);
    PG8_WAIT_V(6); PG8_BAR;
    for (;;) {
        const bool has_next = S.next(ui + 1, nxt);
        const char* nA = has_next ? nxt.a : cA; const char* nB = has_next ? nxt.b : cB;
#pragma unroll 1
        for (int t = 0; t < nt; t += 2) {
            const bool last = (t == nt - 2);
            const char* a1 = cA + (size_t)(t + 1) * kstep;
            const char* a2 = last ? nA : cA + (size_t)(t + 2) * kstep; const char* b2 = last ? nB : cB + (size_t)(t + 2) * kstep;
            const char* a3 = a2 + kstep; const char* b3 = b2 + kstep;
            PG8_LDB(B0, 0, 0); PG8_LDB(B1, 0, 1); PG8_SCHED; PG8_LDA(At, 0, 0); PG8_STAGE(PG8_SA(1, 1), a1 + hstepA, voffA);
            PG8_WAIT_V(8); PG8_WAIT_L(0); PG8_BAR; PG8_MMA(0, 0, At, B0); PG8_MMA(0, 1, At, B1); PG8_BAR; PG8_SCHED;
            PG8_LDA(At, 0, 1); PG8_STAGE(PG8_SB(0, 0), b2, voffB); PG8_STAGE(PG8_SB(0, 1), b2 + hstepB, voffB); PG8_STAGE(PG8_SA(0, 0), a2, voffA);
            PG8_WAIT_V(8); PG8_WAIT_L(0); PG8_BAR; PG8_MMA(1, 0, At, B0); PG8_MMA(1, 1, At, B1); PG8_BAR; PG8_SCHED;
            PG8_LDB(B0, 1, 0); PG8_LDB(B1, 1, 1); PG8_SCHED; PG8_LDA(At, 1, 0); PG8_STAGE(PG8_SA(0, 1), a2 + hstepA, voffA);
            PG8_WAIT_V(8); PG8_WAIT_L(0); PG8_BAR; PG8_MMA(0, 0, At, B0); PG8_MMA(0, 1, At, B1); PG8_BAR; PG8_SCHED;
            PG8_LDA(At, 1, 1); PG8_STAGE(PG8_SB(1, 0), b3, voffB); PG8_STAGE(PG8_SB(1, 1), b3 + hstepB, voffB); PG8_STAGE(PG8_SA(1, 0), a3, voffA);
            PG8_WAIT_V(8); PG8_WAIT_L(0); PG8_BAR; PG8_MMA(1, 0, At, B0); PG8_MMA(1, 1, At, B1); PG8_BAR; PG8_SCHED;
            if constexpr (Epi::MID) { if (t + 2 == nt / 2) { int fr_m = fr, fq_m = fq; asm volatile("" : "+v"(fr_m), "+v"(fq_m)); E.mid(acc, cur, wr, wc, fr_m, fq_m); } }
        }
        if constexpr (ALIGN_EPI) { if (wr == 0) PG8_BAR; }
        { int fr_e = fr, fq_e = fq; asm volatile("" : "+v"(fr_e), "+v"(fq_e));
          E(acc, cur, wr, wc, fr_e, fq_e);
#if ATT_PROBE == 9
          if constexpr (I8) { asm volatile("" : "+v"(fr_e), "+v"(fq_e)); E(acc, cur, wr, wc, fr_e, fq_e); }
#endif
        }
        if (!has_next) break;
#pragma unroll
        for (int a = 0; a < 2; ++a)
#pragma unroll
            for (int b = 0; b < 2; ++b)
#pragma unroll
                for (int m = 0; m < 4; ++m)
#pragma unroll
                    for (int n = 0; n < 2; ++n) acc[a][b][m][n] = (f32x4){0.f, 0.f, 0.f, 0.f};
        cur = nxt; cA = nA; cB = nB; ++ui;
        if constexpr (ALIGN_EPI) { if (wr == 1) PG8_BAR; }
    }
    PG8_WAIT_V(0);
    if constexpr (!ALIGN_EPI) { if (wr == 0) PG8_BAR; }
    PG8_BAR;
#undef PG8_SA
#undef PG8_SB
#undef PG8_STAGE
#undef PG8_LDA
#undef PG8_LDB
#undef PG8_HALF
#undef PG8_HALFI
#undef PG8_MMA
#undef PG8_WAIT_V
#undef PG8_WAIT_L
#undef PG8_BAR
#undef PG8_SCHED
}
}

namespace pg8 {
constexpr int NXCD = 8, WGM = 8;
struct StaticSched {
    int nM, nN, nwg, G, c; const char* A; const char* B; size_t strideA, strideB;
    __device__ __forceinline__ void init(int M_, int N_, int G_, int c_, const void* A_, int lda, const void* B_, int K) {
        nM = M_ / BM; nN = N_ / BM; nwg = nM * nN; G = G_; c = c_; A = (const char*)A_; B = (const char*)B_; strideA = (size_t)BM * lda * 2; strideB = (size_t)BM * K * 2; }
    __device__ __forceinline__ bool next(int i, Unit& u) const {
        const long L = (long)i * G + c; if (L >= nwg) return false;
        int wgid = (int)L; { const int q = nwg / NXCD, r = nwg % NXCD, xcd = wgid % NXCD, off = wgid / NXCD; wgid = (xcd < r ? xcd * (q + 1) : r * (q + 1) + (xcd - r) * q) + off; }
        const int nig = WGM * nN, gid = wgid / nig, fm = gid * WGM, gsz = (nM - fm) < WGM ? (nM - fm) : WGM;
        u.pm = fm + ((wgid % nig) % gsz); u.pn = (wgid % nig) / gsz; u.aux = 0;
        u.a = A + (size_t)u.pm * strideA; u.b = B + (size_t)u.pn * strideB; return true;
    }
};
struct MoeSched {
    int ntiles, nN, G, v; const LAS int* tile_e; const char* A; const char* W; size_t strideA, strideE, strideB;
    int p0, np; const char* PA; const char* PW; size_t pstrideA, pstrideB;
    __device__ __forceinline__ bool next(int i, Unit& u) const {
        const int L = i * G + v, nmoe = ntiles * nN;
        if (L < nmoe) { const int tile = L / nN, pn = L - tile * nN; const int e = tile_e[tile];
            u.pm = tile; u.pn = pn; u.aux = e; u.a = A + (size_t)tile * strideA; u.b = W + (size_t)e * strideE + (size_t)pn * strideB; return true; }
        const int p = L - nmoe; if (p >= np) return false;
        const int q = p0 + p; u.pm = q >> 2; u.pn = q & 3; u.aux = -1; u.a = PA + (size_t)u.pm * pstrideA; u.b = PW + (size_t)u.pn * pstrideB; return true;
    }
};

#define EPI_LOOP_ROWS for (int ai = 0; ai < 2; ++ai) _Pragma("unroll") for (int m = 0; m < 4; ++m)
__device__ __forceinline__ u32x4 pack8(f32x4 v0, f32x4 v1) { u32x4 w; w.x = pk2(v0[0], v0[1]); w.y = pk2(v0[2], v0[3]); w.z = pk2(v1[0], v1[1]); w.w = pk2(v1[2], v1[3]); return w; }

__device__ __forceinline__ f32x4 i2f4(f32x4 a) { const i32x4 v = __builtin_bit_cast(i32x4, a); return (f32x4){(float)v[0], (float)v[1], (float)v[2], (float)v[3]}; }
template <bool I8IN> struct EpiZ {
    static constexpr bool PERM = true, MID = false;
    bf16 *Q, *KV, *QI, *KI; float* WI; bf16 *U, *SGA, *SGB; const float* rope; const float* rows;
    __device__ __forceinline__ void operator()(const f32x4 (&acc)[2][2][4][2], const Unit& u, int wr, int wc, int fr, int fq) const {
        const int pn = u.pn; bf16* dst; int ldc, cb; unsigned ropemask = 0u; int mode = 0;
        if (pn < 2) { dst = Q; ldc = 512; cb = 256 * pn; ropemask = 0xFu; }
        else if (pn == 2) { dst = KV; ldc = 256; cb = 0; ropemask = 0x3u; }
        else if (pn < 5) { dst = QI; ldc = 512; cb = 256 * (pn - 3); ropemask = 0xFu; }
        else if (pn == 5) { dst = KI; ldc = 64; cb = 0; ropemask = 0x1u; mode = 2; }
        else if (pn < 8) { dst = U; ldc = 512; cb = 256 * (pn - 6); }
        else if (pn < 12) { dst = SGA; ldc = 1024; cb = 256 * (pn - 8); mode = 1; }
        else { dst = SGB; ldc = 1024; cb = 256 * (pn - 12); mode = 1; }
        const int row0 = u.pm * BM + wr * 64 + fr;
#pragma unroll
        EPI_LOOP_ROWS {
            const int row = row0 + ai * HALF + m * 16; const int pos = row & (SEQ - 1);
            float rs = 1.0f; if constexpr (I8IN) rs = rows[row] * (1.0f / I8_WS_GU);
#pragma unroll
            for (int bj = 0; bj < 2; ++bj) {
                f32x4 v0 = acc[ai][bj][m][0], v1 = acc[ai][bj][m][1];
                if constexpr (I8IN) { v0 = i2f4(v0) * rs; v1 = i2f4(v1) * rs; }
                const int grp = 2 * bj + (wc >> 1);
                if (((ropemask >> grp) & 1u) && !(wc & 1)) {
                    f32x4 p0, p1;
#pragma unroll
                    for (int e = 0; e < 4; ++e) { p0[e] = shx<16>(v0[e]); p1[e] = shx<16>(v1[e]); }
                    if (fq < 2) {
                        const f32x4 c0 = *(const f32x4*)(rope + pos * 16), c1 = *(const f32x4*)(rope + pos * 16 + 4), s0 = *(const f32x4*)(rope + pos * 16 + 8), s1 = *(const f32x4*)(rope + pos * 16 + 12);
                        if (fq == 0) { v0 = v0 * c0 - p0 * s0; v1 = v1 * c1 - p1 * s1; }
                        else         { v0 = v0 * c0 + p0 * s0; v1 = v1 * c1 + p1 * s1; }
                    }
                }
                if (mode == 1) {
#pragma unroll
                    for (int e = 0; e < 4; ++e) { v0[e] = sigmoidf_(v0[e]); v1[e] = sigmoidf_(v1[e]); }
                }
                if (mode == 2) {
                    if (bj == 0) {
                        if (wc < 2) *(u32x4*)(KI + ((size_t)((row >> 5) * 4 + 2 * wc + (fq >> 1)) * 64 + (row & 31) + 32 * (fq & 1)) * 8) = pack8(v0, v1);
                        else if (wc == 2 && fq == 0) { *(f32x4*)(WI + (size_t)row * 8) = v0; *(f32x4*)(WI + (size_t)row * 8 + 4) = v1; }
                    }
                } else if (pn == 2) {
                    u32x2 w8; w8.x = pack4_fp8(v0[0], v0[1], v0[2], v0[3]); w8.y = pack4_fp8(v1[0], v1[1], v1[2], v1[3]);
                    *(u32x2*)((unsigned char*)KV + (size_t)row * 256 + 128 * bj + 32 * wc + 8 * fq) = w8;
                } else {
                    *(u32x4*)(dst + (size_t)row * ldc + cb + 128 * bj + 32 * wc + 8 * fq) = pack8(v0, v1);
                }
            }
        }
    }
};
struct EpiBf16 {
    static constexpr bool PERM = true, MID = false;
    bf16* O; int ldc, coff; const float* scale;
    __device__ __forceinline__ void operator()(const f32x4 (&acc)[2][2][4][2], const Unit& u, int wr, int wc, int fr, int fq) const {
        const int row0 = u.pm * BM + wr * 64 + fr, col0 = u.pn * BM + wc * 32 + 8 * fq;
        f32x4 sv[2][2];
#pragma unroll
        for (int bj = 0; bj < 2; ++bj)
#pragma unroll
            for (int n = 0; n < 2; ++n) sv[bj][n] = scale ? *(const f32x4*)(scale + col0 + bj * HALF + 4 * n) : (f32x4){1.f, 1.f, 1.f, 1.f};
#pragma unroll
        EPI_LOOP_ROWS {
            bf16* rowp = O + (size_t)(row0 + ai * HALF + m * 16) * ldc + coff + col0;
#pragma unroll
            for (int bj = 0; bj < 2; ++bj) *(u32x4*)(rowp + bj * HALF) = pack8(acc[ai][bj][m][0] * sv[bj][0], acc[ai][bj][m][1] * sv[bj][1]);
        }
    }
};
struct EpiGateMerge {
    static constexpr bool PERM = true, MID = true;
    const bf16* SGA; const bf16* SGB; bf16* O;
    __device__ __forceinline__ void mid(f32x4 (&acc)[2][2][4][2], const Unit& u, int wr, int wc, int fr, int fq) const {
        const int row0 = u.pm * BM + wr * 64 + fr, col0 = u.pn * BM + wc * 32 + 8 * fq;
#pragma unroll
        for (int aq = 0; aq < 4; ++aq) {
            const int ai = aq >> 1;
            u32x4 ga[2][2], gb[2][2];
#pragma unroll
            for (int mm = 0; mm < 2; ++mm)
#pragma unroll
                for (int bj = 0; bj < 2; ++bj) { const size_t off = (size_t)(row0 + ai * HALF + (2 * (aq & 1) + mm) * 16) * 1024 + col0 + bj * HALF; ga[mm][bj] = *(const u32x4*)(SGA + off); gb[mm][bj] = *(const u32x4*)(SGB + off); }
            asm volatile("" ::: "memory");
#pragma unroll
            for (int mm = 0; mm < 2; ++mm)
#pragma unroll
                for (int bj = 0; bj < 2; ++bj) {
                    const int m = 2 * (aq & 1) + mm;
                    const u32x4 a = ga[mm][bj], b = gb[mm][bj];
                    f32x4& v0 = acc[ai][bj][m][0]; f32x4& v1 = acc[ai][bj][m][1];
                    v0[0] *= bflo(a.x) * __builtin_amdgcn_rcpf(bflo(b.x)); v0[1] *= bfhi(a.x) * __builtin_amdgcn_rcpf(bfhi(b.x)); v0[2] *= bflo(a.y) * __builtin_amdgcn_rcpf(bflo(b.y)); v0[3] *= bfhi(a.y) * __builtin_amdgcn_rcpf(bfhi(b.y));
                    v1[0] *= bflo(a.z) * __builtin_amdgcn_rcpf(bflo(b.z)); v1[1] *= bfhi(a.z) * __builtin_amdgcn_rcpf(bfhi(b.z)); v1[2] *= bflo(a.w) * __builtin_amdgcn_rcpf(bflo(b.w)); v1[3] *= bfhi(a.w) * __builtin_amdgcn_rcpf(bfhi(b.w));
                }
            asm volatile("" ::: "memory");
        }
    }
    __device__ __forceinline__ void operator()(const f32x4 (&acc)[2][2][4][2], const Unit& u, int wr, int wc, int fr, int fq) const {
        const int row0 = u.pm * BM + wr * 64 + fr, col0 = u.pn * BM + wc * 32 + 8 * fq;
        u32x4 gq[2][4][2];
#pragma unroll
        EPI_LOOP_ROWS
#pragma unroll
            for (int bj = 0; bj < 2; ++bj) gq[ai][m][bj] = *(const u32x4*)(SGB + (size_t)(row0 + ai * HALF + m * 16) * 1024 + col0 + bj * HALF);
        asm volatile("" ::: "memory");
#pragma unroll
        EPI_LOOP_ROWS {
            const size_t off = (size_t)(row0 + ai * HALF + m * 16) * 1024 + col0;
#pragma unroll
            for (int bj = 0; bj < 2; ++bj) {
                const u32x4 g = gq[ai][m][bj];
                f32x4 v0 = acc[ai][bj][m][0], v1 = acc[ai][bj][m][1];
                v0[0] *= bflo(g.x); v0[1] *= bfhi(g.x); v0[2] *= bflo(g.y); v0[3] *= bfhi(g.y); v1[0] *= bflo(g.z); v1[1] *= bfhi(g.z); v1[2] *= bflo(g.w); v1[3] *= bfhi(g.w);
                *(u32x4*)(O + off + bj * HALF) = pack8(v0, v1);
            }
        }
        asm volatile("" ::: "memory");
    }
};
struct EpiResid {
    static constexpr bool PERM = false, MID = false;
    const float* X; float* V; float alpha;
    __device__ __forceinline__ void operator()(const f32x4 (&acc)[2][2][4][2], const Unit& u, int wr, int wc, int fr, int fq) const {
        const int row0 = u.pm * BM + wr * 64 + fr, col0 = u.pn * BM + wc * 32 + 4 * fq;
#pragma unroll
        for (int ai = 0; ai < 2; ++ai) {
            f32x4 xv[4][2][2];
#pragma unroll
            for (int m = 0; m < 4; ++m)
#pragma unroll
                for (int bj = 0; bj < 2; ++bj)
#pragma unroll
                    for (int n = 0; n < 2; ++n) xv[m][bj][n] = *(const f32x4*)(X + (size_t)(row0 + ai * HALF + m * 16) * 1024 + col0 + bj * HALF + n * 16);
            asm volatile("" ::: "memory");
#pragma unroll
            for (int m = 0; m < 4; ++m)
#pragma unroll
                for (int bj = 0; bj < 2; ++bj)
#pragma unroll
                    for (int n = 0; n < 2; ++n) *(f32x4*)(V + (size_t)(row0 + ai * HALF + m * 16) * 1024 + col0 + bj * HALF + n * 16) = xv[m][bj][n] * alpha + acc[ai][bj][m][n];
            asm volatile("" ::: "memory");
        }
    }
};
__device__ __forceinline__ f32x4 swiglu4(f32x4 g, f32x4 u) {
    f32x4 gt, up, sg;
#pragma unroll
    for (int e = 0; e < 4; ++e) { gt[e] = fminf(g[e], 7.0f); up[e] = fminf(fmaxf(u[e], -7.0f), 7.0f); }
    const f32x4 ea = gt * (-1.702f * 1.44269504088896341f);
#pragma unroll
    for (int e = 0; e < 4; ++e) sg[e] = __builtin_amdgcn_exp2f(ea[e]);
    sg = sg + 1.0f;
#pragma unroll
    for (int e = 0; e < 4; ++e) sg[e] = __builtin_amdgcn_rcpf(sg[e]);
    const f32x4 as4 = (f32x4){I8_AS, I8_AS, I8_AS, I8_AS};
    return (gt * sg) * __builtin_elementwise_fma(up, as4, as4);
}
struct EpiSwigluI8 {
    static constexpr bool PERM = true, MID = false;
    const float* bgu; const float* rows; unsigned char* ACT;
    __device__ __forceinline__ void operator()(const f32x4 (&acc)[2][2][4][2], const Unit& u, int wr, int wc, int fr, int fq) const {
        const int row0 = u.pm * BM + wr * 64 + fr, cin = wc * 32 + 8 * fq, col0 = u.pn * HALF + cin;
        const float* bb = bgu + (size_t)u.aux * 2048 + col0;
        const f32x4 bg0 = *(const f32x4*)(bb), bg1 = *(const f32x4*)(bb + 4), bu0 = *(const f32x4*)(bb + 1024), bu1 = *(const f32x4*)(bb + 1028);
        float rsv[2][4];
#pragma unroll
        EPI_LOOP_ROWS rsv[ai][m] = rows[row0 + ai * HALF + m * 16];
        asm volatile("" ::: "memory");
#pragma unroll
        EPI_LOOP_ROWS {
            const int row = row0 + ai * HALF + m * 16; const float rs = rsv[ai][m] * (1.0f / I8_WS_GU);
            const f32x4 rs4 = (f32x4){rs, rs, rs, rs};
            const f32x4 o0 = swiglu4(__builtin_elementwise_fma(i2f4(acc[ai][0][m][0]), rs4, bg0), __builtin_elementwise_fma(i2f4(acc[ai][1][m][0]), rs4, bu0));
            const f32x4 o1 = swiglu4(__builtin_elementwise_fma(i2f4(acc[ai][0][m][1]), rs4, bg1), __builtin_elementwise_fma(i2f4(acc[ai][1][m][1]), rs4, bu1));
            u32x2 w; w.x = pack4_i8(o0[0], o0[1], o0[2], o0[3]); w.y = pack4_i8(o1[0], o1[1], o1[2], o1[3]);
            *(u32x2*)(ACT + (size_t)row * 1024 + col0) = w;
        }
        asm volatile("" ::: "memory");
    }
};
struct EpiDownI8 {
    static constexpr bool PERM = true, MID = false;
    const float* bdn; const float* rowg; bf16* YR;
    __device__ __forceinline__ void operator()(const f32x4 (&acc)[2][2][4][2], const Unit& u, int wr, int wc, int fr, int fq) const {
        const int row0 = u.pm * BM + wr * 64 + fr, col0 = u.pn * BM + wc * 32 + 8 * fq;
        const float* bp = bdn + (size_t)u.aux * 1024 + col0;
        constexpr float rs = 1.0f / (I8_AS * I8_WS_DN);
        f32x4 bv[2][2]; float gv[2][4];
#pragma unroll
        for (int bj = 0; bj < 2; ++bj) { bv[bj][0] = *(const f32x4*)(bp + bj * HALF); bv[bj][1] = *(const f32x4*)(bp + bj * HALF + 4); }
#pragma unroll
        EPI_LOOP_ROWS gv[ai][m] = rowg[row0 + ai * HALF + m * 16];
        asm volatile("" ::: "memory");
#pragma unroll
        EPI_LOOP_ROWS {
            const int row = row0 + ai * HALF + m * 16; const float gt = gv[ai][m];
#pragma unroll
            for (int bj = 0; bj < 2; ++bj)
                *(u32x4*)(YR + (size_t)row * 1024 + col0 + bj * HALF) = pack8((i2f4(acc[ai][bj][m][0]) * rs + bv[bj][0]) * gt, (i2f4(acc[ai][bj][m][1]) * rs + bv[bj][1]) * gt);
        }
        asm volatile("" ::: "memory");
    }
};
struct EpiPleGateI8 {
    static constexpr bool PERM = true, MID = false;
    const bf16* P; const float* rows; bf16* O;
    __device__ __forceinline__ void operator()(const f32x4 (&acc)[2][2][4][2], const Unit& u, int wr, int wc, int fr, int fq) const {
        const int row0 = u.pm * BM + wr * 64 + fr, col0 = u.pn * BM + wc * 32 + 8 * fq;
        float rsv[2][4];
#pragma unroll
        EPI_LOOP_ROWS rsv[ai][m] = rows[row0 + ai * HALF + m * 16];
#pragma unroll
        for (int ai = 0; ai < 2; ++ai) {
            u32x4 gq[4][2];
#pragma unroll
            for (int m = 0; m < 4; ++m)
#pragma unroll
                for (int bj = 0; bj < 2; ++bj) gq[m][bj] = *(const u32x4*)(P + (size_t)(row0 + ai * HALF + m * 16) * 1024 + col0 + bj * HALF);
            asm volatile("" ::: "memory");
#pragma unroll
            for (int m = 0; m < 4; ++m) {
                const int row = row0 + ai * HALF + m * 16; const size_t off = (size_t)row * 1024 + col0; const float rs = rsv[ai][m] * (1.0f / I8_WS_GU);
#pragma unroll
                for (int bj = 0; bj < 2; ++bj) {
                    const u32x4 g = gq[m][bj];
                    f32x4 v0 = i2f4(acc[ai][bj][m][0]) * rs, v1 = i2f4(acc[ai][bj][m][1]) * rs;
                    v0[0] = sigmoidf_(v0[0]) * bflo(g.x); v0[1] = sigmoidf_(v0[1]) * bfhi(g.x); v0[2] = sigmoidf_(v0[2]) * bflo(g.y); v0[3] = sigmoidf_(v0[3]) * bfhi(g.y);
                    v1[0] = sigmoidf_(v1[0]) * bflo(g.z); v1[1] = sigmoidf_(v1[1]) * bfhi(g.z); v1[2] = sigmoidf_(v1[2]) * bflo(g.w); v1[3] = sigmoidf_(v1[3]) * bfhi(g.w);
                    *(u32x4*)(O + off + bj * HALF) = pack8(v0, v1);
                }
            }
            asm volatile("" ::: "memory");
        }
    }
};
struct EpiSwigluPle {
    static constexpr bool PERM = true, MID = false;
    EpiSwigluI8 moe; EpiPleGateI8 ple;
    __device__ __forceinline__ void operator()(const f32x4 (&acc)[2][2][4][2], const Unit& u, int wr, int wc, int fr, int fq) const { if (u.aux >= 0) moe(acc, u, wr, wc, fr, fq); else ple(acc, u, wr, wc, fr, fq); }
};
struct EpiDownPle {
    static constexpr bool PERM = true, MID = false;
    EpiDownI8 moe; EpiPleGateI8 ple;
    __device__ __forceinline__ void operator()(const f32x4 (&acc)[2][2][4][2], const Unit& u, int wr, int wc, int fr, int fq) const { if (u.aux >= 0) moe(acc, u, wr, wc, fr, fq); else ple(acc, u, wr, wc, fr, fq); }
};
#undef EPI_LOOP_ROWS
}

constexpr size_t MiB = 1u << 20;
constexpr size_t WS_CTL = 0, CTL_ZERO_BYTES = 1 * MiB;
constexpr int CW_BAR = 4096;
constexpr size_t LW_WIN = 0, LW_WUPA = 8 * MiB, LW_WUPB = 9 * MiB, LW_POOL = 10 * MiB, LW_WOUT = 11 * MiB, LW_PLEG = 13 * MiB, LW_PLEP = 15 * MiB, LW_WGU = 16 * MiB, LW_WDN = 144 * MiB, LW_SIZE = 208 * MiB;
constexpr size_t WS_W = 1 * MiB;
constexpr size_t WS_ROPE = WS_W + DEPTH * LW_SIZE;
constexpr size_t WS_PB16 = WS_ROPE + 1 * MiB;
constexpr size_t WS_XF = WS_PB16 + 16 * MiB;
constexpr size_t WS_XB = WS_XF + 64 * MiB;
constexpr size_t WS_Q = WS_XB + 32 * MiB;
constexpr size_t WS_KV = WS_Q + 16 * MiB;
constexpr size_t WS_QI = WS_KV + 8 * MiB;
constexpr size_t WS_KI = WS_QI + 16 * MiB;
constexpr size_t WS_WI = WS_KI + 2 * MiB;
constexpr size_t WS_U = WS_WI + 1 * MiB;
constexpr size_t WS_SGA = WS_U + 16 * MiB;
constexpr size_t WS_SGB = WS_SGA + 32 * MiB;
constexpr size_t WS_YAYP = WS_SGB + 32 * MiB;
constexpr size_t WS_DP = WS_YAYP + 32 * MiB;
constexpr size_t WS_T1 = WS_DP + 16 * MiB;
constexpr size_t WS_MRG = WS_T1 + 64 * MiB;
constexpr size_t WS_X1F = WS_MRG + 32 * MiB;
constexpr size_t WS_X1B = WS_X1F + 64 * MiB;
constexpr size_t WS_XS = WS_X1B + 32 * MiB;
constexpr size_t WS_ACT = WS_XS + 144 * MiB;
constexpr size_t WS_YR = WS_ACT + 144 * MiB;
constexpr size_t WS_PLEP = WS_YR + 144 * MiB;
constexpr size_t WS_PLEV = WS_PLEP + 32 * MiB;
constexpr size_t WS_ROUTE = WS_PLEV + 32 * MiB;
constexpr size_t RT_TOPI = 0, RT_GATE = 256 * 1024, RT_LRANK = 512 * 1024, RT_TOKROW = 768 * 1024, RT_ROWG = 1024 * 1024, RT_HIST = 1536 * 1024, RT_TILE = 1664 * 1024, RT_ROWS = 1700 * 1024, RT_X1S = 1472 * 1024, RT_XQS = 1988 * 1024;
constexpr size_t WS_END = WS_ROUTE + 3 * MiB;
static_assert((size_t)RMAX * 1024 * 2 == 144 * MiB, "row buffers");
static_assert(RT_ROWG + (size_t)RMAX * 4 <= RT_X1S && RT_X1S + (size_t)M * 4 <= RT_HIST && RT_HIST + (size_t)DEPTH * 256 * 32 * 4 <= RT_TILE && RT_ROWS + (size_t)RMAX * 4 <= RT_XQS, "routing map");

constexpr int RING_BYTES = 131072;
constexpr int XTRA_OFF = RING_BYTES;
constexpr int XTRA_BYTES = 24576;
constexpr int MISC_OFF = XTRA_OFF + XTRA_BYTES;
constexpr int LDS_BYTES = MISC_OFF + 4096;
constexpr int NWAVES = 8;

#define XB_TMO      128
#define XB_XCNT(j)  (256  + 64 * (j))
#define XB_XSUB(j)  (1280 + 64 * (j))
#define XB_XGEN(j)  (2304 + 64 * (j))
#define XB_TOP      3328
#define XB_TOPGEN   3392
#define XCD_BAR_WORDS 3456
#define XB_SPIN_CAP (1u << 18)

__device__ __forceinline__ unsigned xb_ld(unsigned* p)              { return __hip_atomic_load(p, __ATOMIC_RELAXED, __HIP_MEMORY_SCOPE_AGENT); }
__device__ __forceinline__ unsigned xb_add(unsigned* p, unsigned v) { return __hip_atomic_fetch_add(p, v, __ATOMIC_RELAXED, __HIP_MEMORY_SCOPE_AGENT); }
__device__ __forceinline__ unsigned xb_xcc_id() { return (unsigned)__builtin_amdgcn_s_getreg((3 << 11) | 20) & 0xFu; }
#define XB_SPIN(cond, bar) do { unsigned _sp = 0; while (cond) { __builtin_amdgcn_s_sleep(1); \
    if ((++_sp & 255u) == 0u) { if (xb_ld(&(bar)[XB_TMO])) break; if (_sp > XB_SPIN_CAP) { atomicAdd(&(bar)[XB_TMO], 1u); break; } } } } while (0)

struct XcdBarrier {
    unsigned* bar; unsigned x;
    volatile LAS unsigned* st;
};

__device__ __forceinline__ XcdBarrier xcd_barrier_post(unsigned* bar, volatile LAS unsigned* st) {
    XcdBarrier b; b.bar = bar; b.x = xb_xcc_id(); b.st = st;
    if (threadIdx.x == 0) (void)xb_add(&bar[XB_XCNT(b.x)], 1u);
    return b;
}
__device__ __forceinline__ void xcd_barrier_complete(unsigned* bar, unsigned x, unsigned& nloc, unsigned& nx) {
    const unsigned G = gridDim.x * gridDim.y * gridDim.z;
    unsigned sum, cnt, mine, sp = 0u;
    for (;;) {
        sum = 0u; cnt = 0u; mine = 0u;
#pragma unroll
        for (unsigned j = 0; j < 16; ++j) { const unsigned c = xb_ld(&bar[XB_XCNT(j)]); sum += c; cnt += (c > 0u) ? 1u : 0u; mine = (j == x) ? c : mine; }
        if (sum == G) break;
        __builtin_amdgcn_s_sleep(1);
        if ((++sp & 255u) == 0u) { if (xb_ld(&bar[XB_TMO])) break; if (sp > XB_SPIN_CAP) { atomicAdd(&bar[XB_TMO], 1u); break; } }
    }
    nloc = mine > 0u ? mine : 1u; nx = cnt > 0u ? cnt : 1u;
}

__device__ __forceinline__ void xcd_barrier(const XcdBarrier& b) {
    asm volatile("s_waitcnt vmcnt(0)" ::: "memory");
    __syncthreads();
    if (threadIdx.x == 0) {
        unsigned* bar = b.bar; { size_t zo_ = 0; asm volatile("" : "+s"(zo_)); bar += zo_; }
        __builtin_amdgcn_s_waitcnt(0);
        unsigned bx = b.x; asm volatile("" : "+s"(bx));
        unsigned nloc = b.st[0], nx = b.st[1];
        if (nloc == 0u) { xcd_barrier_complete(bar, bx, nloc, nx); b.st[0] = nloc; b.st[1] = nx; }
        const unsigned old = xb_add(&bar[XB_XSUB(bx)], 1u);
        const unsigned gen = old / nloc;
        if (old + 1u == (gen + 1u) * nloc) {
            __builtin_amdgcn_fence(__ATOMIC_RELEASE, "agent");
            asm volatile("s_waitcnt vmcnt(0)" ::: "memory");
            const unsigned og = xb_add(&bar[XB_TOP], 1u);
            const unsigned tg = og / nx;
            if (og + 1u == (tg + 1u) * nx) xb_add(&bar[XB_TOPGEN], 1u);
            else XB_SPIN(xb_ld(&bar[XB_TOPGEN]) == tg, bar);
            __builtin_amdgcn_fence(__ATOMIC_ACQUIRE, "agent");
            xb_add(&bar[XB_XGEN(bx)], 1u);
            asm volatile("s_waitcnt vmcnt(0)" ::: "memory");
        } else {
            XB_SPIN(xb_ld(&bar[XB_XGEN(bx)]) == gen, bar);
            __builtin_amdgcn_fence(__ATOMIC_ACQUIRE, "agent");
            asm volatile("s_waitcnt vmcnt(0)" ::: "memory");
        }
    }
    __syncthreads();
}


template <int CTRL> __device__ __forceinline__ float dppx(float v) { return __builtin_bit_cast(float, __builtin_amdgcn_update_dpp(0, __builtin_bit_cast(int, v), CTRL, 0xf, 0xf, false)); }
__device__ __forceinline__ float wave_sum(float v, int) { v += dppx<0xB1>(v); v += dppx<0x4E>(v); v += dppx<0x141>(v); v += dppx<0x140>(v); v += shx<16>(v); return sum32(v); }
__device__ __forceinline__ float wave_max(float v, int) { v = fmaxf(v, dppx<0xB1>(v)); v = fmaxf(v, dppx<0x4E>(v)); v = fmaxf(v, dppx<0x141>(v)); v = fmaxf(v, dppx<0x140>(v)); v = fmaxf(v, shx<16>(v)); return max32(v); }
__device__ __forceinline__ float wave_min(float v, int) { v = fminf(v, dppx<0xB1>(v)); v = fminf(v, dppx<0x4E>(v)); v = fminf(v, dppx<0x141>(v)); v = fminf(v, dppx<0x140>(v)); v = fminf(v, shx<16>(v)); return min32(v); }
struct MapId { __device__ __forceinline__ int operator()(int n) const { return n; } };
struct MapWin { __device__ __forceinline__ int operator()(int n) const {
    if (n < 512) return n;
    if (n < 768) return n;
    if (n < 1352) return n;
    if (n < 1536) return -1;
    if (n < 2048) return 1352 + (n - 1536);
    if (n < 3072) return 1864 + (n - 2048);
    return 2888 + (n - 3072); } };
struct MapGU { __device__ __forceinline__ int operator()(int n) const { const int t = n >> 8, w = n & 255; return w < 128 ? t * 128 + w : 1024 + t * 128 + (w - 128); } };

__device__ __forceinline__ void ln_regs(f32x4 (&v)[4], const float* g, const float* b, int lane) {
    float s = 0.f;
#pragma unroll
    for (int j = 0; j < 4; ++j) s += (v[j].x + v[j].y) + (v[j].z + v[j].w);
    const float mean = wave_sum(s, lane) * (1.f / D); float s2 = 0.f;
#pragma unroll
    for (int j = 0; j < 4; ++j) { v[j] = v[j] - mean; s2 += (v[j].x * v[j].x + v[j].y * v[j].y) + (v[j].z * v[j].z + v[j].w * v[j].w); }
    const float rstd = 1.f / sqrtf(wave_sum(s2, lane) * (1.f / D) + LN_EPS);
#pragma unroll
    for (int j = 0; j < 4; ++j) { const f32x4 gg = *(const f32x4*)(g + 4 * lane + 256 * j), bb = *(const f32x4*)(b + 4 * lane + 256 * j); v[j] = v[j] * rstd * gg + bb; }
}
__device__ __forceinline__ void store_row_f32(float* row, const f32x4 (&v)[4], int lane) {
#pragma unroll
    for (int j = 0; j < 4; ++j) *(f32x4*)(row + 4 * lane + 256 * j) = v[j];
}
__device__ __forceinline__ void store_row_i8(unsigned char* row, float* scale_out, const f32x4 (&v)[4], int lane) {
    float mx = 0.f;
#pragma unroll
    for (int j = 0; j < 4; ++j) mx = fmaxf(fmaxf(mx, fmaxf(fabsf(v[j].x), fabsf(v[j].y))), fmaxf(fabsf(v[j].z), fabsf(v[j].w)));
    mx = fmaxf(wave_max(mx, lane), 1e-20f); const float inv = 127.0f / mx;
    if (lane == 0) *scale_out = mx * (1.0f / 127.0f);
#pragma unroll
    for (int j = 0; j < 4; ++j) *(unsigned*)(row + 4 * lane + 256 * j) = pack4_i8(v[j].x * inv, v[j].y * inv, v[j].z * inv, v[j].w * inv);
}
__device__ __forceinline__ void store_row_bf16(bf16* row, const f32x4 (&v)[4], int lane) {
#pragma unroll
    for (int j = 0; j < 4; ++j) { u32x2 w; w.x = pk2(v[j].x, v[j].y); w.y = pk2(v[j].z, v[j].w); *(u32x2*)(row + 4 * lane + 256 * j) = w; }
}

typedef __bf16 bf16x2_t __attribute__((ext_vector_type(2)));
typedef short v4i16_t __attribute__((ext_vector_type(4)));
typedef int v2i32_t __attribute__((ext_vector_type(2)));
typedef short s16x4_t __attribute__((ext_vector_type(4)));
__device__ __forceinline__ float dot2bf(unsigned a, unsigned b, float c) { return __builtin_amdgcn_fdot2_f32_bf16(__builtin_bit_cast(bf16x2_t, a), __builtin_bit_cast(bf16x2_t, b), c, false); }

__device__ __forceinline__ int score_bin(float v, float vmin, float scale) { const int b = (int)((v - vmin) * scale); return b > 511 ? 511 : b; }

__device__ __forceinline__ void attn_unit(LAS unsigned char* lds, const int wave, const int lane_in, const int b, const int t0,
                                          const bf16* QI, const bf16* KI, const float* WI, const bf16* Q, const bf16* KV, bf16* YAYP) {
    int lane = lane_in; asm volatile("" : "+v"(lane));
    const int m0 = b * SEQ + t0;
    const int r = lane & 31, h = lane >> 5;
    const int qit = 2 * ((r >> 2) & 1) + (r >> 4), hd = (r & 3) + 4 * ((r >> 3) & 1);
    bf16x8 Af[4][4];
#pragma unroll
    for (int mt = 0; mt < 4; ++mt)
#pragma unroll
        for (int ks = 0; ks < 4; ++ks) Af[mt][ks] = *(const bf16x8*)(QI + (size_t)(m0 + 4 * mt + qit) * 512 + hd * 64 + 16 * ks + 8 * h);
    f32x4 wv[4][2][2];
#pragma unroll
    for (int mt = 0; mt < 4; ++mt)
#pragma unroll
        for (int qq = 0; qq < 2; ++qq) { const float* wp = WI + (size_t)(m0 + 4 * mt + 2 * h + qq) * 8; wv[mt][qq][0] = *(const f32x4*)wp; wv[mt][qq][1] = *(const f32x4*)(wp + 4); }
    for (int rep2_ = 0; rep2_ < (ATT_PROBE == 1 ? 2 : 1); ++rep2_) {
    const int nkt = (t0 + 16 + 31) >> 5;
    LAS _Float16* SCH = (LAS _Float16*)lds;
    const bf16* kib = KI + (size_t)b * SEQ * 64;
#pragma unroll 1
    for (int kt0 = wave; kt0 < nkt; kt0 += 32) {
        bf16x8 Bq[4][4];
#pragma unroll
        for (int u = 0; u < 4; ++u) {
            if (kt0 + 8 * u < nkt) {
#pragma unroll
                for (int ks = 0; ks < 4; ++ks) Bq[u][ks] = *(const bf16x8*)(kib + ((size_t)((kt0 + 8 * u) * 4 + ks) * 64 + lane) * 8);
            }
        }
#pragma unroll
        for (int u = 0; u < 4; ++u) {
            if (kt0 + 8 * u < nkt) {
                const int key = 32 * (kt0 + 8 * u) + r;
#pragma unroll
                for (int mt = 0; mt < 4; ++mt) {
                    f32x16 acc;
#pragma unroll
                    for (int i = 0; i < 16; ++i) acc[i] = 0.f;
#pragma unroll
                    for (int ks = 0; ks < 4; ++ks) acc = __builtin_amdgcn_mfma_f32_32x32x16_bf16(Af[mt][ks], Bq[u][ks], acc, 0, 0, 0);
                    float s0 = 0.f, s1 = 0.f;
#pragma unroll
                    for (int i = 0; i < 8; ++i) { s0 += fmaxf(acc[i], 0.f) * wv[mt][0][i >> 2][i & 3]; s1 += fmaxf(acc[8 + i], 0.f) * wv[mt][1][i >> 2][i & 3]; }
                    const int qa = 4 * mt + 2 * h;
                    SCH[qa * 4096 + key] = (_Float16)s0; SCH[(qa + 1) * 4096 + key] = (_Float16)s1;
                }
            }
        }
    }
    }
    __syncthreads();
    asm volatile("" : "+v"(lane));
    LAS unsigned* HIST = (LAS unsigned*)(lds + XTRA_OFF + wave * 2048);
#pragma unroll 1
    for (int qs3_ = 0; qs3_ < 2 * (ATT_PROBE == 2 ? 2 : 1); ++qs3_) {
    asm volatile("" : "+v"(lane));
    const int qi = 2 * wave + (qs3_ & 1);
    const LAS _Float16* SCw = (const LAS _Float16*)lds + qi * 4096;
    LAS unsigned short* SEL = (LAS unsigned short*)(lds + XTRA_OFF + 16384 + wave * 1024 + (qs3_ & 1) * 512);
    const int n = t0 + qi + 1;
    const unsigned long long ltmask = (1ull << lane) - 1ull;
    {
    if (n <= NSEL) {
        for (int i = lane; i < NSEL; i += 64) SEL[i] = (unsigned short)(i < n ? i : 0);
    } else {
        const int nj = (n + 63) >> 6;
        float sv[64]; float vmax = -INFINITY, vmin = INFINITY;
#pragma unroll
        for (int gq = 0; gq < 8; ++gq) {
            if (512 * (gq + 1) <= n) {
#pragma unroll
                for (int jj = 0; jj < 8; ++jj) { const int j = 8 * gq + jj; const float v = (float)SCw[64 * j + lane]; sv[j] = v; vmax = fmaxf(vmax, v); vmin = fminf(vmin, v); }
            } else if (512 * gq < n) {
#pragma unroll
                for (int jj = 0; jj < 8; ++jj) { const int j = 8 * gq + jj; const float v = (float)SCw[64 * j + lane]; const bool in = 64 * j + lane < n;
                    sv[j] = in ? v : -INFINITY; vmax = fmaxf(vmax, sv[j]); vmin = fminf(vmin, in ? v : INFINITY); }
            } else {
#pragma unroll
                for (int jj = 0; jj < 8; ++jj) sv[8 * gq + jj] = -INFINITY;
            }
        }
        vmax = wave_max(vmax, lane); vmin = wave_min(vmin, lane);
        const float range = vmax - vmin, scale = range > 0.f ? 512.0f / range : 0.f;
#pragma unroll
        for (int i = 0; i < 8; ++i) HIST[lane * 8 + i] = 0u;
        WAVE_FENCE();
        int ba[64];
#pragma unroll
        for (int gq = 0; gq < 8; ++gq) {
            if (512 * (gq + 1) <= n) {
#pragma unroll
                for (int jj = 0; jj < 8; ++jj) { const int j = 8 * gq + jj; const int bq = score_bin(sv[j], vmin, scale); ba[j] = bq * 4;
                    __hip_atomic_fetch_add(HIST + bq, 1u, __ATOMIC_RELAXED, __HIP_MEMORY_SCOPE_WORKGROUP); }
            } else if (512 * gq < n) {
#pragma unroll
                for (int jj = 0; jj < 8; ++jj) { const int j = 8 * gq + jj; const bool in = 64 * j + lane < n; const int bq = in ? score_bin(sv[j], vmin, scale) : 0; ba[j] = in ? bq * 4 : -4;
                    if (in) __hip_atomic_fetch_add(HIST + bq, 1u, __ATOMIC_RELAXED, __HIP_MEMORY_SCOPE_WORKGROUP); }
            } else {
#pragma unroll
                for (int jj = 0; jj < 8; ++jj) ba[8 * gq + jj] = -4;
            }
        }
        WAVE_FENCE();
        unsigned wds[8]; unsigned sl = 0u;
#pragma unroll
        for (int i = 0; i < 8; ++i) { wds[i] = HIST[lane * 8 + i]; sl += wds[i]; }
        unsigned T = sl;
#pragma unroll
        for (int off = 1; off < 64; off <<= 1) { const unsigned o = (unsigned)__builtin_amdgcn_ds_bpermute((lane + off) << 2, (int)T); if (lane + off < 64) T += o; }
        const unsigned E = T - sl;
        int tb = 0; unsigned cab = 0u, ctb = 0u;
        { unsigned run = E; bool found = false;
#pragma unroll
          for (int bb = 7; bb >= 0; --bb) { const unsigned c = wds[bb];
              if (!found) { if (run + c >= (unsigned)NSEL) { found = true; tb = lane * 8 + bb; cab = run; ctb = c; } else run += c; } } }
        const unsigned long long bal = __ballot(E < (unsigned)NSEL && T >= (unsigned)NSEL);
        const int L = __ffsll((long long)bal) - 1;
        tb = __builtin_amdgcn_readlane(tb, L); cab = (unsigned)__builtin_amdgcn_readlane((int)cab, L); ctb = (unsigned)__builtin_amdgcn_readlane((int)ctb, L);
        const int need = NSEL - (int)cab;
        const int tb4 = tb * 4;
        WAVE_FENCE();
        LAS float* CVAL = (LAS float*)HIST; LAS int* CKEY = (LAS int*)(HIST + 256);
        unsigned pc = 0u;
#pragma unroll
        for (int j = 0; j < 64; ++j) pc += (ba[j] > tb4 ? 1u : 0u) + (ba[j] == tb4 ? 65536u : 0u);
        unsigned pi = pc;
#pragma unroll
        for (int off = 1; off < 64; off <<= 1) { const unsigned o = (unsigned)__builtin_amdgcn_ds_bpermute((lane - off) << 2, (int)pi); if (lane >= off) pi += o; }
        pi -= pc;
        const bool docand = ctb <= 256u;
        int tb4c = tb4; asm volatile("" : "+s"(tb4c));
        LAS unsigned char* dummy = lds + MISC_OFF + 1024 + wave * 256 + lane * 4;
        unsigned os = (pi & 0xffffu) * 2u, oc = (pi >> 16) * 4u;
        LAS unsigned char* selb = (LAS unsigned char*)SEL; LAS unsigned char* ckb = (LAS unsigned char*)CKEY;
#pragma unroll
        for (int gq = 0; gq < 8; ++gq) {
            if (512 * gq < n) {
#pragma unroll
                for (int jj = 0; jj < 8; ++jj) { const int j = 8 * gq + jj; const int key = 64 * j + lane;
                    const bool isel = ba[j] > tb4c;
                    *(LAS unsigned short*)(isel ? selb + os : dummy) = (unsigned short)key; os += isel ? 2u : 0u;
                    if (docand) { const bool ic = ba[j] == tb4c;
                        *(LAS int*)(ic ? ckb + oc : dummy) = key; oc += ic ? 4u : 0u; } }
            }
        }
        int nsel = (int)cab; const int ncand = (int)ctb;
        WAVE_FENCE();
        if (docand) for (int i = lane; i < ncand; i += 64) CVAL[i] = (float)SCw[CKEY[i]];
        (void)nj;
        WAVE_FENCE();
        if (ncand <= 256) {
            for (int c0 = 0; c0 < ncand; c0 += 64) {
                const int i = c0 + lane; const bool act = i < ncand; const float vi = act ? CVAL[i] : 0.f; const int ki = act ? CKEY[i] : 0;
                int rank = 0;
                for (int jj = 0; jj < ncand; ++jj) { const float vj = CVAL[jj]; const int kj = CKEY[jj]; rank += (vj > vi || (vj == vi && kj < ki)) ? 1 : 0; }
                const bool take = act && rank < need; const unsigned long long ms = __ballot(take);
                if (take) SEL[nsel + __popcll(ms & ltmask)] = (unsigned short)ki;
                nsel += __popcll(ms);
            }
        } else {
            for (int j = 0; j < nj; ++j) {
                const int key = 64 * j + lane; const bool in = key < n; const float v = in ? (float)SCw[key] : 0.f; const bool ic = in && score_bin(v, vmin, scale) == tb;
                if (__ballot(ic) == 0ull) continue;
                int rank = 0;
                for (int jj = 0; jj < n; ++jj) { const float vj = (float)SCw[jj]; rank += (score_bin(vj, vmin, scale) == tb && (vj > v || (vj == v && jj < key))) ? 1 : 0; }
                const bool take = ic && rank < need; const unsigned long long ms = __ballot(take);
                if (take) SEL[nsel + __popcll(ms & ltmask)] = (unsigned short)key;
                nsel += __popcll(ms);
            }
        }
    }
    WAVE_FENCE();
    }
    }
    asm volatile("" : "+v"(lane));
#pragma unroll 1
    for (int qs4_ = 0; qs4_ < 2 * (ATT_PROBE == 3 ? 2 : 1); ++qs4_) {
    asm volatile("" : "+v"(lane));
    const int qi = 2 * wave + (qs4_ & 1);
    const LAS unsigned short* SEL = (const LAS unsigned short*)(lds + XTRA_OFF + 16384 + wave * 1024 + (qs4_ & 1) * 512);
    const int n = t0 + qi + 1, cnt = n < NSEL ? n : NSEL;
    const int m = m0 + qi;
    LAS unsigned char* RING = lds + wave * 16384;
    const char* kvb = (const char*)KV + (size_t)b * SEQ * 256;
    const int li = lane & 15, kq = lane >> 4;
    long qb[2][2];
#pragma unroll
    for (int c = 0; c < 2; ++c)
#pragma unroll
        for (int ks = 0; ks < 2; ++ks) { qb[c][ks] = 0;
            if (li < 4) { const u32x4 w = *(const u32x4*)(Q + (size_t)m * 512 + (4 * c + li) * 64 + 32 * ks + 8 * kq);
                const unsigned lo = pack4_fp8(bflo(w.x), bfhi(w.x), bflo(w.y), bfhi(w.y)), hi = pack4_fp8(bflo(w.z), bfhi(w.z), bflo(w.w), bfhi(w.w));
                qb[c][ks] = (long)(((unsigned long long)hi << 32) | lo); } }
    int koff[2][2];
#pragma unroll
    for (int c = 0; c < 2; ++c)
#pragma unroll
        for (int ks = 0; ks < 2; ++ks) koff[c][ks] = li * 128 + (((4 * c + 2 * ks + (kq >> 1)) ^ ((li >> 1) & 7)) << 4) + 8 * (kq & 1);
    const int tq = li >> 1, tp = li & 1, rowv = 16 * (tq >> 2) + 4 * kq + (tq & 3);
    int voff[2][4];
#pragma unroll
    for (int c = 0; c < 2; ++c)
#pragma unroll
        for (int dt = 0; dt < 4; ++dt) voff[c][dt] = rowv * 128 + (((4 * c + dt) ^ ((rowv >> 1) & 7)) << 4) + 8 * tp;
    const int r8 = lane >> 3, c16 = lane & 7;
    unsigned dsw[4];
#pragma unroll
    for (int j = 0; j < 4; ++j) dsw[j] = (unsigned)((c16 ^ ((4 * j + (r8 >> 1)) & 7)) << 4);
#define ATT_KEYS(s_) (*(const LAS u32x2*)(SEL + 32 * ((s_) & 7) + 4 * r8))
#define ATT_ISSUE(s_, kk_) do { const unsigned part_ = (((s_) & 15) >> 3) * 128u; \
        _Pragma("unroll") for (int j_ = 0; j_ < 4; ++j_) { const unsigned key_ = (((j_ & 2) ? (kk_).y : (kk_).x) >> ((j_ & 1) * 16)) & 0xffffu; \
            __builtin_amdgcn_global_load_lds((const unsigned*)(kvb + (size_t)key_ * 256 + part_ + dsw[j_]), (LAS unsigned*)(RING + ((s_) & 3) * 4096 + j_ * 1024), 16, 0, 0); } } while (0)
    { const u32x2 k0 = ATT_KEYS(0), k1 = ATT_KEYS(1), k2 = ATT_KEYS(2); ATT_ISSUE(0, k0); ATT_ISSUE(1, k1); ATT_ISSUE(2, k2); }
    u32x2 kk = ATT_KEYS(3);
    f32x4 lgs[8][2][2];
#pragma unroll
    for (int s = 0; s < 8; ++s) {
        ATT_ISSUE(s + 3, kk);
        kk = ATT_KEYS(s + 4);
        asm volatile("s_waitcnt vmcnt(12)" ::: "memory");
        const LAS unsigned char* slot = RING + (s & 3) * 4096;
#pragma unroll
        for (int T = 0; T < 2; ++T)
#pragma unroll
            for (int c = 0; c < 2; ++c) {
                f32x4 acc = (f32x4){0.f, 0.f, 0.f, 0.f};
#pragma unroll
                for (int ks = 0; ks < 2; ++ks) acc = __builtin_amdgcn_mfma_f32_16x16x32_fp8_fp8(*(const LAS long*)(slot + T * 2048 + koff[c][ks]), qb[c][ks], acc, 0, 0, 0);
#pragma unroll
                for (int i = 0; i < 4; ++i) acc[i] = (32 * s + 16 * (kq & 1) + 4 * i + 2 * T + (kq >> 1) < cnt) ? acc[i] : -INFINITY;
                lgs[s][T][c] = acc;
            }
        asm volatile("s_waitcnt lgkmcnt(0)" ::: "memory");
    }
    float inv[2];
#pragma unroll
    for (int c = 0; c < 2; ++c) {
        float mx = -INFINITY;
#pragma unroll
        for (int s = 0; s < 8; ++s)
#pragma unroll
            for (int T = 0; T < 2; ++T) mx = fmaxf(fmaxf(mx, fmaxf(lgs[s][T][c][0], lgs[s][T][c][1])), fmaxf(lgs[s][T][c][2], lgs[s][T][c][3]));
        mx = fmaxf(mx, shx<16>(mx)); mx = max32(mx);
        const float mxs = mx * 0.18033688011112042f;
        float sm = 0.f;
#pragma unroll
        for (int s = 0; s < 8; ++s)
#pragma unroll
            for (int T = 0; T < 2; ++T)
#pragma unroll
                for (int i = 0; i < 4; ++i) { const float p = __builtin_amdgcn_exp2f(lgs[s][T][c][i] * 0.18033688011112042f - mxs); lgs[s][T][c][i] = p; sm += p; }
        sm += shx<16>(sm); sm = sum32(sm);
        inv[c] = 1.0f / sm;
    }
    f32x4 o[2][4];
#pragma unroll
    for (int c = 0; c < 2; ++c)
#pragma unroll
        for (int dt = 0; dt < 4; ++dt) o[c][dt] = (f32x4){0.f, 0.f, 0.f, 0.f};
#pragma unroll
    for (int s = 8; s < 16; ++s) {
        ATT_ISSUE(s + 3, kk);
        kk = ATT_KEYS(s + 4);
        asm volatile("s_waitcnt vmcnt(12)" ::: "memory");
        const LAS unsigned char* slot = RING + (s & 3) * 4096;
#pragma unroll
        for (int c = 0; c < 2; ++c) {
            const f32x4 t0 = lgs[s - 8][0][c], t1 = lgs[s - 8][1][c];
            const long pf = (long)(((unsigned long long)pack4_fp8(t1[0], t1[1], t1[2], t1[3]) << 32) | pack4_fp8(t0[0], t0[1], t0[2], t0[3]));
#pragma unroll
            for (int dt = 0; dt < 4; ++dt) {
                const v2i32_t va = __builtin_amdgcn_ds_read_tr8_b64_v2i32((LAS v2i32_t*)(slot + voff[c][dt]));
                const long vf = (long)(((unsigned long long)(unsigned)va.y << 32) | (unsigned)va.x);
                o[c][dt] = __builtin_amdgcn_mfma_f32_16x16x32_fp8_fp8(vf, pf, o[c][dt], 0, 0, 0);
            }
        }
        asm volatile("s_waitcnt lgkmcnt(0)" ::: "memory");
    }
#undef ATT_ISSUE
#undef ATT_KEYS
    if (li < 4) {
#pragma unroll
        for (int c = 0; c < 2; ++c)
#pragma unroll
            for (int dt = 0; dt < 4; ++dt) { const f32x4 v = o[c][dt] * inv[c]; u32x2 w; w.x = pk2(v[0], v[1]); w.y = pk2(v[2], v[3]);
                *(u32x2*)(YAYP + (size_t)m * 1024 + (4 * c + li) * 64 + 16 * dt + 4 * kq) = w; }
    }
    asm volatile("s_waitcnt vmcnt(0)" ::: "memory");
    }
}

template <int WIN> __device__ __forceinline__ void pool_item(const bf16* U, bf16* DP, const int mrow, const int ck) {
    const int t = mrow & (SEQ - 1), cw = WIN < t + 1 ? WIN : t + 1;
    u32x4 x[WIN];
#pragma unroll
    for (int i = 0; i < WIN; ++i) x[i] = *(const u32x4*)(U + (size_t)(mrow - (i < cw ? i : 0)) * 512 + 8 * ck);
    float s[8];
#pragma unroll
    for (int e = 0; e < 8; ++e) s[e] = 0.f;
#pragma unroll
    for (int i = 0; i < WIN; ++i) { const float w = i < cw ? 1.f : 0.f;
        s[0] += w * bflo(x[i].x); s[1] += w * bfhi(x[i].x); s[2] += w * bflo(x[i].y); s[3] += w * bfhi(x[i].y); s[4] += w * bflo(x[i].z); s[5] += w * bfhi(x[i].z); s[6] += w * bflo(x[i].w); s[7] += w * bfhi(x[i].w); }
    const float inv = 1.0f / (float)cw;
    u32x4 o; o.x = pk2(s[0] * inv - bflo(x[0].x), s[1] * inv - bfhi(x[0].x)); o.y = pk2(s[2] * inv - bflo(x[0].y), s[3] * inv - bfhi(x[0].y));
    o.z = pk2(s[4] * inv - bflo(x[0].z), s[5] * inv - bfhi(x[0].z)); o.w = pk2(s[6] * inv - bflo(x[0].w), s[7] * inv - bfhi(x[0].w));
    *(u32x4*)(DP + (size_t)mrow * 1024 + 8 * ck) = o;
}
__device__ __forceinline__ void pool_window(const bf16* U, bf16* DP, int gtid, int nthreads) {
    for (int it = gtid; it < M * 64; it += nthreads) {
        const int mrow = it >> 6, ck = it & 63, g = ck >> 4;
        if (g == 0) pool_item<2>(U, DP, mrow, ck); else if (g == 1) pool_item<4>(U, DP, mrow, ck); else if (g == 2) pool_item<8>(U, DP, mrow, ck); else pool_item<16>(U, DP, mrow, ck);
    }
}

__device__ __forceinline__ void butterfly32(const float (&lg)[32], const int lane, float& out) {
    float r16[16], r8[8], r4[4], r2[2], r1;
    { const bool hi = (lane & 32) != 0;
#pragma unroll
      for (int q = 0; q < 16; ++q) { const float mine = hi ? lg[16 + q] : lg[q], oth = hi ? lg[q] : lg[16 + q]; r16[q] = mine + partner32(oth, hi); } }
    { const bool hi = (lane & 16) != 0;
#pragma unroll
      for (int q = 0; q < 8; ++q) { const float mine = hi ? r16[8 + q] : r16[q], oth = hi ? r16[q] : r16[8 + q]; r8[q] = mine + shx<16>(oth); } }
    { const bool hi = (lane & 8) != 0;
#pragma unroll
      for (int q = 0; q < 4; ++q) { const float mine = hi ? r8[4 + q] : r8[q], oth = hi ? r8[q] : r8[4 + q]; r4[q] = mine + shx<8>(oth); } }
    { const bool hi = (lane & 4) != 0;
#pragma unroll
      for (int q = 0; q < 2; ++q) { const float mine = hi ? r4[2 + q] : r4[q], oth = hi ? r4[q] : r4[2 + q]; r2[q] = mine + shx<4>(oth); } }
    { const bool hi = (lane & 2) != 0; const float mine = hi ? r2[1] : r2[0], oth = hi ? r2[0] : r2[1]; r1 = mine + shx<2>(oth); }
    out = r1 + shx<1>(r1);
}
__device__ __forceinline__ void ln1_router_phase(LAS unsigned char* lds, const int tid, const int wave, const int lane_in, const int blk,
                                                 const float* V, const float* g1, const float* b1, const float* Wr, const float* br,
                                                 float* X1F, unsigned char* X1Q, float* X1S, int* TOPI, float* GATE, int* LRANK, int* HISTL) {
    LAS float* WL = (LAS float*)lds;
#pragma unroll 2
    for (int i = tid; i < 8192; i += NWAVES * 64) {
        const f32x4 w = *(const f32x4*)(Wr + 4 * i); const int k = i >> 3, e4 = (i & 7) * 4;
        WL[(e4 + 0) * 1024 + k] = w.x; WL[(e4 + 1) * 1024 + k] = w.y; WL[(e4 + 2) * 1024 + k] = w.z; WL[(e4 + 3) * 1024 + k] = w.w;
    }
    LAS int* EL = (LAS int*)(lds + XTRA_OFF);
    LAS float* LG = (LAS float*)(lds + XTRA_OFF + 2048 + wave * 512);
    LAS float* TV = LG + 64; LAS int* TE = (LAS int*)(LG + 72);
    __syncthreads();
    const int lane = lane_in, row0 = blk * 64 + wave * 8;
    f32x4 va[4], vb[4];
#pragma unroll
    for (int j = 0; j < 4; ++j) { va[j] = *(const f32x4*)(V + (size_t)row0 * D + 4 * lane + 256 * j); vb[j] = *(const f32x4*)(V + (size_t)(row0 + 1) * D + 4 * lane + 256 * j); }
#pragma unroll 1
    for (int pr = 0; pr < 4; ++pr) {
        const int rowA = row0 + 2 * pr;
        ln_regs(va, g1, b1, lane); ln_regs(vb, g1, b1, lane);
        store_row_f32(X1F + (size_t)rowA * D, va, lane); store_row_f32(X1F + (size_t)(rowA + 1) * D, vb, lane);
        store_row_i8(X1Q + (size_t)rowA * D, X1S + rowA, va, lane); store_row_i8(X1Q + (size_t)(rowA + 1) * D, X1S + rowA + 1, vb, lane);
        f32x2 l2[32];
#pragma unroll
        for (int e = 0; e < 32; ++e) l2[e] = (f32x2){0.f, 0.f};
#pragma unroll
        for (int j = 0; j < 4; ++j) {
            const f32x2 p0 = (f32x2){va[j].x, vb[j].x}, p1 = (f32x2){va[j].y, vb[j].y}, p2 = (f32x2){va[j].z, vb[j].z}, p3 = (f32x2){va[j].w, vb[j].w};
#pragma unroll
            for (int e = 0; e < 32; ++e) { const f32x4 w4 = *(const LAS f32x4*)(WL + e * 1024 + 4 * lane + 256 * j);
                l2[e] = __builtin_elementwise_fma(p0, (f32x2){w4.x, w4.x}, l2[e]); l2[e] = __builtin_elementwise_fma(p1, (f32x2){w4.y, w4.y}, l2[e]);
                l2[e] = __builtin_elementwise_fma(p2, (f32x2){w4.z, w4.z}, l2[e]); l2[e] = __builtin_elementwise_fma(p3, (f32x2){w4.w, w4.w}, l2[e]); }
        }
        float la[32], lb[32];
#pragma unroll
        for (int e = 0; e < 32; ++e) { la[e] = l2[e].x; lb[e] = l2[e].y; }
        { const int rowN = row0 + 2 * (pr < 3 ? pr + 1 : pr);
#pragma unroll
          for (int j = 0; j < 4; ++j) { va[j] = *(const f32x4*)(V + (size_t)rowN * D + 4 * lane + 256 * j); vb[j] = *(const f32x4*)(V + (size_t)(rowN + 1) * D + 4 * lane + 256 * j); }
          asm volatile("" ::: "memory"); }
        float vala, valb; butterfly32(la, lane, vala); butterfly32(lb, lane, valb);
        int em = lane >> 1; asm volatile("" : "+v"(em));
        const int myrow = lane & 1; const float bias = br[em];
        vala += bias; valb += bias;
        if (myrow == 0) LG[em] = vala; else LG[32 + em] = valb;
        WAVE_FENCE();
        const float mine = myrow ? valb : vala; int rank = 0;
#pragma unroll
        for (int q = 0; q < 8; ++q) { const f32x4 o4 = *(const LAS f32x4*)(LG + 32 * myrow + 4 * q);
#pragma unroll
            for (int u = 0; u < 4; ++u) rank += (o4[u] > mine || (o4[u] == mine && 4 * q + u < em)) ? 1 : 0; }
        if (rank < 4) { TV[4 * myrow + rank] = mine; TE[4 * myrow + rank] = em; }
        WAVE_FENCE();
        if (lane < 2) {
            const f32x4 tv = *(const LAS f32x4*)(TV + 4 * lane); const int t0 = TE[4 * lane], t1 = TE[4 * lane + 1], t2 = TE[4 * lane + 2], t3 = TE[4 * lane + 3];
            const float e1 = __expf(tv[1] - tv[0]), e2 = __expf(tv[2] - tv[0]), e3 = __expf(tv[3] - tv[0]); const float inv = 1.0f / (1.0f + e1 + e2 + e3);
            const int row = rowA + lane, gi = row * 4, rl = row - blk * 64;
            *(int4*)(TOPI + gi) = make_int4(t0, t1, t2, t3);
            *(f32x4*)(GATE + gi) = (f32x4){inv, e1 * inv, e2 * inv, e3 * inv};
            EL[rl * 4] = t0; EL[rl * 4 + 1] = t1; EL[rl * 4 + 2] = t2; EL[rl * 4 + 3] = t3;
        }
        WAVE_FENCE();
    }
    __syncthreads();
    LAS int* CNT = (LAS int*)(lds + XTRA_OFF + 1024);
    if (wave < 4) {
        const int e = EL[tid]; int rk = 0;
#pragma unroll 4
        for (int q = 0; q < 32; ++q) { const unsigned long long mq = __ballot(e == q); if (e == q) rk = __popcll(mq & ((1ull << lane_in) - 1ull)); if (lane_in == q) CNT[wave * 32 + q] = __popcll(mq); }
        __syncthreads();
        for (int w2 = 0; w2 < wave; ++w2) rk += CNT[w2 * 32 + e];
        LRANK[blk * 256 + tid] = rk;
        if (tid < 32) HISTL[blk * 32 + tid] = CNT[tid] + CNT[32 + tid] + CNT[64 + tid] + CNT[96 + tid];
    } else {
        __syncthreads();
    }
    __syncthreads();
}

__device__ __forceinline__ void scatter_phase(LAS unsigned char* lds, const int tid, const int wave, const int lane, const int blk,
                                              const int* HISTL, const int* TOPI, const float* GATE, const int* LRANK, const unsigned char* X1Q, const float* X1S,
                                              unsigned char* XS8, float* ROWG, float* ROWS, int* TOKROW, int* TILE) {
    LAS int* TOT = (LAS int*)lds; LAS int* BEF = TOT + 32; LAS int* OFFS = TOT + 64; LAS int* PT = TOT + 128; LAS int* PBF = TOT + 640;
    { const int e = tid & 31, part = tid >> 5; int hv[16];
#pragma unroll
      for (int q = 0; q < 16; ++q) hv[q] = HISTL[(part * 16 + q) * 32 + e];
      int tot = 0, bef = 0;
#pragma unroll
      for (int q = 0; q < 16; ++q) { tot += hv[q]; bef += (part * 16 + q < blk) ? hv[q] : 0; }
      PT[part * 32 + e] = tot; PBF[part * 32 + e] = bef; }
    __syncthreads();
    if (tid < 32) { int tot = 0, bef = 0;
#pragma unroll
        for (int q = 0; q < 16; ++q) { tot += PT[q * 32 + tid]; bef += PBF[q * 32 + tid]; }
        TOT[tid] = tot; BEF[tid] = bef; }
    __syncthreads();
    if (tid == 0) {
        int off = 0;
#pragma unroll 1
        for (int e = 0; e < 32; ++e) { OFFS[e] = off + BEF[e]; const int nt = (TOT[e] + 255) >> 8;
            if (blk == 0) {
#pragma unroll 1
                for (int k = 0; k < nt; ++k) TILE[1 + (off >> 8) + k] = e; }
            off += nt << 8; }
        if (blk == 0) TILE[0] = off >> 8;
    }
    __syncthreads();
#pragma unroll 1
    for (int i0 = 0; i0 < 32; i0 += 8) {
        int rowv[8]; u32x4 d[8]; float gv[8], sv[8];
#pragma unroll
        for (int u = 0; u < 8; ++u) { const int gi = blk * 256 + wave * 32 + i0 + u; const int e = TOPI[gi]; rowv[u] = OFFS[e] + LRANK[gi]; gv[u] = GATE[gi]; sv[u] = X1S[gi >> 2];
            d[u] = *(const u32x4*)(X1Q + (size_t)(gi >> 2) * D + 16 * lane); }
#pragma unroll
        for (int u = 0; u < 8; ++u) { const int gi = blk * 256 + wave * 32 + i0 + u;
            if (lane == 0) { TOKROW[gi] = rowv[u]; ROWG[rowv[u]] = gv[u]; ROWS[rowv[u]] = sv[u]; }
            *(u32x4*)(XS8 + (size_t)rowv[u] * D + 16 * lane) = d[u]; }
    }
    __syncthreads();
}

__device__ __forceinline__ void add_bf16_row(f32x4 (&v)[4], const bf16* row, int lane) {
#pragma unroll
    for (int j = 0; j < 4; ++j) { const u32x2 w = *(const u32x2*)(row + 4 * lane + 256 * j); v[j].x += bflo(w.x); v[j].y += bfhi(w.x); v[j].z += bflo(w.y); v[j].w += bfhi(w.y); }
}
__device__ __forceinline__ void combine_ln2_phase(const int gw, const int ngw, const int lane, const float* X1F, const bf16* PLEV, const bf16* YR, const int* TOKROW,
                                                  const float* g2, const float* b2, float* XF, unsigned char* XQ, float* XQS, float* OUT) {
#pragma unroll 1
    for (int row = gw; row < M; row += 2 * ngw) {
        const int rowb = row + ngw;
        const int4 ra = *(const int4*)(TOKROW + row * 4), rb = *(const int4*)(TOKROW + rowb * 4);
        f32x4 va[4], vb[4];
#pragma unroll
        for (int j = 0; j < 4; ++j) { va[j] = *(const f32x4*)(X1F + (size_t)row * D + 4 * lane + 256 * j) * DN_ALPHA; vb[j] = *(const f32x4*)(X1F + (size_t)rowb * D + 4 * lane + 256 * j) * DN_ALPHA; }
        add_bf16_row(va, PLEV + (size_t)row * D, lane); add_bf16_row(vb, PLEV + (size_t)rowb * D, lane);
        add_bf16_row(va, YR + (size_t)ra.x * D, lane); add_bf16_row(vb, YR + (size_t)rb.x * D, lane);
        add_bf16_row(va, YR + (size_t)ra.y * D, lane); add_bf16_row(vb, YR + (size_t)rb.y * D, lane);
        add_bf16_row(va, YR + (size_t)ra.z * D, lane); add_bf16_row(vb, YR + (size_t)rb.z * D, lane);
        add_bf16_row(va, YR + (size_t)ra.w * D, lane); add_bf16_row(vb, YR + (size_t)rb.w * D, lane);
        ln_regs(va, g2, b2, lane); ln_regs(vb, g2, b2, lane);
        if (OUT) { store_row_f32(OUT + (size_t)row * D, va, lane); store_row_f32(OUT + (size_t)rowb * D, vb, lane); }
        else { store_row_f32(XF + (size_t)row * D, va, lane); store_row_i8(XQ + (size_t)row * D, XQS + row, va, lane); store_row_f32(XF + (size_t)rowb * D, vb, lane); store_row_i8(XQ + (size_t)rowb * D, XQS + rowb, vb, lane); }
    }
}

#ifndef MK_N_LAUNCHES
#define MK_N_LAUNCHES 1
#endif
constexpr int PH_PER_LAYER = 10, N_PHASES = 1 + DEPTH * PH_PER_LAYER;
constexpr double ROPE_TURNS[8] = {0.15915494309189535, 0.03086376340470123, 0.005985185712713705, 0.001160663641240061, 0.00022507907903927653, 4.364795279280289e-05, 8.464330808241401e-06, 1.6414262627950345e-06};

#define ARGP(i) ((const float*)(const GAS float*)kargs_[i])
constexpr int B_WIN = 8 * 16, B_UP = 4 * 4, B_OUT = 8 * 4, B_PLEP = 2 * 4, B_GU1 = 8 * 8, B_DN1 = 8 * 4;
constexpr int B_LAYER = B_WIN + B_UP + 2 * B_OUT + B_PLEP + NE * B_GU1 + NE * B_DN1;
struct P0D { const float* src; int nsrc; unsigned char* dst; int ldtb; int i8; float ws; int valid; };
__device__ __forceinline__ void p0_decode(P0D& d, const int it_in, const int wave, unsigned char* ws, const __attribute__((address_space(4))) unsigned long long* kargs_, const int lane) {
    int it = __builtin_amdgcn_readfirstlane(it_in); asm volatile("" : "+s"(it));
    const int ll = it / B_LAYER; int r = it - ll * B_LAYER; unsigned char* lw2 = ws + WS_W + (size_t)ll * LW_SIZE;
    const float* W; int nsrc, nblk, ldt, kind = 0; unsigned char* wt; d.i8 = 0; d.ws = 1.0f;
    if (r < B_WIN) { W = ARGP(4) + (size_t)ll * D * D_IN; nsrc = D_IN; wt = lw2 + LW_WIN; ldt = D; nblk = 16; kind = 1; d.i8 = 1; d.ws = I8_WS_GU; }
    else if ((r -= B_WIN) < B_UP) { W = ARGP(7) + (size_t)ll * 512 * D; nsrc = D; wt = lw2 + LW_WUPA; ldt = 1024; nblk = 4; }
    else if ((r -= B_UP) < B_OUT) { W = ARGP(9) + (size_t)ll * D * D; nsrc = D; wt = lw2 + LW_WOUT; ldt = D; nblk = 4; }
    else if ((r -= B_OUT) < B_OUT) { W = ARGP(18) + (size_t)ll * D * D; nsrc = D; wt = lw2 + LW_PLEG; ldt = D; nblk = 4; d.i8 = 1; d.ws = I8_WS_GU; }
    else if ((r -= B_OUT) < B_PLEP) { W = ARGP(19) + (size_t)ll * PLE * D; nsrc = D; wt = lw2 + LW_PLEP; ldt = PLE; nblk = 4; }
    else if ((r -= B_PLEP) < NE * B_GU1) { const int e = r / B_GU1; r -= e * B_GU1; W = ARGP(14) + ((size_t)ll * NE + e) * D * 2048; nsrc = 2048; wt = lw2 + LW_WGU + (size_t)e * 2048 * D; ldt = D; nblk = 8; kind = 2; d.i8 = 1; d.ws = I8_WS_GU; }
    else { r -= NE * B_GU1; const int e = r / B_DN1; r -= e * B_DN1; W = ARGP(16) + ((size_t)ll * NE + e) * DFF * D; nsrc = D; wt = lw2 + LW_WDN + (size_t)e * D * DFF; ldt = DFF; nblk = 4; d.i8 = 1; d.ws = I8_WS_DN; }
    const int kb = r / nblk, nb = r - kb * nblk, k0 = 128 * kb + 16 * wave, np = 256 * nb + 4 * lane;
    const int sc = kind == 1 ? MapWin()(np) : (kind == 2 ? MapGU()(np) : np);
    d.valid = sc >= 0; d.nsrc = nsrc; d.src = W + (size_t)k0 * nsrc + (sc < 0 ? 0 : sc);
    const int esz = d.i8 ? 1 : 2; d.ldtb = ldt * esz; d.dst = wt + (size_t)(256 * nb) * d.ldtb + (size_t)(128 * kb) * esz;
}
struct Args { const float* in[22]; float* out; unsigned char* ws; int ph_lo, ph_hi; };

template <unsigned PMASK>
__global__ void __launch_bounds__(NWAVES * 64, 2) mega_fwd(Args args) {
    extern __shared__ __attribute__((aligned(16))) unsigned char lds_raw[];
    LAS unsigned char* lds = (LAS unsigned char*)lds_raw;
    volatile LAS unsigned* MISC = (volatile LAS unsigned*)(lds + MISC_OFF);
    const int G = gridDim.x, blk = blockIdx.x;
    const int wave_s_ = __builtin_amdgcn_readfirstlane(threadIdx.x >> 6);
    for (int u = threadIdx.x; u < (LDS_BYTES - MISC_OFF) / 4; u += NWAVES * 64) ((LAS unsigned*)(lds + MISC_OFF))[u] = 0u;
    __syncthreads();
    XcdBarrier bar; bar.bar = (unsigned*)(args.ws + WS_CTL) + CW_BAR; bar.x = 0; bar.st = nullptr;
#if MK_N_LAUNCHES == 1
    bar = xcd_barrier_post((unsigned*)(args.ws + WS_CTL) + CW_BAR, MISC + 8);
#define GRID_BAR() xcd_barrier(bar)
#else
#define GRID_BAR() do { } while (0)
#endif
    const int lo = args.ph_lo, hi = args.ph_hi;
#ifndef PROBE_MASK
#define PROBE_MASK 0u
#endif
#define PH_KIND(k) ((k) == 0 ? 0 : 1 + ((k) - 1) % PH_PER_LAYER)
#define REPS(kk) for (int rep_ = 0; rep_ < (((PROBE_MASK >> (kk)) & 1u) ? 2 : 1); ++rep_)
#define HASK(kk) (((PMASK >> (kk)) & 1u) != 0u)

#define PHASE_VARS \
    const __attribute__((address_space(4))) unsigned long long* kargs_ = (const __attribute__((address_space(4))) unsigned long long*)__builtin_amdgcn_kernarg_segment_ptr(); \
    __builtin_amdgcn_s_waitcnt(0);       \
    asm volatile("" : "+s"(kargs_));     \
    unsigned char* ws = (unsigned char*)(GAS unsigned char*)kargs_[23]; \
    int lane_o_ = (int)__builtin_amdgcn_mbcnt_hi(~0u, __builtin_amdgcn_mbcnt_lo(~0u, 0u)); asm volatile("" : "+v"(lane_o_));     \
    const int lane = lane_o_, wave = wave_s_, tid = wave_s_ * 64 + lane_o_; \
    const int gw = blk * NWAVES + wave, NGW = G * NWAVES, gtid = blk * (NWAVES * 64) + tid, NT = G * NWAVES * 64; \
    (void)lane; (void)wave; (void)gw; (void)NGW; (void)gtid; (void)NT; \
    float* XF = (float*)(ws + WS_XF); bf16* XB = (bf16*)(ws + WS_XB); \
    float* ROPE = (float*)(ws + WS_ROPE); bf16* PB16 = (bf16*)(ws + WS_PB16); \
    bf16* Qb = (bf16*)(ws + WS_Q); bf16* KVb = (bf16*)(ws + WS_KV); bf16* QIb = (bf16*)(ws + WS_QI); bf16* KIb = (bf16*)(ws + WS_KI); float* WIb = (float*)(ws + WS_WI); \
    bf16* Ub = (bf16*)(ws + WS_U); bf16* SGA = (bf16*)(ws + WS_SGA); bf16* SGB = (bf16*)(ws + WS_SGB); bf16* YAYP = (bf16*)(ws + WS_YAYP); bf16* DP = (bf16*)(ws + WS_DP); \
    float* T1 = (float*)(ws + WS_T1); bf16* MRG = (bf16*)(ws + WS_MRG); float* X1F = (float*)(ws + WS_X1F); bf16* X1B = (bf16*)(ws + WS_X1B); \
    bf16* XS = (bf16*)(ws + WS_XS); bf16* ACT = (bf16*)(ws + WS_ACT); bf16* YR = (bf16*)(ws + WS_YR); bf16* PLEPb = (bf16*)(ws + WS_PLEP); bf16* PLEV = (bf16*)(ws + WS_PLEV); \
    int* TOPI = (int*)(ws + WS_ROUTE + RT_TOPI); float* GATE = (float*)(ws + WS_ROUTE + RT_GATE); int* LRANK = (int*)(ws + WS_ROUTE + RT_LRANK); \
    int* TOKROW = (int*)(ws + WS_ROUTE + RT_TOKROW); float* ROWG = (float*)(ws + WS_ROUTE + RT_ROWG); float* ROWS = (float*)(ws + WS_ROUTE + RT_ROWS); (void)ROWS; float* X1S = (float*)(ws + WS_ROUTE + RT_X1S); (void)X1S; unsigned char* X1Q = (unsigned char*)(ws + WS_X1B); (void)X1Q; unsigned char* XQ = (unsigned char*)(ws + WS_XB); (void)XQ; float* XQS = (float*)(ws + WS_ROUTE + RT_XQS); (void)XQS; \
    unsigned char* lw = ws + WS_W + (size_t)l * LW_SIZE; \
    int* HISTL = (int*)(ws + WS_ROUTE + RT_HIST) + l * 256 * 32; int* TILE = (int*)(ws + WS_ROUTE + RT_TILE) + l * 512; \
    (void)XF; (void)XB; (void)ROPE; (void)PB16; (void)Qb; (void)KVb; (void)QIb; (void)KIb; (void)WIb; (void)Ub; (void)SGA; (void)SGB; (void)YAYP; (void)DP; (void)T1; (void)MRG; (void)X1F; (void)X1B; \
    (void)XS; (void)ACT; (void)YR; (void)PLEPb; (void)PLEV; (void)TOPI; (void)GATE; (void)LRANK; (void)TOKROW; (void)ROWG; (void)lw; (void)HISTL; (void)TILE;

#pragma unroll 1
    for (int ph = lo; ph < hi; ++ph) {
    const int kind = PH_KIND(ph), l = (ph - 1) / PH_PER_LAYER;
    if (kind == 0 && HASK(0)) REPS(0) {
        PHASE_VARS
        const float* x_in = ARGP(0); const float* p_in = ARGP(1);
        if (blk < DEPTH * B_LAYER) {
            P0D cur; p0_decode(cur, blk, wave, ws, kargs_, lane); f32x4 tv[16]; int par = 0;
#pragma unroll
            for (int i = 0; i < 16; ++i) tv[i] = __builtin_nontemporal_load((const f32x4*)(cur.src + (size_t)i * cur.nsrc));
#pragma unroll 1
            for (int it = blk;; it += G) {
                const bool has = it + G < DEPTH * B_LAYER; P0D nx; f32x4 tn[16];
                p0_decode(nx, has ? it + G : it, wave, ws, kargs_, lane);
#pragma unroll
                for (int i = 0; i < 16; ++i) tn[i] = __builtin_nontemporal_load((const f32x4*)(nx.src + (size_t)i * nx.nsrc));
                asm volatile("" ::: "memory");
                const float sc_ = cur.valid ? cur.ws : 0.f;
                LAS unsigned char* tile = lds + par * 65536; par ^= 1;
                if (cur.i8) {
#pragma unroll
                    for (int c = 0; c < 4; ++c) { u32x4 o;
                        o.x = pack4_i8(tv[0][c] * sc_, tv[1][c] * sc_, tv[2][c] * sc_, tv[3][c] * sc_); o.y = pack4_i8(tv[4][c] * sc_, tv[5][c] * sc_, tv[6][c] * sc_, tv[7][c] * sc_);
                        o.z = pack4_i8(tv[8][c] * sc_, tv[9][c] * sc_, tv[10][c] * sc_, tv[11][c] * sc_); o.w = pack4_i8(tv[12][c] * sc_, tv[13][c] * sc_, tv[14][c] * sc_, tv[15][c] * sc_);
                        *(LAS u32x4*)(tile + (4 * lane + c) * 128 + 16 * (wave ^ (lane & 7))) = o; }
                    LDS_WAIT(); __builtin_amdgcn_s_barrier();
#pragma unroll
                    for (int j = 0; j < 4; ++j) { const int ci = j * 512 + tid, n = ci >> 3, q = ci & 7;
                        *(GAS u32x4*)(cur.dst + (size_t)n * cur.ldtb + 16 * q) = *(const LAS u32x4*)(tile + n * 128 + 16 * (q ^ ((n >> 2) & 7))); }
                } else {
#pragma unroll
                    for (int c = 0; c < 4; ++c) { u32x4 o0, o1;
                        o0.x = pk2(tv[0][c] * sc_, tv[1][c] * sc_); o0.y = pk2(tv[2][c] * sc_, tv[3][c] * sc_); o0.z = pk2(tv[4][c] * sc_, tv[5][c] * sc_); o0.w = pk2(tv[6][c] * sc_, tv[7][c] * sc_);
                        o1.x = pk2(tv[8][c] * sc_, tv[9][c] * sc_); o1.y = pk2(tv[10][c] * sc_, tv[11][c] * sc_); o1.z = pk2(tv[12][c] * sc_, tv[13][c] * sc_); o1.w = pk2(tv[14][c] * sc_, tv[15][c] * sc_);
                        *(LAS u32x4*)(tile + (4 * lane + c) * 256 + 16 * ((2 * wave) ^ (lane & 7))) = o0; *(LAS u32x4*)(tile + (4 * lane + c) * 256 + 16 * ((2 * wave + 1) ^ (lane & 7))) = o1; }
                    LDS_WAIT(); __builtin_amdgcn_s_barrier();
#pragma unroll
                    for (int j = 0; j < 8; ++j) { const int ci = j * 512 + tid, n = ci >> 4, q = ci & 15;
                        *(GAS u32x4*)(cur.dst + (size_t)n * cur.ldtb + 16 * q) = *(const LAS u32x4*)(tile + n * 256 + 16 * (q ^ ((n >> 2) & 7))); }
                }
                if (!has) break;
                cur = nx;
#pragma unroll
                for (int i = 0; i < 16; ++i) tv[i] = tn[i];
            }
        }
        for (int it = gtid; it < DEPTH * 64 * 1024; it += NT) {
            const int n = it & 1023, kc = (it >> 10) & 63, ll = it >> 16, g = kc >> 4, c0 = (kc & 15) * 8;
            const float* pw = ARGP(5) + ((size_t)(ll * 4 + g) * 128 + c0) * 128;
            const float* sc = ARGP(6) + (size_t)ll * 512 + g * 128;
            const float* wp = ARGP(8) + ((size_t)ll * 512 + g * 128) * D + n;
            float a8[8];
#pragma unroll
            for (int j = 0; j < 8; ++j) a8[j] = 0.f;
#pragma unroll 2
            for (int d = 0; d < 128; d += 4) {
                const f32x4 s4 = *(const f32x4*)(sc + d);
                const f32x4 w4 = (f32x4){wp[(size_t)d * D] * s4[0], wp[(size_t)(d + 1) * D] * s4[1], wp[(size_t)(d + 2) * D] * s4[2], wp[(size_t)(d + 3) * D] * s4[3]};
#pragma unroll
                for (int j = 0; j < 8; ++j) { const f32x4 p4 = *(const f32x4*)(pw + j * 128 + d); a8[j] += (p4[0] * w4[0] + p4[1] * w4[1]) + (p4[2] * w4[2] + p4[3] * w4[3]); }
            }
            u32x4 o; o.x = pk2(a8[0], a8[1]); o.y = pk2(a8[2], a8[3]); o.z = pk2(a8[4], a8[5]); o.w = pk2(a8[6], a8[7]);
            *(u32x4*)((bf16*)(ws + WS_W + (size_t)ll * LW_SIZE + LW_WUPA) + (size_t)n * 1024 + 512 + 8 * kc) = o;
        }
        for (int it = gtid; it < SEQ * 8; it += NT) {
            const int pos = it >> 3, i = it & 7; const double tr = (double)pos * ROPE_TURNS[i]; const float fr = (float)(tr - __builtin_rint(tr));
            ROPE[pos * 16 + i] = __builtin_amdgcn_cosf(fr); ROPE[pos * 16 + 8 + i] = __builtin_amdgcn_sinf(fr);
        }
        { f32x4 pa[8], pc[8];
#pragma unroll
          for (int q = 0; q < 8; ++q) { const size_t it = (size_t)gtid + (size_t)q * NT; pa[q] = __builtin_nontemporal_load((const f32x4*)(p_in + it * 8)); pc[q] = __builtin_nontemporal_load((const f32x4*)(p_in + it * 8 + 4)); }
#pragma unroll
          for (int q = 0; q < 8; ++q) { const size_t it = (size_t)gtid + (size_t)q * NT; *(u32x4*)(PB16 + it * 8) = pg8::pack8(pa[q], pc[q]); } }
#pragma unroll 1
        for (int m = gw; m < M; m += 4 * NGW) {
            f32x4 v[4][4];
#pragma unroll
            for (int u = 0; u < 4; ++u)
#pragma unroll
                for (int j = 0; j < 4; ++j) v[u][j] = __builtin_nontemporal_load((const f32x4*)(x_in + (size_t)(m + u * NGW) * D + 4 * lane + 256 * j));
#pragma unroll
            for (int u = 0; u < 4; ++u) { const int mr = m + u * NGW; ln_regs(v[u], ARGP(2), ARGP(3), lane);
                store_row_f32(XF + (size_t)mr * D, v[u], lane); store_row_i8(XQ + (size_t)mr * D, XQS + mr, v[u], lane); }
        }
    }
        else if (kind == 1 && HASK(1)) REPS(1) {
            PHASE_VARS
            pg8::StaticSched S; S.init(M, NZ, G, blk, XQ, D / 2, lw + LW_WIN, D / 2);
            pg8::EpiZ<true> E{Qb, KVb, QIb, KIb, WIb, Ub, SGA, SGB, ROPE, XQS};
            pg8::gemm_phase<pg8::EpiZ<true>, pg8::StaticSched, true, true>(lds, wave, pg8::Gemm{D / 2, D / 2}, S, E);
        }
        else if (kind == 2 && HASK(2)) REPS(2) {
            PHASE_VARS
            if (G == 256) {
                const int bb = (blk & 7) >> 1, cb = ((blk & 7) & 1) * 32 + (blk >> 3);
                for (int j = 0; j < 4; ++j) {
                    const int tq = 64 * j + ((j & 1) ? (63 - cb) : cb);
                    attn_unit(lds, wave, lane, bb, 16 * tq, QIb, KIb, WIb, Qb, KVb, YAYP);
                    __syncthreads();
                }
            } else {
                for (int j = 0; j < (1024 + G - 1) / G; ++j) {
                    const int id = G * j + ((j & 1) ? (G - 1 - blk) : blk);
                    if (id < 1024) attn_unit(lds, wave, lane, id & 3, 16 * (id >> 2), QIb, KIb, WIb, Qb, KVb, YAYP);
                    __syncthreads();
                }
            }
            for (int repw_ = 0; repw_ < (ATT_PROBE == 4 ? 2 : 1); ++repw_) pool_window(Ub, YAYP + 512, gtid, NT);
            __syncthreads();
            { pg8::StaticSched S; S.init(M, D, G, blk, PB16 + (size_t)l * M * PLE, PLE, lw + LW_PLEP, PLE);
              pg8::EpiBf16 E{PLEPb, 1024, 0, nullptr};
              pg8::gemm_phase<pg8::EpiBf16, pg8::StaticSched, true>(lds, wave, pg8::Gemm{PLE, PLE}, S, E); }
        }
        else if (kind == 3) { }
        else if (kind == 4 && HASK(4)) REPS(4) {
            PHASE_VARS
            { pg8::StaticSched S; S.init(M, D, G, blk, YAYP, 1024, lw + LW_WUPA, 1024);
              pg8::EpiGateMerge E{SGA, SGB, MRG};
              pg8::gemm_phase<pg8::EpiGateMerge, pg8::StaticSched, true>(lds, wave, pg8::Gemm{1024, 1024}, S, E); }
        }
        else if (kind == 5 && HASK(5)) REPS(5) {
            PHASE_VARS
            pg8::StaticSched S; S.init(M, D, G, blk, MRG, D, lw + LW_WOUT, D);
            pg8::EpiResid E{XF, T1, DN_ALPHA};
            pg8::gemm_phase<pg8::EpiResid, pg8::StaticSched, true>(lds, wave, pg8::Gemm{D, D}, S, E);
        }
        else if (kind == 6 && HASK(6)) REPS(6) {
            PHASE_VARS
            if (blk < 256) ln1_router_phase(lds, tid, wave, lane, blk, T1, ARGP(10) + (size_t)l * D, ARGP(11) + (size_t)l * D, ARGP(12) + (size_t)l * D * NE, ARGP(13) + (size_t)l * NE,
                                            X1F, X1Q, X1S, TOPI, GATE, LRANK, HISTL);
        }
        else if (kind == 7 && HASK(7)) REPS(7) {
            PHASE_VARS
            if (blk < 256) scatter_phase(lds, tid, wave, lane, blk, HISTL, TOPI, GATE, LRANK, X1Q, X1S, (unsigned char*)XS, ROWG, ROWS, TOKROW, TILE);
        }
        else if (kind == 8 && HASK(8)) REPS(8) {
            PHASE_VARS
            LAS int* TL = (LAS int*)(lds + XTRA_OFF);
            for (int i = tid; i < 512; i += NWAVES * 64) TL[i] = __hip_atomic_load(TILE + i, __ATOMIC_RELAXED, __HIP_MEMORY_SCOPE_AGENT);
            __syncthreads();
            const int ntiles = TL[0];
            const int slotsH = ((ntiles * 8 + G - 1) / G) * G - ntiles * 8, pleH = slotsH < 256 ? slotsH : 256;
            { pg8::MoeSched S{ntiles, 8, G, (blk & 7) * (G >> 3) + (blk >> 3), TL + 1, (const char*)XS, (const char*)(lw + LW_WGU), (size_t)256 * D, (size_t)2048 * D, (size_t)256 * D,
                              0, pleH, (const char*)X1Q, (const char*)(lw + LW_PLEG), (size_t)256 * D, (size_t)256 * D};
              pg8::EpiSwigluPle E{{ARGP(15) + (size_t)l * NE * 2048, ROWS, (unsigned char*)ACT}, {PLEPb, X1S, PLEV}};
              pg8::gemm_phase<pg8::EpiSwigluPle, pg8::MoeSched, true, true>(lds, wave, pg8::Gemm{D / 2, D / 2}, S, E); }
        }
        else if (kind == 9 && HASK(9)) REPS(9) {
            PHASE_VARS
            LAS int* TL = (LAS int*)(lds + XTRA_OFF);
            for (int i = tid; i < 512; i += NWAVES * 64) TL[i] = __hip_atomic_load(TILE + i, __ATOMIC_RELAXED, __HIP_MEMORY_SCOPE_AGENT);
            __syncthreads();
            const int ntiles = TL[0];
            const int slotsH = ((ntiles * 8 + G - 1) / G) * G - ntiles * 8, pleH = slotsH < 256 ? slotsH : 256;
            { pg8::MoeSched S{ntiles, 4, G, (blk & 7) * (G >> 3) + (blk >> 3), TL + 1, (const char*)ACT, (const char*)(lw + LW_WDN), (size_t)256 * DFF, (size_t)D * DFF, (size_t)256 * DFF,
                              pleH, 256 - pleH, (const char*)X1Q, (const char*)(lw + LW_PLEG), (size_t)256 * D, (size_t)256 * D};
              pg8::EpiDownPle E{{ARGP(17) + (size_t)l * NE * D, ROWG, YR}, {PLEPb, X1S, PLEV}};
              pg8::gemm_phase<pg8::EpiDownPle, pg8::MoeSched, true, true>(lds, wave, pg8::Gemm{DFF / 2, DFF / 2}, S, E); }
        }
        else if (kind == 10 && HASK(10)) REPS(10) {
            PHASE_VARS
            combine_ln2_phase(gw, NGW, lane, X1F, PLEV, YR, TOKROW, ARGP(20) + (size_t)l * D, ARGP(21) + (size_t)l * D, XF, XQ, XQS, (l == DEPTH - 1) ? (float*)(GAS float*)kargs_[22] : nullptr);
        }
    if (ph + 1 < hi && kind != 3) { GRID_BAR(); if (ATT_PROBE == 5) GRID_BAR(); }
    }
}

#if MK_N_LAUNCHES == 1
#define MEGA_ALL mega_fwd<0x7ffu>
#else
typedef void (*kern_t)(Args);
static kern_t phase_kernel(int kind) {
    switch (kind) { case 0: return mega_fwd<1u>; case 1: return mega_fwd<2u>; case 2: return mega_fwd<4u>; case 3: return mega_fwd<8u>; case 4: return mega_fwd<16u>; case 5: return mega_fwd<32u>;
                    case 6: return mega_fwd<64u>; case 7: return mega_fwd<128u>; case 8: return mega_fwd<256u>; case 9: return mega_fwd<512u>; default: return mega_fwd<1024u>; }
}
#endif
extern "C" void kernel_launch(void* const* d_in, const int* in_sizes, int n_in, void* d_out, int out_size, void* d_ws, size_t ws_size, hipStream_t stream) {
    static int grid = 0;
    if (grid == 0) {
        if (n_in != 22 || out_size != M * D || ws_size < WS_END) { fprintf(stderr, "kernel_launch: unexpected shapes (n_in %d out %d ws %zu need %zu)\n", n_in, out_size, ws_size, (size_t)WS_END); grid = -1; return; }
        int dev = 0, cus = 0, per_cu = 0;
        if (hipGetDevice(&dev) != hipSuccess || hipDeviceGetAttribute(&cus, hipDeviceAttributeMultiprocessorCount, dev) != hipSuccess) { grid = -1; return; }
#if MK_N_LAUNCHES == 1
        if (hipFuncSetAttribute((const void*)MEGA_ALL, hipFuncAttributeMaxDynamicSharedMemorySize, LDS_BYTES) != hipSuccess) { fprintf(stderr, "kernel_launch: hipFuncSetAttribute failed\n"); grid = -1; return; }
        if (hipOccupancyMaxActiveBlocksPerMultiprocessor(&per_cu, (const void*)MEGA_ALL, NWAVES * 64, LDS_BYTES) != hipSuccess || per_cu < 1) { fprintf(stderr, "kernel_launch: occupancy query says %d blocks per CU\n", per_cu); grid = -1; return; }
#else
        for (int k = 0; k <= PH_PER_LAYER; ++k) if (hipFuncSetAttribute((const void*)phase_kernel(k), hipFuncAttributeMaxDynamicSharedMemorySize, LDS_BYTES) != hipSuccess) { fprintf(stderr, "kernel_launch: hipFuncSetAttribute failed\n"); grid = -1; return; }
        per_cu = 1;
#endif
        (void)hipGetLastError();
        grid = cus < 256 ? cus : 256;
    }
    if (grid < 0) return;
    (void)hipMemsetAsync((char*)d_ws + WS_CTL, 0, CTL_ZERO_BYTES, stream);
    Args a{};
    for (int i = 0; i < 22; ++i) a.in[i] = (const float*)d_in[i];
    a.out = (float*)d_out; a.ws = (unsigned char*)d_ws;
#if MK_N_LAUNCHES == 1
    a.ph_lo = 0; a.ph_hi = N_PHASES;
    hipLaunchKernelGGL(MEGA_ALL, dim3(grid), dim3(NWAVES * 64), LDS_BYTES, stream, a);
#else
    for (int ph = 0; ph < N_PHASES; ++ph) { a.ph_lo = ph; a.ph_hi = ph + 1; hipLaunchKernelGGL(phase_kernel(PH_KIND(ph)), dim3(grid), dim3(NWAVES * 64), LDS_BYTES, stream, a); }
#endif
}
```

```cpp
#include <hip/hip_runtime.h>
#ifndef ATT_PROBE
#define ATT_PROBE 0
#endif
#include <cstdio>
#include <cstdint>

#define LAS __attribute__((address_space(3)))
#define GAS __attribute__((address_space(1)))
typedef unsigned short bf16;
typedef short bf16x8 __attribute__((ext_vector_type(8)));
typedef float f32x4 __attribute__((ext_vector_type(4)));
typedef float f32x2 __attribute__((ext_vector_type(2)));
typedef float f32x16 __attribute__((ext_vector_type(16)));
typedef unsigned u32x4 __attribute__((ext_vector_type(4)));
typedef unsigned u32x2 __attribute__((ext_vector_type(2)));
typedef GAS unsigned gu32;

constexpr int D = 1024, BATCH = 4, SEQ = 4096, M = BATCH * SEQ, DEPTH = 2;
constexpr int NZ = 4096;
constexpr int D_IN = 3912;
constexpr int NE = 32, TOPK = 4, DFF = 1024, PLE = 256;
constexpr int NSEL = 256;
constexpr int RMAX = M * TOPK + NE * 256;
constexpr int TMAX = RMAX / 256;
constexpr float LN_EPS = 1e-5f;
constexpr float DN_ALPHA = 1.41421356237309515f;

__device__ __forceinline__ unsigned f2bf(float f) { unsigned u = __builtin_bit_cast(unsigned, f); return (u + 0x7fffu + ((u >> 16) & 1u)) >> 16; }
typedef __bf16 hwbf16x2 __attribute__((ext_vector_type(2)));
__device__ __forceinline__ unsigned pk2(float lo, float hi) { const f32x2 v = {lo, hi}; return __builtin_bit_cast(unsigned, __builtin_convertvector(v, hwbf16x2)); }
__device__ __forceinline__ float bf2f(unsigned short h) { return __builtin_bit_cast(float, (unsigned)h << 16); }
__device__ __forceinline__ float bflo(unsigned w) { return __builtin_bit_cast(float, w << 16); }
__device__ __forceinline__ float bfhi(unsigned w) { return __builtin_bit_cast(float, w & 0xffff0000u); }
__device__ __forceinline__ float sigmoidf_(float x) { return __builtin_amdgcn_rcpf(1.0f + __expf(-x)); }
constexpr float I8_WS_GU = 127.0f / (6.0f / 32.0f), I8_WS_DN = 127.0f / (6.0f / 64.0f), I8_AS = 127.0f / 10.0f;
__device__ __forceinline__ unsigned pack4_i8(float a, float b, float c, float d) {
    unsigned r = 0u;
    r = __builtin_amdgcn_cvt_pk_u8_f32(a + 128.0f, 0, r); r = __builtin_amdgcn_cvt_pk_u8_f32(b + 128.0f, 1, r);
    r = __builtin_amdgcn_cvt_pk_u8_f32(c + 128.0f, 2, r); r = __builtin_amdgcn_cvt_pk_u8_f32(d + 128.0f, 3, r);
    return r ^ 0x80808080u;
}
__device__ __forceinline__ unsigned pack4_fp8(float a, float b, float c, float d) { int r = __builtin_amdgcn_cvt_pk_fp8_f32(a, b, 0, false); r = __builtin_amdgcn_cvt_pk_fp8_f32(c, d, r, true); return (unsigned)r; }
#define LDS_WAIT() asm volatile("s_waitcnt lgkmcnt(0)" ::: "memory")
#define VM_WAIT() asm volatile("s_waitcnt vmcnt(0)" ::: "memory")
#define WAVE_FENCE() do { asm volatile("s_waitcnt lgkmcnt(0)" ::: "memory"); __builtin_amdgcn_wave_barrier(); } while (0)

template <int X> __device__ __forceinline__ float shx(float v) {
    static_assert(X == 1 || X == 2 || X == 4 || X == 8 || X == 16, "shx: xor distance below 32");
    return __builtin_bit_cast(float, __builtin_amdgcn_ds_swizzle(__builtin_bit_cast(int, v), (X << 10) | 0x1f));
}
template <int X> __device__ __forceinline__ int shxi(int v) { return __builtin_amdgcn_ds_swizzle(v, (X << 10) | 0x1f); }
struct SwapPair { unsigned a, b; };
__device__ __forceinline__ SwapPair swap32(float v) { unsigned a = __builtin_bit_cast(unsigned, v), b = a; asm volatile("" : "+v"(b)); const auto r = __builtin_amdgcn_permlane32_swap(a, b, false, false); return SwapPair{r[0], r[1]}; }
__device__ __forceinline__ float sum32(float v) { const SwapPair r = swap32(v); return __builtin_bit_cast(float, r.a) + __builtin_bit_cast(float, r.b); }
__device__ __forceinline__ float max32(float v) { const SwapPair r = swap32(v); return fmaxf(__builtin_bit_cast(float, r.a), __builtin_bit_cast(float, r.b)); }
__device__ __forceinline__ float min32(float v) { const SwapPair r = swap32(v); return fminf(__builtin_bit_cast(float, r.a), __builtin_bit_cast(float, r.b)); }
__device__ __forceinline__ float partner32(float v, bool upper_half) { const SwapPair r = swap32(v); return __builtin_bit_cast(float, upper_half ? r.a : r.b); }

namespace pg8 {
typedef int i32x4 __attribute__((ext_vector_type(4)));
typedef int i32x8 __attribute__((ext_vector_type(8)));
constexpr int BM = 256, BK = 64, HALF = 128, HTB = HALF * BK * 2  , STAGE_BYTES = 8 * HTB;

__host__ __device__ __forceinline__ int lds_byte(int r, int c) { const int st = (r >> 4) * 2 + (c >> 5), rr = r & 15, cc = c & 31, ob = rr * 64 + cc * 2; return st * 1024 + (ob ^ (((ob >> 9) & 1) << 5)); }
__host__ __device__ __forceinline__ void stage_rc(int b, int& R, int& C) { const int st = b / 1024, sb = b % 1024, swz = sb ^ (((sb >> 9) & 1) << 5); R = (st >> 1) * 16 + swz / 64; C = (st & 1) * 32 + (swz % 64) / 2; }
__host__ __device__ __forceinline__ int perm32(int rho) { const int n = rho >> 4, i = rho & 15; return 8 * (i >> 2) + 4 * n + (i & 3); }

struct Unit { int pm, pn, aux; const char* a; const char* b; };
struct Gemm { int lda, K; };

template <class Epi, class Sched, bool ALIGN_EPI, bool I8 = false>
__device__ __forceinline__ void gemm_phase(LAS unsigned char* lds, const int wave_id, const Gemm g, const Sched& S, const Epi& E) {
    int lane = (int)__builtin_amdgcn_mbcnt_hi(~0u, __builtin_amdgcn_mbcnt_lo(~0u, 0u)); asm volatile("" : "+v"(lane));
    const int wid = wave_id, tid = wave_id * 64 + lane, wr = wid >> 2, wc = wid & 3, fr = lane & 15, fq = lane >> 4;
    const int K = g.K, nt = K / BK, lda = g.lda;
    unsigned voffA[2], voffB[2];
#pragma unroll
    for (int i = 0; i < 2; ++i) { int R, C; stage_rc(tid * 16 + i * 8192, R, C); const int Rb = Epi::PERM ? ((R & ~31) + perm32(R & 31)) : R;
        voffA[i] = (unsigned)(R * lda + C) * 2u; voffB[i] = (unsigned)(Rb * K + C) * 2u; }
    const size_t kstep = (size_t)(BK * 2);
    const size_t hstepA = (size_t)HALF * lda * 2, hstepB = (size_t)HALF * K * 2;
    const unsigned ldsw = (unsigned)wid * 1024u;
    const int aoff = lds_byte(wr * 64 + fr, fq * 8), boff = lds_byte(wc * 32 + fr, fq * 8);
#define PG8_SA(b, h) (((b) * 2 + (h)) * HTB)
#define PG8_SB(b, h) ((4 + (b) * 2 + (h)) * HTB)
#define PG8_STAGE(bufoff, gbase, voff) do { _Pragma("unroll") for (int _i = 0; _i < 2; ++_i) \
        __builtin_amdgcn_global_load_lds((const unsigned*)((const char*)(gbase) + (voff)[_i]), (LAS unsigned*)(lds + (bufoff) + ldsw + _i * 8192), 16, 0, 0); } while (0)
#define PG8_LDA(dst, b, h) do { _Pragma("unroll") for (int m = 0; m < 4; ++m) dst[m] = __builtin_shufflevector(*(const LAS i32x4*)(lds + PG8_SA(b, h) + aoff + m * 2048), *(const LAS i32x4*)(lds + PG8_SA(b, h) + aoff + m * 2048 + 1024), 0, 1, 2, 3, 4, 5, 6, 7); } while (0)
#define PG8_LDB(dst, b, h) do { _Pragma("unroll") for (int n = 0; n < 2; ++n) dst[n] = __builtin_shufflevector(*(const LAS i32x4*)(lds + PG8_SB(b, h) + boff + n * 2048), *(const LAS i32x4*)(lds + PG8_SB(b, h) + boff + n * 2048 + 1024), 0, 1, 2, 3, 4, 5, 6, 7); } while (0)
#define PG8_HALFI(v, k) __builtin_shufflevector(v, v, 4 * (k), 4 * (k) + 1, 4 * (k) + 2, 4 * (k) + 3)
#define PG8_HALF(v, k) __builtin_bit_cast(bf16x8, __builtin_shufflevector(v, v, 4 * (k), 4 * (k) + 1, 4 * (k) + 2, 4 * (k) + 3))
#define PG8_MMA(ai, bj, At, Bt) do { __builtin_amdgcn_s_setprio(1); \
        if constexpr (I8) { _Pragma("unroll") for (int m = 0; m < 4; ++m) _Pragma("unroll") for (int n = 0; n < 2; ++n) { \
            acc[ai][bj][m][n] = __builtin_bit_cast(f32x4, __builtin_amdgcn_mfma_i32_16x16x64_i8(PG8_HALFI(Bt[n], 0), PG8_HALFI(At[m], 0), __builtin_bit_cast(i32x4, acc[ai][bj][m][n]), 0, 0, 0)); \
            acc[ai][bj][m][n] = __builtin_bit_cast(f32x4, __builtin_amdgcn_mfma_i32_16x16x64_i8(PG8_HALFI(Bt[n], 1), PG8_HALFI(At[m], 1), __builtin_bit_cast(i32x4, acc[ai][bj][m][n]), 0, 0, 0)); } } \
        else { _Pragma("unroll") for (int m = 0; m < 4; ++m) _Pragma("unroll") for (int n = 0; n < 2; ++n) { \
            acc[ai][bj][m][n] = __builtin_amdgcn_mfma_f32_16x16x32_bf16(PG8_HALF(Bt[n], 0), PG8_HALF(At[m], 0), acc[ai][bj][m][n], 0, 0, 0); \
            acc[ai][bj][m][n] = __builtin_amdgcn_mfma_f32_16x16x32_bf16(PG8_HALF(Bt[n], 1), PG8_HALF(At[m], 1), acc[ai][bj][m][n], 0, 0, 0); } } \
        __builtin_amdgcn_s_setprio(0); } while (0)
#define PG8_WAIT_V(n) asm volatile("s_waitcnt vmcnt(" #n ")" ::: "memory")
#define PG8_WAIT_L(n) asm volatile("s_waitcnt lgkmcnt(" #n ")" ::: "memory")
#define PG8_BAR __builtin_amdgcn_s_barrier()
#define PG8_SCHED __builtin_amdgcn_sched_barrier(0)
    Unit cur, nxt; int ui = 0;
    if (!S.next(0, cur)) return;
    f32x4 acc[2][2][4][2];
#pragma unroll
    for (int a = 0; a < 2; ++a)
#pragma unroll
        for (int b = 0; b < 2; ++b)
#pragma unroll
            for (int m = 0; m < 4; ++m)
#pragma unroll
                for (int n = 0; n < 2; ++n) acc[a][b][m][n] = (f32x4){0.f, 0.f, 0.f, 0.f};
    i32x8 At[4], B0[2], B1[2];
    const char* cA = cur.a; const char* cB = cur.b;
    PG8_STAGE(PG8_SB(0, 0), cB, voffB); PG8_STAGE(PG8_SB(0, 1), cB + hstepB, voffB); PG8_STAGE(PG8_SA(0, 0), cA, voffA); PG8_STAGE(PG8_SA(0, 1), cA + hstepA, voffA);
    if (wr == 1) PG8_BAR;
    PG8_WAIT_V(2); PG8_BAR;
    PG8_STAGE(PG8_SB(1, 0), cB + kstep, voffB); PG8_STAGE(PG8_SA(1, 0), cA + kstep, voffA); PG8_STAGE(PG8_SB(1, 1), cB + hstepB + kstep, voffB);
    PG8_WAIT_V(6); PG8_BAR;
    for (;;) {
        const bool has_next = S.next(ui + 1, nxt);
        const char* nA = has_next ? nxt.a : cA; const char* nB = has_next ? nxt.b : cB;
#pragma unroll 1
        for (int t = 0; t < nt; t += 2) {
            const bool last = (t == nt - 2);
            const char* a1 = cA + (size_t)(t + 1) * kstep;
            const char* a2 = last ? nA : cA + (size_t)(t + 2) * kstep; const char* b2 = last ? nB : cB + (size_t)(t + 2) * kstep;
            const char* a3 = a2 + kstep; const char* b3 = b2 + kstep;
            PG8_LDB(B0, 0, 0); PG8_LDB(B1, 0, 1); PG8_SCHED; PG8_LDA(At, 0, 0); PG8_STAGE(PG8_SA(1, 1), a1 + hstepA, voffA);
            PG8_WAIT_V(8); PG8_WAIT_L(0); PG8_BAR; PG8_MMA(0, 0, At, B0); PG8_MMA(0, 1, At, B1); PG8_BAR; PG8_SCHED;
            PG8_LDA(At, 0, 1); PG8_STAGE(PG8_SB(0, 0), b2, voffB); PG8_STAGE(PG8_SB(0, 1), b2 + hstepB, voffB); PG8_STAGE(PG8_SA(0, 0), a2, voffA);
            PG8_WAIT_V(8); PG8_WAIT_L(0); PG8_BAR; PG8_MMA(1, 0, At, B0); PG8_MMA(1, 1, At, B1); PG8_BAR; PG8_SCHED;
            PG8_LDB(B0, 1, 0); PG8_LDB(B1, 1, 1); PG8_SCHED; PG8_LDA(At, 1, 0); PG8_STAGE(PG8_SA(0, 1), a2 + hstepA, voffA);
            PG8_WAIT_V(8); PG8_WAIT_L(0); PG8_BAR; PG8_MMA(0, 0, At, B0); PG8_MMA(0, 1, At, B1); PG8_BAR; PG8_SCHED;
            PG8_LDA(At, 1, 1); PG8_STAGE(PG8_SB(1, 0), b3, voffB); PG8_STAGE(PG8_SB(1, 1), b3 + hstepB, voffB); PG8_STAGE(PG8_SA(1, 0), a3, voffA);
            PG8_WAIT_V(8); PG8_WAIT_L(0); PG8_BAR; PG8_MMA(1, 0, At, B0); PG8_MMA(1, 1, At, B1); PG8_BAR; PG8_SCHED;
            if constexpr (Epi::MID) { if (t + 2 == nt / 2) { int fr_m = fr, fq_m = fq; asm volatile("" : "+v"(fr_m), "+v"(fq_m)); E.mid(acc, cur, wr, wc, fr_m, fq_m); } }
        }
        if constexpr (ALIGN_EPI) { if (wr == 0) PG8_BAR; }
        { int fr_e = fr, fq_e = fq; asm volatile("" : "+v"(fr_e), "+v"(fq_e));
          E(acc, cur, wr, wc, fr_e, fq_e);
#if ATT_PROBE == 9
          if constexpr (I8) { asm volatile("" : "+v"(fr_e), "+v"(fq_e)); E(acc, cur, wr, wc, fr_e, fq_e); }
#endif
        }
        if (!has_next) break;
#pragma unroll
        for (int a = 0; a < 2; ++a)
#pragma unroll
            for (int b = 0; b < 2; ++b)
#pragma unroll
                for (int m = 0; m < 4; ++m)
#pragma unroll
                    for (int n = 0; n < 2; ++n) acc[a][b][m][n] = (f32x4){0.f, 0.f, 0.f, 0.f};
        cur = nxt; cA = nA; cB = nB; ++ui;
        if constexpr (ALIGN_EPI) { if (wr == 1) PG8_BAR; }
    }
    PG8_WAIT_V(0);
    if constexpr (!ALIGN_EPI) { if (wr == 0) PG8_BAR; }
    PG8_BAR;
#undef PG8_SA
#undef PG8_SB
#undef PG8_STAGE
#undef PG8_LDA
#undef PG8_LDB
#undef PG8_HALF
#undef PG8_HALFI
#undef PG8_MMA
#undef PG8_WAIT_V
#undef PG8_WAIT_L
#undef PG8_BAR
#undef PG8_SCHED
}
}

namespace pg8 {
constexpr int NXCD = 8, WGM = 8;
struct StaticSched {
    int nM, nN, nwg, G, c; const char* A; const char* B; size_t strideA, strideB;
    __device__ __forceinline__ void init(int M_, int N_, int G_, int c_, const void* A_, int lda, const void* B_, int K) {
        nM = M_ / BM; nN = N_ / BM; nwg = nM * nN; G = G_; c = c_; A = (const char*)A_; B = (const char*)B_; strideA = (size_t)BM * lda * 2; strideB = (size_t)BM * K * 2; }
    __device__ __forceinline__ bool next(int i, Unit& u) const {
        const long L = (long)i * G + c; if (L >= nwg) return false;
        int wgid = (int)L; { const int q = nwg / NXCD, r = nwg % NXCD, xcd = wgid % NXCD, off = wgid / NXCD; wgid = (xcd < r ? xcd * (q + 1) : r * (q + 1) + (xcd - r) * q) + off; }
        const int nig = WGM * nN, gid = wgid / nig, fm = gid * WGM, gsz = (nM - fm) < WGM ? (nM - fm) : WGM;
        u.pm = fm + ((wgid % nig) % gsz); u.pn = (wgid % nig) / gsz; u.aux = 0;
        u.a = A + (size_t)u.pm * strideA; u.b = B + (size_t)u.pn * strideB; return true;
    }
};
struct MoeSched {
    int ntiles, nN, G, v; const LAS int* tile_e; const char* A; const char* W; size_t strideA, strideE, strideB;
    int p0, np; const char* PA; const char* PW; size_t pstrideA, pstrideB;
    __device__ __forceinline__ bool next(int i, Unit& u) const {
        const int L = i * G + v, nmoe = ntiles * nN;
        if (L < nmoe) { const int tile = L / nN, pn = L - tile * nN; const int e = tile_e[tile];
            u.pm = tile; u.pn = pn; u.aux = e; u.a = A + (size_t)tile * strideA; u.b = W + (size_t)e * strideE + (size_t)pn * strideB; return true; }
        const int p = L - nmoe; if (p >= np) return false;
        const int q = p0 + p; u.pm = q >> 2; u.pn = q & 3; u.aux = -1; u.a = PA + (size_t)u.pm * pstrideA; u.b = PW + (size_t)u.pn * pstrideB; return true;
    }
};

#define EPI_LOOP_ROWS for (int ai = 0; ai < 2; ++ai) _Pragma("unroll") for (int m = 0; m < 4; ++m)
__device__ __forceinline__ u32x4 pack8(f32x4 v0, f32x4 v1) { u32x4 w; w.x = pk2(v0[0], v0[1]); w.y = pk2(v0[2], v0[3]); w.z = pk2(v1[0], v1[1]); w.w = pk2(v1[2], v1[3]); return w; }

__device__ __forceinline__ f32x4 i2f4(f32x4 a) { const i32x4 v = __builtin_bit_cast(i32x4, a); return (f32x4){(float)v[0], (float)v[1], (float)v[2], (float)v[3]}; }
template <bool I8IN> struct EpiZ {
    static constexpr bool PERM = true, MID = false;
    bf16 *Q, *KV, *QI, *KI; float* WI; bf16 *U, *SGA, *SGB; const float* rope; const float* rows;
    __device__ __forceinline__ void operator()(const f32x4 (&acc)[2][2][4][2], const Unit& u, int wr, int wc, int fr, int fq) const {
        const int pn = u.pn; bf16* dst; int ldc, cb; unsigned ropemask = 0u; int mode = 0;
        if (pn < 2) { dst = Q; ldc = 512; cb = 256 * pn; ropemask = 0xFu; }
        else if (pn == 2) { dst = KV; ldc = 256; cb = 0; ropemask = 0x3u; }
        else if (pn < 5) { dst = QI; ldc = 512; cb = 256 * (pn - 3); ropemask = 0xFu; }
        else if (pn == 5) { dst = KI; ldc = 64; cb = 0; ropemask = 0x1u; mode = 2; }
        else if (pn < 8) { dst = U; ldc = 512; cb = 256 * (pn - 6); }
        else if (pn < 12) { dst = SGA; ldc = 1024; cb = 256 * (pn - 8); mode = 1; }
        else { dst = SGB; ldc = 1024; cb = 256 * (pn - 12); mode = 1; }
        const int row0 = u.pm * BM + wr * 64 + fr;
        float rsv[2][4];
#pragma unroll
        EPI_LOOP_ROWS { rsv[ai][m] = 1.0f; if constexpr (I8IN) rsv[ai][m] = rows[row0 + ai * HALF + m * 16]; }
        const bool ropewave = ropemask != 0u && !(wc & 1);
#pragma unroll
        for (int ai = 0; ai < 2; ++ai) {
        f32x4 rc[4][4];
#pragma unroll
        for (int m = 0; m < 4; ++m)
#pragma unroll
            for (int q = 0; q < 4; ++q) rc[m][q] = (f32x4){0.f, 0.f, 0.f, 0.f};
        if (ropewave && fq < 2) {
#pragma unroll
            for (int m = 0; m < 4; ++m) { const int pos = (row0 + ai * HALF + m * 16) & (SEQ - 1);
#pragma unroll
                for (int q = 0; q < 4; ++q) rc[m][q] = *(const f32x4*)(rope + pos * 16 + 4 * q); }
        }
        asm volatile("" ::: "memory");
#pragma unroll
        for (int m = 0; m < 4; ++m) {
            const int row = row0 + ai * HALF + m * 16;
            const float rs = rsv[ai][m] * (1.0f / I8_WS_GU);
#pragma unroll
            for (int bj = 0; bj < 2; ++bj) {
                f32x4 v0 = acc[ai][bj][m][0], v1 = acc[ai][bj][m][1];
                if constexpr (I8IN) { v0 = i2f4(v0) * rs; v1 = i2f4(v1) * rs; }
                const int grp = 2 * bj + (wc >> 1);
                if (((ropemask >> grp) & 1u) && !(wc & 1)) {
                    f32x4 p0, p1;
#pragma unroll
                    for (int e = 0; e < 4; ++e) { p0[e] = shx<16>(v0[e]); p1[e] = shx<16>(v1[e]); }
                    if (fq < 2) {
                        const f32x4 c0 = rc[m][0], c1 = rc[m][1], s0 = rc[m][2], s1 = rc[m][3];
                        if (fq == 0) { v0 = v0 * c0 - p0 * s0; v1 = v1 * c1 - p1 * s1; }
                        else         { v0 = v0 * c0 + p0 * s0; v1 = v1 * c1 + p1 * s1; }
                    }
                }
                if (mode == 1) {
#pragma unroll
                    for (int e = 0; e < 4; ++e) { v0[e] = sigmoidf_(v0[e]); v1[e] = sigmoidf_(v1[e]); }
                }
                if (mode == 2) {
                    if (bj == 0) {
                        if (wc < 2) *(u32x4*)(KI + ((size_t)((row >> 5) * 4 + 2 * wc + (fq >> 1)) * 64 + (row & 31) + 32 * (fq & 1)) * 8) = pack8(v0, v1);
                        else if (wc == 2 && fq == 0) { *(f32x4*)(WI + (size_t)row * 8) = v0; *(f32x4*)(WI + (size_t)row * 8 + 4) = v1; }
                    }
                } else if (pn == 2) {
                    u32x2 w8; w8.x = pack4_fp8(v0[0], v0[1], v0[2], v0[3]); w8.y = pack4_fp8(v1[0], v1[1], v1[2], v1[3]);
                    *(u32x2*)((unsigned char*)KV + (size_t)row * 256 + 128 * bj + 32 * wc + 8 * fq) = w8;
                } else {
                    *(u32x4*)(dst + (size_t)row * ldc + cb + 128 * bj + 32 * wc + 8 * fq) = pack8(v0, v1);
                }
            }
        }
        asm volatile("" ::: "memory");
        }
    }
};
struct EpiBf16 {
    static constexpr bool PERM = true, MID = false;
    bf16* O; int ldc, coff; const float* scale;
    __device__ __forceinline__ void operator()(const f32x4 (&acc)[2][2][4][2], const Unit& u, int wr, int wc, int fr, int fq) const {
        const int row0 = u.pm * BM + wr * 64 + fr, col0 = u.pn * BM + wc * 32 + 8 * fq;
        f32x4 sv[2][2];
#pragma unroll
        for (int bj = 0; bj < 2; ++bj)
#pragma unroll
            for (int n = 0; n < 2; ++n) sv[bj][n] = scale ? *(const f32x4*)(scale + col0 + bj * HALF + 4 * n) : (f32x4){1.f, 1.f, 1.f, 1.f};
#pragma unroll
        EPI_LOOP_ROWS {
            bf16* rowp = O + (size_t)(row0 + ai * HALF + m * 16) * ldc + coff + col0;
#pragma unroll
            for (int bj = 0; bj < 2; ++bj) *(u32x4*)(rowp + bj * HALF) = pack8(acc[ai][bj][m][0] * sv[bj][0], acc[ai][bj][m][1] * sv[bj][1]);
        }
    }
};
struct EpiGateMerge {
    static constexpr bool PERM = true, MID = true;
    const bf16* SGA; const bf16* SGB; bf16* O;
    __device__ __forceinline__ void mid(f32x4 (&acc)[2][2][4][2], const Unit& u, int wr, int wc, int fr, int fq) const {
        const int row0 = u.pm * BM + wr * 64 + fr, col0 = u.pn * BM + wc * 32 + 8 * fq;
#pragma unroll
        for (int aq = 0; aq < 4; ++aq) {
            const int ai = aq >> 1;
            u32x4 ga[2][2], gb[2][2];
#pragma unroll
            for (int mm = 0; mm < 2; ++mm)
#pragma unroll
                for (int bj = 0; bj < 2; ++bj) { const size_t off = (size_t)(row0 + ai * HALF + (2 * (aq & 1) + mm) * 16) * 1024 + col0 + bj * HALF; ga[mm][bj] = *(const u32x4*)(SGA + off); gb[mm][bj] = *(const u32x4*)(SGB + off); }
            asm volatile("" ::: "memory");
#pragma unroll
            for (int mm = 0; mm < 2; ++mm)
#pragma unroll
                for (int bj = 0; bj < 2; ++bj) {
                    const int m = 2 * (aq & 1) + mm;
                    const u32x4 a = ga[mm][bj], b = gb[mm][bj];
                    f32x4& v0 = acc[ai][bj][m][0]; f32x4& v1 = acc[ai][bj][m][1];
                    v0[0] *= bflo(a.x) * __builtin_amdgcn_rcpf(bflo(b.x)); v0[1] *= bfhi(a.x) * __builtin_amdgcn_rcpf(bfhi(b.x)); v0[2] *= bflo(a.y) * __builtin_amdgcn_rcpf(bflo(b.y)); v0[3] *= bfhi(a.y) * __builtin_amdgcn_rcpf(bfhi(b.y));
                    v1[0] *= bflo(a.z) * __builtin_amdgcn_rcpf(bflo(b.z)); v1[1] *= bfhi(a.z) * __builtin_amdgcn_rcpf(bfhi(b.z)); v1[2] *= bflo(a.w) * __builtin_amdgcn_rcpf(bflo(b.w)); v1[3] *= bfhi(a.w) * __builtin_amdgcn_rcpf(bfhi(b.w));
                }
            asm volatile("" ::: "memory");
        }
    }
    __device__ __forceinline__ void operator()(const f32x4 (&acc)[2][2][4][2], const Unit& u, int wr, int wc, int fr, int fq) const {
        const int row0 = u.pm * BM + wr * 64 + fr, col0 = u.pn * BM + wc * 32 + 8 * fq;
        u32x4 gq[2][4][2];
#pragma unroll
        EPI_LOOP_ROWS
#pragma unroll
            for (int bj = 0; bj < 2; ++bj) gq[ai][m][bj] = *(const u32x4*)(SGB + (size_t)(row0 + ai * HALF + m * 16) * 1024 + col0 + bj * HALF);
        asm volatile("" ::: "memory");
#pragma unroll
        EPI_LOOP_ROWS {
            const size_t off = (size_t)(row0 + ai * HALF + m * 16) * 1024 + col0;
#pragma unroll
            for (int bj = 0; bj < 2; ++bj) {
                const u32x4 g = gq[ai][m][bj];
                f32x4 v0 = acc[ai][bj][m][0], v1 = acc[ai][bj][m][1];
                v0[0] *= bflo(g.x); v0[1] *= bfhi(g.x); v0[2] *= bflo(g.y); v0[3] *= bfhi(g.y); v1[0] *= bflo(g.z); v1[1] *= bfhi(g.z); v1[2] *= bflo(g.w); v1[3] *= bfhi(g.w);
                *(u32x4*)(O + off + bj * HALF) = pack8(v0, v1);
            }
        }
        asm volatile("" ::: "memory");
    }
};
struct EpiResid {
    static constexpr bool PERM = true, MID = false;
    const bf16* X; bf16* V; float alpha;
    __device__ __forceinline__ void operator()(const f32x4 (&acc)[2][2][4][2], const Unit& u, int wr, int wc, int fr, int fq) const {
        const int row0 = u.pm * BM + wr * 64 + fr, col0 = u.pn * BM + wc * 32 + 8 * fq;
        u32x4 xv[2][4][2];
#pragma unroll
        EPI_LOOP_ROWS
#pragma unroll
            for (int bj = 0; bj < 2; ++bj) xv[ai][m][bj] = *(const u32x4*)(X + (size_t)(row0 + ai * HALF + m * 16) * 1024 + col0 + bj * HALF);
        asm volatile("" ::: "memory");
#pragma unroll
        EPI_LOOP_ROWS
#pragma unroll
            for (int bj = 0; bj < 2; ++bj) { const u32x4 w = xv[ai][m][bj];
                *(u32x4*)(V + (size_t)(row0 + ai * HALF + m * 16) * 1024 + col0 + bj * HALF) =
                    pack8((f32x4){bflo(w.x), bfhi(w.x), bflo(w.y), bfhi(w.y)} * alpha + acc[ai][bj][m][0], (f32x4){bflo(w.z), bfhi(w.z), bflo(w.w), bfhi(w.w)} * alpha + acc[ai][bj][m][1]); }
        asm volatile("" ::: "memory");
    }
};
__device__ __forceinline__ f32x4 swiglu4(f32x4 g, f32x4 u) {
    f32x4 gt, up, sg;
#pragma unroll
    for (int e = 0; e < 4; ++e) { gt[e] = fminf(g[e], 7.0f); up[e] = fminf(fmaxf(u[e], -7.0f), 7.0f); }
    const f32x4 ea = gt * (-1.702f * 1.44269504088896341f);
#pragma unroll
    for (int e = 0; e < 4; ++e) sg[e] = __builtin_amdgcn_exp2f(ea[e]);
    sg = sg + 1.0f;
#pragma unroll
    for (int e = 0; e < 4; ++e) sg[e] = __builtin_amdgcn_rcpf(sg[e]);
    const f32x4 as4 = (f32x4){I8_AS, I8_AS, I8_AS, I8_AS};
    return (gt * sg) * __builtin_elementwise_fma(up, as4, as4);
}
struct EpiSwigluI8 {
    static constexpr bool PERM = true, MID = false;
    const float* bgu; const float* rows; unsigned char* ACT;
    __device__ __forceinline__ void operator()(const f32x4 (&acc)[2][2][4][2], const Unit& u, int wr, int wc, int fr, int fq) const {
        const int row0 = u.pm * BM + wr * 64 + fr, cin = wc * 32 + 8 * fq, col0 = u.pn * HALF + cin;
        const float* bb = bgu + (size_t)u.aux * 2048 + col0;
        const f32x4 bg0 = *(const f32x4*)(bb), bg1 = *(const f32x4*)(bb + 4), bu0 = *(const f32x4*)(bb + 1024), bu1 = *(const f32x4*)(bb + 1028);
        float rsv[2][4];
#pragma unroll
        EPI_LOOP_ROWS rsv[ai][m] = rows[row0 + ai * HALF + m * 16];
        asm volatile("" ::: "memory");
#pragma unroll
        EPI_LOOP_ROWS {
            const int row = row0 + ai * HALF + m * 16; const float rs = rsv[ai][m] * (1.0f / I8_WS_GU);
            const f32x4 rs4 = (f32x4){rs, rs, rs, rs};
            const f32x4 o0 = swiglu4(__builtin_elementwise_fma(i2f4(acc[ai][0][m][0]), rs4, bg0), __builtin_elementwise_fma(i2f4(acc[ai][1][m][0]), rs4, bu0));
            const f32x4 o1 = swiglu4(__builtin_elementwise_fma(i2f4(acc[ai][0][m][1]), rs4, bg1), __builtin_elementwise_fma(i2f4(acc[ai][1][m][1]), rs4, bu1));
            u32x2 w; w.x = pack4_i8(o0[0], o0[1], o0[2], o0[3]); w.y = pack4_i8(o1[0], o1[1], o1[2], o1[3]);
            *(u32x2*)(ACT + (size_t)row * 1024 + col0) = w;
        }
        asm volatile("" ::: "memory");
    }
};
struct EpiDownI8 {
    static constexpr bool PERM = true, MID = false;
    const float* bdn; const float* rowg; bf16* YR;
    __device__ __forceinline__ void operator()(const f32x4 (&acc)[2][2][4][2], const Unit& u, int wr, int wc, int fr, int fq) const {
        const int row0 = u.pm * BM + wr * 64 + fr, col0 = u.pn * BM + wc * 32 + 8 * fq;
        const float* bp = bdn + (size_t)u.aux * 1024 + col0;
        constexpr float rs = 1.0f / (I8_AS * I8_WS_DN);
        f32x4 bv[2][2]; float gv[2][4];
#pragma unroll
        for (int bj = 0; bj < 2; ++bj) { bv[bj][0] = *(const f32x4*)(bp + bj * HALF); bv[bj][1] = *(const f32x4*)(bp + bj * HALF + 4); }
#pragma unroll
        EPI_LOOP_ROWS gv[ai][m] = rowg[row0 + ai * HALF + m * 16];
        asm volatile("" ::: "memory");
#pragma unroll
        EPI_LOOP_ROWS {
            const int row = row0 + ai * HALF + m * 16; const float gt = gv[ai][m];
#pragma unroll
            for (int bj = 0; bj < 2; ++bj)
                *(u32x4*)(YR + (size_t)row * 1024 + col0 + bj * HALF) = pack8((i2f4(acc[ai][bj][m][0]) * rs + bv[bj][0]) * gt, (i2f4(acc[ai][bj][m][1]) * rs + bv[bj][1]) * gt);
        }
        asm volatile("" ::: "memory");
    }
};
struct EpiPleGateI8 {
    static constexpr bool PERM = true, MID = false;
    const bf16* P; const float* rows; bf16* O;
    __device__ __forceinline__ void operator()(const f32x4 (&acc)[2][2][4][2], const Unit& u, int wr, int wc, int fr, int fq) const {
        const int row0 = u.pm * BM + wr * 64 + fr, col0 = u.pn * BM + wc * 32 + 8 * fq;
        float rsv[2][4];
#pragma unroll
        EPI_LOOP_ROWS rsv[ai][m] = rows[row0 + ai * HALF + m * 16];
#pragma unroll
        for (int ai = 0; ai < 2; ++ai) {
            u32x4 gq[4][2];
#pragma unroll
            for (int m = 0; m < 4; ++m)
#pragma unroll
                for (int bj = 0; bj < 2; ++bj) gq[m][bj] = *(const u32x4*)(P + (size_t)(row0 + ai * HALF + m * 16) * 1024 + col0 + bj * HALF);
            asm volatile("" ::: "memory");
#pragma unroll
            for (int m = 0; m < 4; ++m) {
                const int row = row0 + ai * HALF + m * 16; const size_t off = (size_t)row * 1024 + col0; const float rs = rsv[ai][m] * (1.0f / I8_WS_GU);
#pragma unroll
                for (int bj = 0; bj < 2; ++bj) {
                    const u32x4 g = gq[m][bj];
                    f32x4 v0 = i2f4(acc[ai][bj][m][0]) * rs, v1 = i2f4(acc[ai][bj][m][1]) * rs;
                    v0[0] = sigmoidf_(v0[0]) * bflo(g.x); v0[1] = sigmoidf_(v0[1]) * bfhi(g.x); v0[2] = sigmoidf_(v0[2]) * bflo(g.y); v0[3] = sigmoidf_(v0[3]) * bfhi(g.y);
                    v1[0] = sigmoidf_(v1[0]) * bflo(g.z); v1[1] = sigmoidf_(v1[1]) * bfhi(g.z); v1[2] = sigmoidf_(v1[2]) * bflo(g.w); v1[3] = sigmoidf_(v1[3]) * bfhi(g.w);
                    *(u32x4*)(O + off + bj * HALF) = pack8(v0, v1);
                }
            }
            asm volatile("" ::: "memory");
        }
    }
};
struct EpiSwigluPle {
    static constexpr bool PERM = true, MID = false;
    EpiSwigluI8 moe; EpiPleGateI8 ple;
    __device__ __forceinline__ void operator()(const f32x4 (&acc)[2][2][4][2], const Unit& u, int wr, int wc, int fr, int fq) const { if (u.aux >= 0) moe(acc, u, wr, wc, fr, fq); else ple(acc, u, wr, wc, fr, fq); }
};
struct EpiDownPle {
    static constexpr bool PERM = true, MID = false;
    EpiDownI8 moe; EpiPleGateI8 ple;
    __device__ __forceinline__ void operator()(const f32x4 (&acc)[2][2][4][2], const Unit& u, int wr, int wc, int fr, int fq) const { if (u.aux >= 0) moe(acc, u, wr, wc, fr, fq); else ple(acc, u, wr, wc, fr, fq); }
};
#undef EPI_LOOP_ROWS
}

constexpr size_t MiB = 1u << 20;
constexpr size_t WS_CTL = 0, CTL_ZERO_BYTES = 1 * MiB;
constexpr int CW_BAR = 4096;
constexpr size_t LW_WIN = 0, LW_WUPA = 8 * MiB, LW_WUPB = 9 * MiB, LW_POOL = 10 * MiB, LW_WOUT = 11 * MiB, LW_PLEG = 13 * MiB, LW_PLEP = 15 * MiB, LW_WGU = 16 * MiB, LW_WDN = 144 * MiB, LW_SIZE = 208 * MiB;
constexpr size_t WS_W = 1 * MiB;
constexpr size_t WS_ROPE = WS_W + DEPTH * LW_SIZE;
constexpr size_t WS_PB16 = WS_ROPE + 1 * MiB;
constexpr size_t WS_XF = WS_PB16 + 16 * MiB;
constexpr size_t WS_XB = WS_XF + 64 * MiB;
constexpr size_t WS_Q = WS_XB + 32 * MiB;
constexpr size_t WS_KV = WS_Q + 16 * MiB;
constexpr size_t WS_QI = WS_KV + 8 * MiB;
constexpr size_t WS_KI = WS_QI + 16 * MiB;
constexpr size_t WS_WI = WS_KI + 2 * MiB;
constexpr size_t WS_U = WS_WI + 1 * MiB;
constexpr size_t WS_SGA = WS_U + 16 * MiB;
constexpr size_t WS_SGB = WS_SGA + 32 * MiB;
constexpr size_t WS_YAYP = WS_SGB + 32 * MiB;
constexpr size_t WS_DP = WS_YAYP + 32 * MiB;
constexpr size_t WS_T1 = WS_DP + 16 * MiB;
constexpr size_t WS_MRG = WS_T1 + 64 * MiB;
constexpr size_t WS_X1F = WS_MRG + 32 * MiB;
constexpr size_t WS_X1B = WS_X1F + 64 * MiB;
constexpr size_t WS_XS = WS_X1B + 32 * MiB;
constexpr size_t WS_ACT = WS_XS + 144 * MiB;
constexpr size_t WS_YR = WS_ACT + 144 * MiB;
constexpr size_t WS_PLEP = WS_YR + 144 * MiB;
constexpr size_t WS_PLEV = WS_PLEP + 32 * MiB;
constexpr size_t WS_ROUTE = WS_PLEV + 32 * MiB;
constexpr size_t RT_TOPI = 0, RT_GATE = 256 * 1024, RT_LRANK = 512 * 1024, RT_TOKROW = 768 * 1024, RT_ROWG = 1024 * 1024, RT_HIST = 1536 * 1024, RT_TILE = 1664 * 1024, RT_ROWS = 1700 * 1024, RT_X1S = 1472 * 1024, RT_XQS = 1988 * 1024;
constexpr size_t WS_END = WS_ROUTE + 3 * MiB;
static_assert((size_t)RMAX * 1024 * 2 == 144 * MiB, "row buffers");
static_assert(RT_ROWG + (size_t)RMAX * 4 <= RT_X1S && RT_X1S + (size_t)M * 4 <= RT_HIST && RT_HIST + (size_t)DEPTH * 256 * 32 * 4 <= RT_TILE && RT_ROWS + (size_t)RMAX * 4 <= RT_XQS, "routing map");

constexpr int RING_BYTES = 131072;
constexpr int XTRA_OFF = RING_BYTES;
constexpr int XTRA_BYTES = 24576;
constexpr int MISC_OFF = XTRA_OFF + XTRA_BYTES;
constexpr int LDS_BYTES = MISC_OFF + 4096;
constexpr int NWAVES = 8;

#define XB_TMO      128
#define XB_XCNT(j)  (256  + 64 * (j))
#define XB_XSUB(j)  (1280 + 64 * (j))
#define XB_XGEN(j)  (2304 + 64 * (j))
#define XB_TOP      3328
#define XB_TOPGEN   3392
#define XCD_BAR_WORDS 3456
#define XB_SPIN_CAP (1u << 18)

__device__ __forceinline__ unsigned xb_ld(unsigned* p)              { return __hip_atomic_load(p, __ATOMIC_RELAXED, __HIP_MEMORY_SCOPE_AGENT); }
__device__ __forceinline__ unsigned xb_add(unsigned* p, unsigned v) { return __hip_atomic_fetch_add(p, v, __ATOMIC_RELAXED, __HIP_MEMORY_SCOPE_AGENT); }
__device__ __forceinline__ unsigned xb_xcc_id() { return (unsigned)__builtin_amdgcn_s_getreg((3 << 11) | 20) & 0xFu; }
#define XB_SPIN(cond, bar) do { unsigned _sp = 0; while (cond) { __builtin_amdgcn_s_sleep(1); \
    if ((++_sp & 255u) == 0u) { if (xb_ld(&(bar)[XB_TMO])) break; if (_sp > XB_SPIN_CAP) { atomicAdd(&(bar)[XB_TMO], 1u); break; } } } } while (0)

struct XcdBarrier {
    unsigned* bar; unsigned x;
    volatile LAS unsigned* st;
};

__device__ __forceinline__ XcdBarrier xcd_barrier_post(unsigned* bar, volatile LAS unsigned* st) {
    XcdBarrier b; b.bar = bar; b.x = xb_xcc_id(); b.st = st;
    if (threadIdx.x == 0) (void)xb_add(&bar[XB_XCNT(b.x)], 1u);
    return b;
}
__device__ __forceinline__ void xcd_barrier_complete(unsigned* bar, unsigned x, unsigned& nloc, unsigned& nx) {
    const unsigned G = gridDim.x * gridDim.y * gridDim.z;
    unsigned sum, cnt, mine, sp = 0u;
    for (;;) {
        sum = 0u; cnt = 0u; mine = 0u;
#pragma unroll
        for (unsigned j = 0; j < 16; ++j) { const unsigned c = xb_ld(&bar[XB_XCNT(j)]); sum += c; cnt += (c > 0u) ? 1u : 0u; mine = (j == x) ? c : mine; }
        if (sum == G) break;
        __builtin_amdgcn_s_sleep(1);
        if ((++sp & 255u) == 0u) { if (xb_ld(&bar[XB_TMO])) break; if (sp > XB_SPIN_CAP) { atomicAdd(&bar[XB_TMO], 1u); break; } }
    }
    nloc = mine > 0u ? mine : 1u; nx = cnt > 0u ? cnt : 1u;
}

__device__ __forceinline__ void xcd_barrier(const XcdBarrier& b) {
    asm volatile("s_waitcnt vmcnt(0)" ::: "memory");
    __syncthreads();
    if (threadIdx.x == 0) {
        unsigned* bar = b.bar; { size_t zo_ = 0; asm volatile("" : "+s"(zo_)); bar += zo_; }
        __builtin_amdgcn_s_waitcnt(0);
        unsigned bx = b.x; asm volatile("" : "+s"(bx));
        unsigned nloc = b.st[0], nx = b.st[1];
        if (nloc == 0u) { xcd_barrier_complete(bar, bx, nloc, nx); b.st[0] = nloc; b.st[1] = nx; }
        const unsigned old = xb_add(&bar[XB_XSUB(bx)], 1u);
        const unsigned gen = old / nloc;
        if (old + 1u == (gen + 1u) * nloc) {
            __builtin_amdgcn_fence(__ATOMIC_RELEASE, "agent");
            asm volatile("s_waitcnt vmcnt(0)" ::: "memory");
            const unsigned og = xb_add(&bar[XB_TOP], 1u);
            const unsigned tg = og / nx;
            if (og + 1u == (tg + 1u) * nx) xb_add(&bar[XB_TOPGEN], 1u);
            else XB_SPIN(xb_ld(&bar[XB_TOPGEN]) == tg, bar);
            __builtin_amdgcn_fence(__ATOMIC_ACQUIRE, "agent");
            xb_add(&bar[XB_XGEN(bx)], 1u);
            asm volatile("s_waitcnt vmcnt(0)" ::: "memory");
        } else {
            XB_SPIN(xb_ld(&bar[XB_XGEN(bx)]) == gen, bar);
            __builtin_amdgcn_fence(__ATOMIC_ACQUIRE, "agent");
            asm volatile("s_waitcnt vmcnt(0)" ::: "memory");
        }
    }
    __syncthreads();
}


template <int CTRL> __device__ __forceinline__ float dppx(float v) { return __builtin_bit_cast(float, __builtin_amdgcn_update_dpp(0, __builtin_bit_cast(int, v), CTRL, 0xf, 0xf, false)); }
__device__ __forceinline__ float wave_sum(float v, int) { v += dppx<0xB1>(v); v += dppx<0x4E>(v); v += dppx<0x141>(v); v += dppx<0x140>(v); v += shx<16>(v); return sum32(v); }
__device__ __forceinline__ float wave_max(float v, int) { v = fmaxf(v, dppx<0xB1>(v)); v = fmaxf(v, dppx<0x4E>(v)); v = fmaxf(v, dppx<0x141>(v)); v = fmaxf(v, dppx<0x140>(v)); v = fmaxf(v, shx<16>(v)); return max32(v); }
__device__ __forceinline__ float wave_min(float v, int) { v = fminf(v, dppx<0xB1>(v)); v = fminf(v, dppx<0x4E>(v)); v = fminf(v, dppx<0x141>(v)); v = fminf(v, dppx<0x140>(v)); v = fminf(v, shx<16>(v)); return min32(v); }
struct MapId { __device__ __forceinline__ int operator()(int n) const { return n; } };
struct MapWin { __device__ __forceinline__ int operator()(int n) const {
    if (n < 512) return n;
    if (n < 768) return n;
    if (n < 1352) return n;
    if (n < 1536) return -1;
    if (n < 2048) return 1352 + (n - 1536);
    if (n < 3072) return 1864 + (n - 2048);
    return 2888 + (n - 3072); } };
struct MapGU { __device__ __forceinline__ int operator()(int n) const { const int t = n >> 8, w = n & 255; return w < 128 ? t * 128 + w : 1024 + t * 128 + (w - 128); } };

__device__ __forceinline__ void ln_regs(f32x4 (&v)[4], const float* g, const float* b, int lane) {
    float s = 0.f;
#pragma unroll
    for (int j = 0; j < 4; ++j) s += (v[j].x + v[j].y) + (v[j].z + v[j].w);
    const float mean = wave_sum(s, lane) * (1.f / D); float s2 = 0.f;
#pragma unroll
    for (int j = 0; j < 4; ++j) { v[j] = v[j] - mean; s2 += (v[j].x * v[j].x + v[j].y * v[j].y) + (v[j].z * v[j].z + v[j].w * v[j].w); }
    const float rstd = 1.f / sqrtf(wave_sum(s2, lane) * (1.f / D) + LN_EPS);
#pragma unroll
    for (int j = 0; j < 4; ++j) { const f32x4 gg = *(const f32x4*)(g + 4 * lane + 256 * j), bb = *(const f32x4*)(b + 4 * lane + 256 * j); v[j] = v[j] * rstd * gg + bb; }
}
__device__ __forceinline__ void store_row_f32(float* row, const f32x4 (&v)[4], int lane) {
#pragma unroll
    for (int j = 0; j < 4; ++j) *(f32x4*)(row + 4 * lane + 256 * j) = v[j];
}
__device__ __forceinline__ void store_row_i8(unsigned char* row, float* scale_out, const f32x4 (&v)[4], int lane) {
    float mx = 0.f;
#pragma unroll
    for (int j = 0; j < 4; ++j) mx = fmaxf(fmaxf(mx, fmaxf(fabsf(v[j].x), fabsf(v[j].y))), fmaxf(fabsf(v[j].z), fabsf(v[j].w)));
    mx = fmaxf(wave_max(mx, lane), 1e-20f); const float inv = 127.0f / mx;
    if (lane == 0) *scale_out = mx * (1.0f / 127.0f);
#pragma unroll
    for (int j = 0; j < 4; ++j) *(unsigned*)(row + 4 * lane + 256 * j) = pack4_i8(v[j].x * inv, v[j].y * inv, v[j].z * inv, v[j].w * inv);
}
__device__ __forceinline__ void store_row_bf16(bf16* row, const f32x4 (&v)[4], int lane) {
#pragma unroll
    for (int j = 0; j < 4; ++j) { u32x2 w; w.x = pk2(v[j].x, v[j].y); w.y = pk2(v[j].z, v[j].w); *(u32x2*)(row + 4 * lane + 256 * j) = w; }
}

typedef __bf16 bf16x2_t __attribute__((ext_vector_type(2)));
typedef short v4i16_t __attribute__((ext_vector_type(4)));
typedef int v2i32_t __attribute__((ext_vector_type(2)));
typedef short s16x4_t __attribute__((ext_vector_type(4)));
__device__ __forceinline__ float dot2bf(unsigned a, unsigned b, float c) { return __builtin_amdgcn_fdot2_f32_bf16(__builtin_bit_cast(bf16x2_t, a), __builtin_bit_cast(bf16x2_t, b), c, false); }

__device__ __forceinline__ int score_bin(float v, float vmin, float scale) { const int b = (int)((v - vmin) * scale); return b > 511 ? 511 : b; }

__device__ __forceinline__ void attn_unit(LAS unsigned char* lds, const int wave, const int lane_in, const int b, const int t0,
                                          const bf16* QI, const bf16* KI, const float* WI, const bf16* Q, const bf16* KV, bf16* YAYP) {
    int lane = lane_in; asm volatile("" : "+v"(lane));
    const int m0 = b * SEQ + t0;
    const int r = lane & 31, h = lane >> 5;
    const int qit = 2 * ((r >> 2) & 1) + (r >> 4), hd = (r & 3) + 4 * ((r >> 3) & 1);
    bf16x8 Af[4][4];
#pragma unroll
    for (int mt = 0; mt < 4; ++mt)
#pragma unroll
        for (int ks = 0; ks < 4; ++ks) Af[mt][ks] = *(const bf16x8*)(QI + (size_t)(m0 + 4 * mt + qit) * 512 + hd * 64 + 16 * ks + 8 * h);
    f32x4 wv[4][2][2];
#pragma unroll
    for (int mt = 0; mt < 4; ++mt)
#pragma unroll
        for (int qq = 0; qq < 2; ++qq) { const float* wp = WI + (size_t)(m0 + 4 * mt + 2 * h + qq) * 8; wv[mt][qq][0] = *(const f32x4*)wp; wv[mt][qq][1] = *(const f32x4*)(wp + 4); }
    for (int rep2_ = 0; rep2_ < (ATT_PROBE == 1 ? 2 : 1); ++rep2_) {
    const int nkt = (t0 + 16 + 31) >> 5;
    LAS _Float16* SCH = (LAS _Float16*)lds;
    const bf16* kib = KI + (size_t)b * SEQ * 64;
#pragma unroll 1
    for (int kt0 = wave; kt0 < nkt; kt0 += 32) {
        bf16x8 Bq[4][4];
#pragma unroll
        for (int u = 0; u < 4; ++u) {
            if (kt0 + 8 * u < nkt) {
#pragma unroll
                for (int ks = 0; ks < 4; ++ks) Bq[u][ks] = *(const bf16x8*)(kib + ((size_t)((kt0 + 8 * u) * 4 + ks) * 64 + lane) * 8);
            }
        }
#pragma unroll
        for (int u = 0; u < 4; ++u) {
            if (kt0 + 8 * u < nkt) {
                const int key = 32 * (kt0 + 8 * u) + r;
#pragma unroll
                for (int mt = 0; mt < 4; ++mt) {
                    f32x16 acc;
#pragma unroll
                    for (int i = 0; i < 16; ++i) acc[i] = 0.f;
#pragma unroll
                    for (int ks = 0; ks < 4; ++ks) acc = __builtin_amdgcn_mfma_f32_32x32x16_bf16(Af[mt][ks], Bq[u][ks], acc, 0, 0, 0);
                    float s0 = 0.f, s1 = 0.f;
#pragma unroll
                    for (int i = 0; i < 8; ++i) { s0 += fmaxf(acc[i], 0.f) * wv[mt][0][i >> 2][i & 3]; s1 += fmaxf(acc[8 + i], 0.f) * wv[mt][1][i >> 2][i & 3]; }
                    const int qa = 4 * mt + 2 * h;
                    SCH[qa * 4096 + key] = (_Float16)s0; SCH[(qa + 1) * 4096 + key] = (_Float16)s1;
                }
            }
        }
    }
    }
    __syncthreads();
    asm volatile("" : "+v"(lane));
    LAS unsigned* HIST = (LAS unsigned*)(lds + XTRA_OFF + wave * 2048);
#pragma unroll 1
    for (int qs3_ = 0; qs3_ < 2 * (ATT_PROBE == 2 ? 2 : 1); ++qs3_) {
    asm volatile("" : "+v"(lane));
    const int qi = 2 * wave + (qs3_ & 1);
    const LAS _Float16* SCw = (const LAS _Float16*)lds + qi * 4096;
    LAS unsigned short* SEL = (LAS unsigned short*)(lds + XTRA_OFF + 16384 + wave * 1024 + (qs3_ & 1) * 512);
    const int n = t0 + qi + 1;
    const unsigned long long ltmask = (1ull << lane) - 1ull;
    {
    if (n <= NSEL) {
        for (int i = lane; i < NSEL; i += 64) SEL[i] = (unsigned short)(i < n ? i : 0);
    } else {
        const int nj = (n + 63) >> 6;
        float sv[64]; float vmax = -INFINITY, vmin = INFINITY;
#pragma unroll
        for (int gq = 0; gq < 8; ++gq) {
            if (512 * (gq + 1) <= n) {
#pragma unroll
                for (int jj = 0; jj < 8; ++jj) { const int j = 8 * gq + jj; const float v = (float)SCw[64 * j + lane]; sv[j] = v; vmax = fmaxf(vmax, v); vmin = fminf(vmin, v); }
            } else if (512 * gq < n) {
#pragma unroll
                for (int jj = 0; jj < 8; ++jj) { const int j = 8 * gq + jj; const float v = (float)SCw[64 * j + lane]; const bool in = 64 * j + lane < n;
                    sv[j] = in ? v : -INFINITY; vmax = fmaxf(vmax, sv[j]); vmin = fminf(vmin, in ? v : INFINITY); }
            } else {
#pragma unroll
                for (int jj = 0; jj < 8; ++jj) sv[8 * gq + jj] = -INFINITY;
            }
        }
        vmax = wave_max(vmax, lane); vmin = wave_min(vmin, lane);
        const float range = vmax - vmin, scale = range > 0.f ? 512.0f / range : 0.f;
#pragma unroll
        for (int i = 0; i < 8; ++i) HIST[lane * 8 + i] = 0u;
        WAVE_FENCE();
        int ba[64];
#pragma unroll
        for (int gq = 0; gq < 8; ++gq) {
            if (512 * (gq + 1) <= n) {
#pragma unroll
                for (int jj = 0; jj < 8; ++jj) { const int j = 8 * gq + jj; const int bq = score_bin(sv[j], vmin, scale); ba[j] = bq * 4;
                    __hip_atomic_fetch_add(HIST + bq, 1u, __ATOMIC_RELAXED, __HIP_MEMORY_SCOPE_WORKGROUP); }
            } else if (512 * gq < n) {
#pragma unroll
                for (int jj = 0; jj < 8; ++jj) { const int j = 8 * gq + jj; const bool in = 64 * j + lane < n; const int bq = in ? score_bin(sv[j], vmin, scale) : 0; ba[j] = in ? bq * 4 : -4;
                    if (in) __hip_atomic_fetch_add(HIST + bq, 1u, __ATOMIC_RELAXED, __HIP_MEMORY_SCOPE_WORKGROUP); }
            } else {
#pragma unroll
                for (int jj = 0; jj < 8; ++jj) ba[8 * gq + jj] = -4;
            }
        }
        WAVE_FENCE();
        unsigned wds[8]; unsigned sl = 0u;
#pragma unroll
        for (int i = 0; i < 8; ++i) { wds[i] = HIST[lane * 8 + i]; sl += wds[i]; }
        unsigned T = sl;
#pragma unroll
        for (int off = 1; off < 64; off <<= 1) { const unsigned o = (unsigned)__builtin_amdgcn_ds_bpermute((lane + off) << 2, (int)T); if (lane + off < 64) T += o; }
        const unsigned E = T - sl;
        int tb = 0; unsigned cab = 0u, ctb = 0u;
        { unsigned run = E; bool found = false;
#pragma unroll
          for (int bb = 7; bb >= 0; --bb) { const unsigned c = wds[bb];
              if (!found) { if (run + c >= (unsigned)NSEL) { found = true; tb = lane * 8 + bb; cab = run; ctb = c; } else run += c; } } }
        const unsigned long long bal = __ballot(E < (unsigned)NSEL && T >= (unsigned)NSEL);
        const int L = __ffsll((long long)bal) - 1;
        tb = __builtin_amdgcn_readlane(tb, L); cab = (unsigned)__builtin_amdgcn_readlane((int)cab, L); ctb = (unsigned)__builtin_amdgcn_readlane((int)ctb, L);
        const int need = NSEL - (int)cab;
        const int tb4 = tb * 4;
        WAVE_FENCE();
        LAS float* CVAL = (LAS float*)HIST; LAS int* CKEY = (LAS int*)(HIST + 256);
        unsigned pc = 0u;
#pragma unroll
        for (int j = 0; j < 64; ++j) pc += (ba[j] > tb4 ? 1u : 0u) + (ba[j] == tb4 ? 65536u : 0u);
        unsigned pi = pc;
#pragma unroll
        for (int off = 1; off < 64; off <<= 1) { const unsigned o = (unsigned)__builtin_amdgcn_ds_bpermute((lane - off) << 2, (int)pi); if (lane >= off) pi += o; }
        pi -= pc;
        const bool docand = ctb <= 256u;
        int tb4c = tb4; asm volatile("" : "+s"(tb4c));
        LAS unsigned char* dummy = lds + MISC_OFF + 1024 + wave * 256 + lane * 4;
        unsigned os = (pi & 0xffffu) * 2u, oc = (pi >> 16) * 4u;
        LAS unsigned char* selb = (LAS unsigned char*)SEL; LAS unsigned char* ckb = (LAS unsigned char*)CKEY;
#pragma unroll
        for (int gq = 0; gq < 8; ++gq) {
            if (512 * gq < n) {
#pragma unroll
                for (int jj = 0; jj < 8; ++jj) { const int j = 8 * gq + jj; const int key = 64 * j + lane;
                    const bool isel = ba[j] > tb4c;
                    *(LAS unsigned short*)(isel ? selb + os : dummy) = (unsigned short)key; os += isel ? 2u : 0u;
                    if (docand) { const bool ic = ba[j] == tb4c;
                        *(LAS int*)(ic ? ckb + oc : dummy) = key; oc += ic ? 4u : 0u; } }
            }
        }
        int nsel = (int)cab; const int ncand = (int)ctb;
        WAVE_FENCE();
        if (docand) for (int i = lane; i < ncand; i += 64) CVAL[i] = (float)SCw[CKEY[i]];
        (void)nj;
        WAVE_FENCE();
        if (ncand <= 256) {
            for (int c0 = 0; c0 < ncand; c0 += 64) {
                const int i = c0 + lane; const bool act = i < ncand; const float vi = act ? CVAL[i] : 0.f; const int ki = act ? CKEY[i] : 0;
                int rank = 0;
                for (int jj = 0; jj < ncand; ++jj) { const float vj = CVAL[jj]; const int kj = CKEY[jj]; rank += (vj > vi || (vj == vi && kj < ki)) ? 1 : 0; }
                const bool take = act && rank < need; const unsigned long long ms = __ballot(take);
                if (take) SEL[nsel + __popcll(ms & ltmask)] = (unsigned short)ki;
                nsel += __popcll(ms);
            }
        } else {
            for (int j = 0; j < nj; ++j) {
                const int key = 64 * j + lane; const bool in = key < n; const float v = in ? (float)SCw[key] : 0.f; const bool ic = in && score_bin(v, vmin, scale) == tb;
                if (__ballot(ic) == 0ull) continue;
                int rank = 0;
                for (int jj = 0; jj < n; ++jj) { const float vj = (float)SCw[jj]; rank += (score_bin(vj, vmin, scale) == tb && (vj > v || (vj == v && jj < key))) ? 1 : 0; }
                const bool take = ic && rank < need; const unsigned long long ms = __ballot(take);
                if (take) SEL[nsel + __popcll(ms & ltmask)] = (unsigned short)key;
                nsel += __popcll(ms);
            }
        }
    }
    WAVE_FENCE();
    }
    }
    asm volatile("" : "+v"(lane));
#pragma unroll 1
    for (int qs4_ = 0; qs4_ < 2 * (ATT_PROBE == 3 ? 2 : 1); ++qs4_) {
    asm volatile("" : "+v"(lane));
    const int qi = 2 * wave + (qs4_ & 1);
    const LAS unsigned short* SEL = (const LAS unsigned short*)(lds + XTRA_OFF + 16384 + wave * 1024 + (qs4_ & 1) * 512);
    const int n = t0 + qi + 1, cnt = n < NSEL ? n : NSEL;
    const int m = m0 + qi;
    LAS unsigned char* RING = lds + wave * 16384;
    const char* kvb = (const char*)KV + (size_t)b * SEQ * 256;
    const int li = lane & 15, kq = lane >> 4;
    long qb[2][2];
#pragma unroll
    for (int c = 0; c < 2; ++c)
#pragma unroll
        for (int ks = 0; ks < 2; ++ks) { qb[c][ks] = 0;
            if (li < 4) { const u32x4 w = *(const u32x4*)(Q + (size_t)m * 512 + (4 * c + li) * 64 + 32 * ks + 8 * kq);
                const unsigned lo = pack4_fp8(bflo(w.x), bfhi(w.x), bflo(w.y), bfhi(w.y)), hi = pack4_fp8(bflo(w.z), bfhi(w.z), bflo(w.w), bfhi(w.w));
                qb[c][ks] = (long)(((unsigned long long)hi << 32) | lo); } }
    int koff[2][2];
#pragma unroll
    for (int c = 0; c < 2; ++c)
#pragma unroll
        for (int ks = 0; ks < 2; ++ks) koff[c][ks] = li * 128 + (((4 * c + 2 * ks + (kq >> 1)) ^ ((li >> 1) & 7)) << 4) + 8 * (kq & 1);
    const int tq = li >> 1, tp = li & 1, rowv = 16 * (tq >> 2) + 4 * kq + (tq & 3);
    int voff[2][4];
#pragma unroll
    for (int c = 0; c < 2; ++c)
#pragma unroll
        for (int dt = 0; dt < 4; ++dt) voff[c][dt] = rowv * 128 + (((4 * c + dt) ^ ((rowv >> 1) & 7)) << 4) + 8 * tp;
    const int r8 = lane >> 3, c16 = lane & 7;
    unsigned dsw[4];
#pragma unroll
    for (int j = 0; j < 4; ++j) dsw[j] = (unsigned)((c16 ^ ((4 * j + (r8 >> 1)) & 7)) << 4);
#define ATT_KEYS(s_) (*(const LAS u32x2*)(SEL + 32 * ((s_) & 7) + 4 * r8))
#define ATT_ISSUE(s_, kk_) do { const unsigned part_ = (((s_) & 15) >> 3) * 128u; \
        _Pragma("unroll") for (int j_ = 0; j_ < 4; ++j_) { const unsigned key_ = (((j_ & 2) ? (kk_).y : (kk_).x) >> ((j_ & 1) * 16)) & 0xffffu; \
            __builtin_amdgcn_global_load_lds((const unsigned*)(kvb + (size_t)key_ * 256 + part_ + dsw[j_]), (LAS unsigned*)(RING + ((s_) & 3) * 4096 + j_ * 1024), 16, 0, 0); } } while (0)
    { const u32x2 k0 = ATT_KEYS(0), k1 = ATT_KEYS(1), k2 = ATT_KEYS(2); ATT_ISSUE(0, k0); ATT_ISSUE(1, k1); ATT_ISSUE(2, k2); }
    u32x2 kk = ATT_KEYS(3);
    f32x4 lgs[8][2][2];
#pragma unroll
    for (int s = 0; s < 8; ++s) {
        ATT_ISSUE(s + 3, kk);
        kk = ATT_KEYS(s + 4);
        asm volatile("s_waitcnt vmcnt(12)" ::: "memory");
        const LAS unsigned char* slot = RING + (s & 3) * 4096;
#pragma unroll
        for (int T = 0; T < 2; ++T)
#pragma unroll
            for (int c = 0; c < 2; ++c) {
                f32x4 acc = (f32x4){0.f, 0.f, 0.f, 0.f};
#pragma unroll
                for (int ks = 0; ks < 2; ++ks) acc = __builtin_amdgcn_mfma_f32_16x16x32_fp8_fp8(*(const LAS long*)(slot + T * 2048 + koff[c][ks]), qb[c][ks], acc, 0, 0, 0);
#pragma unroll
                for (int i = 0; i < 4; ++i) acc[i] = (32 * s + 16 * (kq & 1) + 4 * i + 2 * T + (kq >> 1) < cnt) ? acc[i] : -INFINITY;
                lgs[s][T][c] = acc;
            }
        asm volatile("s_waitcnt lgkmcnt(0)" ::: "memory");
    }
    float inv[2];
#pragma unroll
    for (int c = 0; c < 2; ++c) {
        float mx = -INFINITY;
#pragma unroll
        for (int s = 0; s < 8; ++s)
#pragma unroll
            for (int T = 0; T < 2; ++T) mx = fmaxf(fmaxf(mx, fmaxf(lgs[s][T][c][0], lgs[s][T][c][1])), fmaxf(lgs[s][T][c][2], lgs[s][T][c][3]));
        mx = fmaxf(mx, shx<16>(mx)); mx = max32(mx);
        const float mxs = mx * 0.18033688011112042f;
        float sm = 0.f;
#pragma unroll
        for (int s = 0; s < 8; ++s)
#pragma unroll
            for (int T = 0; T < 2; ++T)
#pragma unroll
                for (int i = 0; i < 4; ++i) { const float p = __builtin_amdgcn_exp2f(lgs[s][T][c][i] * 0.18033688011112042f - mxs); lgs[s][T][c][i] = p; sm += p; }
        sm += shx<16>(sm); sm = sum32(sm);
        inv[c] = 1.0f / sm;
    }
    f32x4 o[2][4];
#pragma unroll
    for (int c = 0; c < 2; ++c)
#pragma unroll
        for (int dt = 0; dt < 4; ++dt) o[c][dt] = (f32x4){0.f, 0.f, 0.f, 0.f};
#pragma unroll
    for (int s = 8; s < 16; ++s) {
        ATT_ISSUE(s + 3, kk);
        kk = ATT_KEYS(s + 4);
        asm volatile("s_waitcnt vmcnt(12)" ::: "memory");
        const LAS unsigned char* slot = RING + (s & 3) * 4096;
#pragma unroll
        for (int c = 0; c < 2; ++c) {
            const f32x4 t0 = lgs[s - 8][0][c], t1 = lgs[s - 8][1][c];
            const long pf = (long)(((unsigned long long)pack4_fp8(t1[0], t1[1], t1[2], t1[3]) << 32) | pack4_fp8(t0[0], t0[1], t0[2], t0[3]));
#pragma unroll
            for (int dt = 0; dt < 4; ++dt) {
                const v2i32_t va = __builtin_amdgcn_ds_read_tr8_b64_v2i32((LAS v2i32_t*)(slot + voff[c][dt]));
                const long vf = (long)(((unsigned long long)(unsigned)va.y << 32) | (unsigned)va.x);
                o[c][dt] = __builtin_amdgcn_mfma_f32_16x16x32_fp8_fp8(vf, pf, o[c][dt], 0, 0, 0);
            }
        }
        asm volatile("s_waitcnt lgkmcnt(0)" ::: "memory");
    }
#undef ATT_ISSUE
#undef ATT_KEYS
    if (li < 4) {
#pragma unroll
        for (int c = 0; c < 2; ++c)
#pragma unroll
            for (int dt = 0; dt < 4; ++dt) { const f32x4 v = o[c][dt] * inv[c]; u32x2 w; w.x = pk2(v[0], v[1]); w.y = pk2(v[2], v[3]);
                *(u32x2*)(YAYP + (size_t)m * 1024 + (4 * c + li) * 64 + 16 * dt + 4 * kq) = w; }
    }
    asm volatile("s_waitcnt vmcnt(0)" ::: "memory");
    }
}

template <int WIN> __device__ __forceinline__ void pool_item(const bf16* U, bf16* DP, const int mrow, const int ck) {
    const int t = mrow & (SEQ - 1), cw = WIN < t + 1 ? WIN : t + 1;
    u32x4 x[WIN];
#pragma unroll
    for (int i = 0; i < WIN; ++i) x[i] = *(const u32x4*)(U + (size_t)(mrow - (i < cw ? i : 0)) * 512 + 8 * ck);
    float s[8];
#pragma unroll
    for (int e = 0; e < 8; ++e) s[e] = 0.f;
#pragma unroll
    for (int i = 0; i < WIN; ++i) { const float w = i < cw ? 1.f : 0.f;
        s[0] += w * bflo(x[i].x); s[1] += w * bfhi(x[i].x); s[2] += w * bflo(x[i].y); s[3] += w * bfhi(x[i].y); s[4] += w * bflo(x[i].z); s[5] += w * bfhi(x[i].z); s[6] += w * bflo(x[i].w); s[7] += w * bfhi(x[i].w); }
    const float inv = 1.0f / (float)cw;
    u32x4 o; o.x = pk2(s[0] * inv - bflo(x[0].x), s[1] * inv - bfhi(x[0].x)); o.y = pk2(s[2] * inv - bflo(x[0].y), s[3] * inv - bfhi(x[0].y));
    o.z = pk2(s[4] * inv - bflo(x[0].z), s[5] * inv - bfhi(x[0].z)); o.w = pk2(s[6] * inv - bflo(x[0].w), s[7] * inv - bfhi(x[0].w));
    *(u32x4*)(DP + (size_t)mrow * 1024 + 8 * ck) = o;
}
__device__ __forceinline__ void pool_window(const bf16* U, bf16* DP, int gtid, int nthreads) {
    for (int it = gtid; it < M * 64; it += nthreads) {
        const int mrow = it >> 6, ck = it & 63, g = ck >> 4;
        if (g == 0) pool_item<2>(U, DP, mrow, ck); else if (g == 1) pool_item<4>(U, DP, mrow, ck); else if (g == 2) pool_item<8>(U, DP, mrow, ck); else pool_item<16>(U, DP, mrow, ck);
    }
}

__device__ __forceinline__ void butterfly32(const float (&lg)[32], const int lane, float& out) {
    float r16[16], r8[8], r4[4], r2[2], r1;
    { const bool hi = (lane & 32) != 0;
#pragma unroll
      for (int q = 0; q < 16; ++q) { const float mine = hi ? lg[16 + q] : lg[q], oth = hi ? lg[q] : lg[16 + q]; r16[q] = mine + partner32(oth, hi); } }
    { const bool hi = (lane & 16) != 0;
#pragma unroll
      for (int q = 0; q < 8; ++q) { const float mine = hi ? r16[8 + q] : r16[q], oth = hi ? r16[q] : r16[8 + q]; r8[q] = mine + shx<16>(oth); } }
    { const bool hi = (lane & 8) != 0;
#pragma unroll
      for (int q = 0; q < 4; ++q) { const float mine = hi ? r8[4 + q] : r8[q], oth = hi ? r8[q] : r8[4 + q]; r4[q] = mine + shx<8>(oth); } }
    { const bool hi = (lane & 4) != 0;
#pragma unroll
      for (int q = 0; q < 2; ++q) { const float mine = hi ? r4[2 + q] : r4[q], oth = hi ? r4[q] : r4[2 + q]; r2[q] = mine + shx<4>(oth); } }
    { const bool hi = (lane & 2) != 0; const float mine = hi ? r2[1] : r2[0], oth = hi ? r2[0] : r2[1]; r1 = mine + shx<2>(oth); }
    out = r1 + shx<1>(r1);
}
__device__ __forceinline__ void ln1_router_phase(LAS unsigned char* lds, const int tid, const int wave, const int lane_in, const int blk,
                                                 const bf16* V, const float* g1, const float* b1, const float* Wr, const float* br,
                                                 bf16* X1F, unsigned char* X1Q, float* X1S, int* TOPI, float* GATE, int* LRANK, int* HISTL) {
    LAS float* WL = (LAS float*)lds;
#pragma unroll 2
    for (int i = tid; i < 8192; i += NWAVES * 64) {
        const f32x4 w = *(const f32x4*)(Wr + 4 * i); const int k = i >> 3, e4 = (i & 7) * 4;
        WL[(e4 + 0) * 1024 + k] = w.x; WL[(e4 + 1) * 1024 + k] = w.y; WL[(e4 + 2) * 1024 + k] = w.z; WL[(e4 + 3) * 1024 + k] = w.w;
    }
    LAS int* EL = (LAS int*)(lds + XTRA_OFF);
    LAS float* LG = (LAS float*)(lds + XTRA_OFF + 2048 + wave * 512);
    LAS float* TV = LG + 64; LAS int* TE = (LAS int*)(LG + 72);
    __syncthreads();
    const int lane = lane_in, row0 = blk * 64 + wave * 8;
    f32x4 va[4], vb[4];
#pragma unroll
    for (int j = 0; j < 4; ++j) { const u32x2 wa = *(const u32x2*)(V + (size_t)row0 * D + 4 * lane + 256 * j), wb = *(const u32x2*)(V + (size_t)(row0 + 1) * D + 4 * lane + 256 * j);
        va[j] = (f32x4){bflo(wa.x), bfhi(wa.x), bflo(wa.y), bfhi(wa.y)}; vb[j] = (f32x4){bflo(wb.x), bfhi(wb.x), bflo(wb.y), bfhi(wb.y)}; }
#pragma unroll 1
    for (int pr = 0; pr < 4; ++pr) {
        const int rowA = row0 + 2 * pr;
        ln_regs(va, g1, b1, lane); ln_regs(vb, g1, b1, lane);
        store_row_bf16(X1F + (size_t)rowA * D, va, lane); store_row_bf16(X1F + (size_t)(rowA + 1) * D, vb, lane);
        store_row_i8(X1Q + (size_t)rowA * D, X1S + rowA, va, lane); store_row_i8(X1Q + (size_t)(rowA + 1) * D, X1S + rowA + 1, vb, lane);
        f32x2 l2[32];
#pragma unroll
        for (int e = 0; e < 32; ++e) l2[e] = (f32x2){0.f, 0.f};
#pragma unroll
        for (int j = 0; j < 4; ++j) {
            const f32x2 p0 = (f32x2){va[j].x, vb[j].x}, p1 = (f32x2){va[j].y, vb[j].y}, p2 = (f32x2){va[j].z, vb[j].z}, p3 = (f32x2){va[j].w, vb[j].w};
#pragma unroll
            for (int e = 0; e < 32; ++e) { const f32x4 w4 = *(const LAS f32x4*)(WL + e * 1024 + 4 * lane + 256 * j);
                l2[e] = __builtin_elementwise_fma(p0, (f32x2){w4.x, w4.x}, l2[e]); l2[e] = __builtin_elementwise_fma(p1, (f32x2){w4.y, w4.y}, l2[e]);
                l2[e] = __builtin_elementwise_fma(p2, (f32x2){w4.z, w4.z}, l2[e]); l2[e] = __builtin_elementwise_fma(p3, (f32x2){w4.w, w4.w}, l2[e]); }
        }
        float la[32], lb[32];
#pragma unroll
        for (int e = 0; e < 32; ++e) { la[e] = l2[e].x; lb[e] = l2[e].y; }
        { const int rowN = row0 + 2 * (pr < 3 ? pr + 1 : pr);
#pragma unroll
          for (int j = 0; j < 4; ++j) { const u32x2 wa = *(const u32x2*)(V + (size_t)rowN * D + 4 * lane + 256 * j), wb = *(const u32x2*)(V + (size_t)(rowN + 1) * D + 4 * lane + 256 * j);
              va[j] = (f32x4){bflo(wa.x), bfhi(wa.x), bflo(wa.y), bfhi(wa.y)}; vb[j] = (f32x4){bflo(wb.x), bfhi(wb.x), bflo(wb.y), bfhi(wb.y)}; }
          asm volatile("" ::: "memory"); }
        float vala, valb; butterfly32(la, lane, vala); butterfly32(lb, lane, valb);
        int em = lane >> 1; asm volatile("" : "+v"(em));
        const int myrow = lane & 1; const float bias = br[em];
        vala += bias; valb += bias;
        if (myrow == 0) LG[em] = vala; else LG[32 + em] = valb;
        WAVE_FENCE();
        const float mine = myrow ? valb : vala; int rank = 0;
#pragma unroll
        for (int q = 0; q < 8; ++q) { const f32x4 o4 = *(const LAS f32x4*)(LG + 32 * myrow + 4 * q);
#pragma unroll
            for (int u = 0; u < 4; ++u) rank += (o4[u] > mine || (o4[u] == mine && 4 * q + u < em)) ? 1 : 0; }
        if (rank < 4) { TV[4 * myrow + rank] = mine; TE[4 * myrow + rank] = em; }
        WAVE_FENCE();
        if (lane < 2) {
            const f32x4 tv = *(const LAS f32x4*)(TV + 4 * lane); const int t0 = TE[4 * lane], t1 = TE[4 * lane + 1], t2 = TE[4 * lane + 2], t3 = TE[4 * lane + 3];
            const float e1 = __expf(tv[1] - tv[0]), e2 = __expf(tv[2] - tv[0]), e3 = __expf(tv[3] - tv[0]); const float inv = 1.0f / (1.0f + e1 + e2 + e3);
            const int row = rowA + lane, gi = row * 4, rl = row - blk * 64;
            *(int4*)(TOPI + gi) = make_int4(t0, t1, t2, t3);
            *(f32x4*)(GATE + gi) = (f32x4){inv, e1 * inv, e2 * inv, e3 * inv};
            EL[rl * 4] = t0; EL[rl * 4 + 1] = t1; EL[rl * 4 + 2] = t2; EL[rl * 4 + 3] = t3;
        }
        WAVE_FENCE();
    }
    __syncthreads();
    LAS int* CNT = (LAS int*)(lds + XTRA_OFF + 1024);
    if (wave < 4) {
        const int e = EL[tid]; int rk = 0;
#pragma unroll 4
        for (int q = 0; q < 32; ++q) { const unsigned long long mq = __ballot(e == q); if (e == q) rk = __popcll(mq & ((1ull << lane_in) - 1ull)); if (lane_in == q) CNT[wave * 32 + q] = __popcll(mq); }
        __syncthreads();
        for (int w2 = 0; w2 < wave; ++w2) rk += CNT[w2 * 32 + e];
        LRANK[blk * 256 + tid] = rk;
        if (tid < 32) HISTL[blk * 32 + tid] = CNT[tid] + CNT[32 + tid] + CNT[64 + tid] + CNT[96 + tid];
    } else {
        __syncthreads();
    }
    __syncthreads();
}

__device__ __forceinline__ void scatter_phase(LAS unsigned char* lds, const int tid, const int wave, const int lane, const int blk,
                                              const int* HISTL, const int* TOPI, const float* GATE, const int* LRANK, const unsigned char* X1Q, const float* X1S,
                                              unsigned char* XS8, float* ROWG, float* ROWS, int* TOKROW, int* TILE) {
    LAS int* TOT = (LAS int*)lds; LAS int* BEF = TOT + 32; LAS int* OFFS = TOT + 64; LAS int* PT = TOT + 128; LAS int* PBF = TOT + 640;
    { const int e = tid & 31, part = tid >> 5; int hv[16];
#pragma unroll
      for (int q = 0; q < 16; ++q) hv[q] = HISTL[(part * 16 + q) * 32 + e];
      int tot = 0, bef = 0;
#pragma unroll
      for (int q = 0; q < 16; ++q) { tot += hv[q]; bef += (part * 16 + q < blk) ? hv[q] : 0; }
      PT[part * 32 + e] = tot; PBF[part * 32 + e] = bef; }
    __syncthreads();
    if (tid < 32) { int tot = 0, bef = 0;
#pragma unroll
        for (int q = 0; q < 16; ++q) { tot += PT[q * 32 + tid]; bef += PBF[q * 32 + tid]; }
        TOT[tid] = tot; BEF[tid] = bef; }
    __syncthreads();
    if (tid == 0) {
        int off = 0;
#pragma unroll 1
        for (int e = 0; e < 32; ++e) { OFFS[e] = off + BEF[e]; const int nt = (TOT[e] + 255) >> 8;
            if (blk == 0) {
#pragma unroll 1
                for (int k = 0; k < nt; ++k) TILE[1 + (off >> 8) + k] = e; }
            off += nt << 8; }
        if (blk == 0) TILE[0] = off >> 8;
    }
    __syncthreads();
#pragma unroll 1
    for (int i0 = 0; i0 < 32; i0 += 8) {
        int rowv[8]; u32x4 d[8]; float gv[8], sv[8];
#pragma unroll
        for (int u = 0; u < 8; ++u) { const int gi = blk * 256 + wave * 32 + i0 + u; const int e = TOPI[gi]; rowv[u] = OFFS[e] + LRANK[gi]; gv[u] = GATE[gi]; sv[u] = X1S[gi >> 2];
            d[u] = *(const u32x4*)(X1Q + (size_t)(gi >> 2) * D + 16 * lane); }
#pragma unroll
        for (int u = 0; u < 8; ++u) { const int gi = blk * 256 + wave * 32 + i0 + u;
            if (lane == 0) { TOKROW[gi] = rowv[u]; ROWG[rowv[u]] = gv[u]; ROWS[rowv[u]] = sv[u]; }
            *(u32x4*)(XS8 + (size_t)rowv[u] * D + 16 * lane) = d[u]; }
    }
    __syncthreads();
}

__device__ __forceinline__ void add_bf16_row(f32x4 (&v)[4], const bf16* row, int lane) {
#pragma unroll
    for (int j = 0; j < 4; ++j) { const u32x2 w = *(const u32x2*)(row + 4 * lane + 256 * j); v[j].x += bflo(w.x); v[j].y += bfhi(w.x); v[j].z += bflo(w.y); v[j].w += bfhi(w.y); }
}
__device__ __forceinline__ void combine_ln2_phase(const int gw, const int ngw, const int lane, const bf16* X1F, const bf16* PLEV, const bf16* YR, const int* TOKROW,
                                                  const float* g2, const float* b2, bf16* XF, unsigned char* XQ, float* XQS, float* OUT) {
#pragma unroll 1
    for (int row = gw; row < M; row += 2 * ngw) {
        const int rowb = row + ngw;
        const int4 ra = *(const int4*)(TOKROW + row * 4), rb = *(const int4*)(TOKROW + rowb * 4);
        f32x4 va[4], vb[4];
#pragma unroll
        for (int j = 0; j < 4; ++j) { const u32x2 wa = *(const u32x2*)(X1F + (size_t)row * D + 4 * lane + 256 * j), wb = *(const u32x2*)(X1F + (size_t)rowb * D + 4 * lane + 256 * j);
            va[j] = (f32x4){bflo(wa.x), bfhi(wa.x), bflo(wa.y), bfhi(wa.y)} * DN_ALPHA; vb[j] = (f32x4){bflo(wb.x), bfhi(wb.x), bflo(wb.y), bfhi(wb.y)} * DN_ALPHA; }
        add_bf16_row(va, PLEV + (size_t)row * D, lane); add_bf16_row(vb, PLEV + (size_t)rowb * D, lane);
        add_bf16_row(va, YR + (size_t)ra.x * D, lane); add_bf16_row(vb, YR + (size_t)rb.x * D, lane);
        add_bf16_row(va, YR + (size_t)ra.y * D, lane); add_bf16_row(vb, YR + (size_t)rb.y * D, lane);
        add_bf16_row(va, YR + (size_t)ra.z * D, lane); add_bf16_row(vb, YR + (size_t)rb.z * D, lane);
        add_bf16_row(va, YR + (size_t)ra.w * D, lane); add_bf16_row(vb, YR + (size_t)rb.w * D, lane);
        ln_regs(va, g2, b2, lane); ln_regs(vb, g2, b2, lane);
        if (OUT) { store_row_f32(OUT + (size_t)row * D, va, lane); store_row_f32(OUT + (size_t)rowb * D, vb, lane); }
        else { store_row_bf16(XF + (size_t)row * D, va, lane); store_row_i8(XQ + (size_t)row * D, XQS + row, va, lane); store_row_bf16(XF + (size_t)rowb * D, vb, lane); store_row_i8(XQ + (size_t)rowb * D, XQS + rowb, vb, lane); }
    }
}

#ifndef MK_N_LAUNCHES
#define MK_N_LAUNCHES 1
#endif
constexpr int PH_PER_LAYER = 10, N_PHASES = 1 + DEPTH * PH_PER_LAYER;
constexpr double ROPE_TURNS[8] = {0.15915494309189535, 0.03086376340470123, 0.005985185712713705, 0.001160663641240061, 0.00022507907903927653, 4.364795279280289e-05, 8.464330808241401e-06, 1.6414262627950345e-06};

#define ARGP(i) ((const float*)(const GAS float*)kargs_[i])
constexpr int B_WIN = 8 * 16, B_UP = 4 * 4, B_OUT = 8 * 4, B_PLEP = 2 * 4, B_GU1 = 8 * 8, B_DN1 = 8 * 4;
constexpr int B_LAYER = B_WIN + B_UP + 2 * B_OUT + B_PLEP + NE * B_GU1 + NE * B_DN1;
struct P0D { const float* src; int nsrc; unsigned char* dst; int ldtb; int i8; float ws; int valid; };
__device__ __forceinline__ void p0_decode(P0D& d, const int it_in, const int wave, unsigned char* ws, const __attribute__((address_space(4))) unsigned long long* kargs_, const int lane) {
    int it = __builtin_amdgcn_readfirstlane(it_in); asm volatile("" : "+s"(it));
    const int ll = it / B_LAYER; int r = it - ll * B_LAYER; unsigned char* lw2 = ws + WS_W + (size_t)ll * LW_SIZE;
    const float* W; int nsrc, nblk, ldt, kind = 0; unsigned char* wt; d.i8 = 0; d.ws = 1.0f;
    if (r < B_WIN) { W = ARGP(4) + (size_t)ll * D * D_IN; nsrc = D_IN; wt = lw2 + LW_WIN; ldt = D; nblk = 16; kind = 1; d.i8 = 1; d.ws = I8_WS_GU; }
    else if ((r -= B_WIN) < B_UP) { W = ARGP(7) + (size_t)ll * 512 * D; nsrc = D; wt = lw2 + LW_WUPA; ldt = 1024; nblk = 4; }
    else if ((r -= B_UP) < B_OUT) { W = ARGP(9) + (size_t)ll * D * D; nsrc = D; wt = lw2 + LW_WOUT; ldt = D; nblk = 4; }
    else if ((r -= B_OUT) < B_OUT) { W = ARGP(18) + (size_t)ll * D * D; nsrc = D; wt = lw2 + LW_PLEG; ldt = D; nblk = 4; d.i8 = 1; d.ws = I8_WS_GU; }
    else if ((r -= B_OUT) < B_PLEP) { W = ARGP(19) + (size_t)ll * PLE * D; nsrc = D; wt = lw2 + LW_PLEP; ldt = PLE; nblk = 4; }
    else if ((r -= B_PLEP) < NE * B_GU1) { const int e = r / B_GU1; r -= e * B_GU1; W = ARGP(14) + ((size_t)ll * NE + e) * D * 2048; nsrc = 2048; wt = lw2 + LW_WGU + (size_t)e * 2048 * D; ldt = D; nblk = 8; kind = 2; d.i8 = 1; d.ws = I8_WS_GU; }
    else { r -= NE * B_GU1; const int e = r / B_DN1; r -= e * B_DN1; W = ARGP(16) + ((size_t)ll * NE + e) * DFF * D; nsrc = D; wt = lw2 + LW_WDN + (size_t)e * D * DFF; ldt = DFF; nblk = 4; d.i8 = 1; d.ws = I8_WS_DN; }
    const int kb = r / nblk, nb = r - kb * nblk, k0 = 128 * kb + 16 * wave, np = 256 * nb + 4 * lane;
    const int sc = kind == 1 ? MapWin()(np) : (kind == 2 ? MapGU()(np) : np);
    d.valid = sc >= 0; d.nsrc = nsrc; d.src = W + (size_t)k0 * nsrc + (sc < 0 ? 0 : sc);
    const int esz = d.i8 ? 1 : 2; d.ldtb = ldt * esz; d.dst = wt + (size_t)(256 * nb) * d.ldtb + (size_t)(128 * kb) * esz;
}
struct Args { const float* in[22]; float* out; unsigned char* ws; int ph_lo, ph_hi; };

template <unsigned PMASK>
__global__ void __launch_bounds__(NWAVES * 64, 2) mega_fwd(Args args) {
    extern __shared__ __attribute__((aligned(16))) unsigned char lds_raw[];
    LAS unsigned char* lds = (LAS unsigned char*)lds_raw;
    volatile LAS unsigned* MISC = (volatile LAS unsigned*)(lds + MISC_OFF);
    const int G = gridDim.x, blk = blockIdx.x;
    const int wave_s_ = __builtin_amdgcn_readfirstlane(threadIdx.x >> 6);
    for (int u = threadIdx.x; u < (LDS_BYTES - MISC_OFF) / 4; u += NWAVES * 64) ((LAS unsigned*)(lds + MISC_OFF))[u] = 0u;
    __syncthreads();
    XcdBarrier bar; bar.bar = (unsigned*)(args.ws + WS_CTL) + CW_BAR; bar.x = 0; bar.st = nullptr;
#if MK_N_LAUNCHES == 1
    bar = xcd_barrier_post((unsigned*)(args.ws + WS_CTL) + CW_BAR, MISC + 8);
#define GRID_BAR() xcd_barrier(bar)
#else
#define GRID_BAR() do { } while (0)
#endif
    const int lo = args.ph_lo, hi = args.ph_hi;
#ifndef PROBE_MASK
#define PROBE_MASK 0u
#endif
#define PH_KIND(k) ((k) == 0 ? 0 : 1 + ((k) - 1) % PH_PER_LAYER)
#define REPS(kk) for (int rep_ = 0; rep_ < (((PROBE_MASK >> (kk)) & 1u) ? 2 : 1); ++rep_)
#define HASK(kk) (((PMASK >> (kk)) & 1u) != 0u)

#define PHASE_VARS \
    const __attribute__((address_space(4))) unsigned long long* kargs_ = (const __attribute__((address_space(4))) unsigned long long*)__builtin_amdgcn_kernarg_segment_ptr(); \
    __builtin_amdgcn_s_waitcnt(0);       \
    asm volatile("" : "+s"(kargs_));     \
    unsigned char* ws = (unsigned char*)(GAS unsigned char*)kargs_[23]; \
    int lane_o_ = (int)__builtin_amdgcn_mbcnt_hi(~0u, __builtin_amdgcn_mbcnt_lo(~0u, 0u)); asm volatile("" : "+v"(lane_o_));     \
    const int lane = lane_o_, wave = wave_s_, tid = wave_s_ * 64 + lane_o_; \
    const int gw = blk * NWAVES + wave, NGW = G * NWAVES, gtid = blk * (NWAVES * 64) + tid, NT = G * NWAVES * 64; \
    (void)lane; (void)wave; (void)gw; (void)NGW; (void)gtid; (void)NT; \
    bf16* XF = (bf16*)(ws + WS_XF); bf16* XB = (bf16*)(ws + WS_XB);     \
    float* ROPE = (float*)(ws + WS_ROPE); bf16* PB16 = (bf16*)(ws + WS_PB16); \
    bf16* Qb = (bf16*)(ws + WS_Q); bf16* KVb = (bf16*)(ws + WS_KV); bf16* QIb = (bf16*)(ws + WS_QI); bf16* KIb = (bf16*)(ws + WS_KI); float* WIb = (float*)(ws + WS_WI); \
    bf16* Ub = (bf16*)(ws + WS_U); bf16* SGA = (bf16*)(ws + WS_SGA); bf16* SGB = (bf16*)(ws + WS_SGB); bf16* YAYP = (bf16*)(ws + WS_YAYP); bf16* DP = (bf16*)(ws + WS_DP); \
    bf16* T1 = (bf16*)(ws + WS_T1); bf16* MRG = (bf16*)(ws + WS_MRG); bf16* X1F = (bf16*)(ws + WS_X1F); bf16* X1B = (bf16*)(ws + WS_X1B); \
    bf16* XS = (bf16*)(ws + WS_XS); bf16* ACT = (bf16*)(ws + WS_ACT); bf16* YR = (bf16*)(ws + WS_YR); bf16* PLEPb = (bf16*)(ws + WS_PLEP); bf16* PLEV = (bf16*)(ws + WS_PLEV); \
    int* TOPI = (int*)(ws + WS_ROUTE + RT_TOPI); float* GATE = (float*)(ws + WS_ROUTE + RT_GATE); int* LRANK = (int*)(ws + WS_ROUTE + RT_LRANK); \
    int* TOKROW = (int*)(ws + WS_ROUTE + RT_TOKROW); float* ROWG = (float*)(ws + WS_ROUTE + RT_ROWG); float* ROWS = (float*)(ws + WS_ROUTE + RT_ROWS); (void)ROWS; float* X1S = (float*)(ws + WS_ROUTE + RT_X1S); (void)X1S; unsigned char* X1Q = (unsigned char*)(ws + WS_X1B); (void)X1Q; unsigned char* XQ = (unsigned char*)(ws + WS_XB); (void)XQ; float* XQS = (float*)(ws + WS_ROUTE + RT_XQS); (void)XQS; \
    unsigned char* lw = ws + WS_W + (size_t)l * LW_SIZE; \
    int* HISTL = (int*)(ws + WS_ROUTE + RT_HIST) + l * 256 * 32; int* TILE = (int*)(ws + WS_ROUTE + RT_TILE) + l * 512; \
    (void)XF; (void)XB; (void)ROPE; (void)PB16; (void)Qb; (void)KVb; (void)QIb; (void)KIb; (void)WIb; (void)Ub; (void)SGA; (void)SGB; (void)YAYP; (void)DP; (void)T1; (void)MRG; (void)X1F; (void)X1B; \
    (void)XS; (void)ACT; (void)YR; (void)PLEPb; (void)PLEV; (void)TOPI; (void)GATE; (void)LRANK; (void)TOKROW; (void)ROWG; (void)lw; (void)HISTL; (void)TILE;

#pragma unroll 1
    for (int ph = lo; ph < hi; ++ph) {
    const int kind = PH_KIND(ph), l = (ph - 1) / PH_PER_LAYER;
    if (kind == 0 && HASK(0)) REPS(0) {
        PHASE_VARS
        const float* x_in = ARGP(0); const float* p_in = ARGP(1);
        if (blk < DEPTH * B_LAYER) {
            P0D cur; p0_decode(cur, blk, wave, ws, kargs_, lane); f32x4 tv[16]; int par = 0;
#pragma unroll
            for (int i = 0; i < 16; ++i) tv[i] = __builtin_nontemporal_load((const f32x4*)(cur.src + (size_t)i * cur.nsrc));
#pragma unroll 1
            for (int it = blk;; it += G) {
                const bool has = it + G < DEPTH * B_LAYER; P0D nx; f32x4 tn[16];
                p0_decode(nx, has ? it + G : it, wave, ws, kargs_, lane);
#pragma unroll
                for (int i = 0; i < 16; ++i) tn[i] = __builtin_nontemporal_load((const f32x4*)(nx.src + (size_t)i * nx.nsrc));
                asm volatile("" ::: "memory");
                const float sc_ = cur.valid ? cur.ws : 0.f;
                LAS unsigned char* tile = lds + par * 65536; par ^= 1;
                if (cur.i8) {
#pragma unroll
                    for (int c = 0; c < 4; ++c) { u32x4 o;
                        o.x = pack4_i8(tv[0][c] * sc_, tv[1][c] * sc_, tv[2][c] * sc_, tv[3][c] * sc_); o.y = pack4_i8(tv[4][c] * sc_, tv[5][c] * sc_, tv[6][c] * sc_, tv[7][c] * sc_);
                        o.z = pack4_i8(tv[8][c] * sc_, tv[9][c] * sc_, tv[10][c] * sc_, tv[11][c] * sc_); o.w = pack4_i8(tv[12][c] * sc_, tv[13][c] * sc_, tv[14][c] * sc_, tv[15][c] * sc_);
                        *(LAS u32x4*)(tile + (4 * lane + c) * 128 + 16 * (wave ^ (lane & 7))) = o; }
                    LDS_WAIT(); __builtin_amdgcn_s_barrier();
#pragma unroll
                    for (int j = 0; j < 4; ++j) { const int ci = j * 512 + tid, n = ci >> 3, q = ci & 7;
                        *(GAS u32x4*)(cur.dst + (size_t)n * cur.ldtb + 16 * q) = *(const LAS u32x4*)(tile + n * 128 + 16 * (q ^ ((n >> 2) & 7))); }
                } else {
#pragma unroll
                    for (int c = 0; c < 4; ++c) { u32x4 o0, o1;
                        o0.x = pk2(tv[0][c] * sc_, tv[1][c] * sc_); o0.y = pk2(tv[2][c] * sc_, tv[3][c] * sc_); o0.z = pk2(tv[4][c] * sc_, tv[5][c] * sc_); o0.w = pk2(tv[6][c] * sc_, tv[7][c] * sc_);
                        o1.x = pk2(tv[8][c] * sc_, tv[9][c] * sc_); o1.y = pk2(tv[10][c] * sc_, tv[11][c] * sc_); o1.z = pk2(tv[12][c] * sc_, tv[13][c] * sc_); o1.w = pk2(tv[14][c] * sc_, tv[15][c] * sc_);
                        *(LAS u32x4*)(tile + (4 * lane + c) * 256 + 16 * ((2 * wave) ^ (lane & 7))) = o0; *(LAS u32x4*)(tile + (4 * lane + c) * 256 + 16 * ((2 * wave + 1) ^ (lane & 7))) = o1; }
                    LDS_WAIT(); __builtin_amdgcn_s_barrier();
#pragma unroll
                    for (int j = 0; j < 8; ++j) { const int ci = j * 512 + tid, n = ci >> 4, q = ci & 15;
                        *(GAS u32x4*)(cur.dst + (size_t)n * cur.ldtb + 16 * q) = *(const LAS u32x4*)(tile + n * 256 + 16 * (q ^ ((n >> 2) & 7))); }
                }
                if (!has) break;
                cur = nx;
#pragma unroll
                for (int i = 0; i < 16; ++i) tv[i] = tn[i];
            }
        }
        for (int it = gtid; it < DEPTH * 64 * 1024; it += NT) {
            const int n = it & 1023, kc = (it >> 10) & 63, ll = it >> 16, g = kc >> 4, c0 = (kc & 15) * 8;
            const float* pw = ARGP(5) + ((size_t)(ll * 4 + g) * 128 + c0) * 128;
            const float* sc = ARGP(6) + (size_t)ll * 512 + g * 128;
            const float* wp = ARGP(8) + ((size_t)ll * 512 + g * 128) * D + n;
            float a8[8];
#pragma unroll
            for (int j = 0; j < 8; ++j) a8[j] = 0.f;
#pragma unroll 2
            for (int d = 0; d < 128; d += 4) {
                const f32x4 s4 = *(const f32x4*)(sc + d);
                const f32x4 w4 = (f32x4){wp[(size_t)d * D] * s4[0], wp[(size_t)(d + 1) * D] * s4[1], wp[(size_t)(d + 2) * D] * s4[2], wp[(size_t)(d + 3) * D] * s4[3]};
#pragma unroll
                for (int j = 0; j < 8; ++j) { const f32x4 p4 = *(const f32x4*)(pw + j * 128 + d); a8[j] += (p4[0] * w4[0] + p4[1] * w4[1]) + (p4[2] * w4[2] + p4[3] * w4[3]); }
            }
            u32x4 o; o.x = pk2(a8[0], a8[1]); o.y = pk2(a8[2], a8[3]); o.z = pk2(a8[4], a8[5]); o.w = pk2(a8[6], a8[7]);
            *(u32x4*)((bf16*)(ws + WS_W + (size_t)ll * LW_SIZE + LW_WUPA) + (size_t)n * 1024 + 512 + 8 * kc) = o;
        }
        for (int it = gtid; it < SEQ * 8; it += NT) {
            const int pos = it >> 3, i = it & 7; const double tr = (double)pos * ROPE_TURNS[i]; const float fr = (float)(tr - __builtin_rint(tr));
            ROPE[pos * 16 + i] = __builtin_amdgcn_cosf(fr); ROPE[pos * 16 + 8 + i] = __builtin_amdgcn_sinf(fr);
        }
        { f32x4 pa[8], pc[8];
#pragma unroll
          for (int q = 0; q < 8; ++q) { const size_t it = (size_t)gtid + (size_t)q * NT; pa[q] = __builtin_nontemporal_load((const f32x4*)(p_in + it * 8)); pc[q] = __builtin_nontemporal_load((const f32x4*)(p_in + it * 8 + 4)); }
#pragma unroll
          for (int q = 0; q < 8; ++q) { const size_t it = (size_t)gtid + (size_t)q * NT; *(u32x4*)(PB16 + it * 8) = pg8::pack8(pa[q], pc[q]); } }
#pragma unroll 1
        for (int m = gw; m < M; m += 4 * NGW) {
            f32x4 v[4][4];
#pragma unroll
            for (int u = 0; u < 4; ++u)
#pragma unroll
                for (int j = 0; j < 4; ++j) v[u][j] = __builtin_nontemporal_load((const f32x4*)(x_in + (size_t)(m + u * NGW) * D + 4 * lane + 256 * j));
#pragma unroll
            for (int u = 0; u < 4; ++u) { const int mr = m + u * NGW; ln_regs(v[u], ARGP(2), ARGP(3), lane);
                store_row_bf16(XF + (size_t)mr * D, v[u], lane); store_row_i8(XQ + (size_t)mr * D, XQS + mr, v[u], lane); }
        }
    }
        else if (kind == 1 && HASK(1)) REPS(1) {
            PHASE_VARS
            pg8::StaticSched S; S.init(M, NZ, G, blk, XQ, D / 2, lw + LW_WIN, D / 2);
            pg8::EpiZ<true> E{Qb, KVb, QIb, KIb, WIb, Ub, SGA, SGB, ROPE, XQS};
            pg8::gemm_phase<pg8::EpiZ<true>, pg8::StaticSched, true, true>(lds, wave, pg8::Gemm{D / 2, D / 2}, S, E);
        }
        else if (kind == 2 && HASK(2)) REPS(2) {
            PHASE_VARS
            if (G == 256) {
                const int bb = (blk & 7) >> 1, cb = ((blk & 7) & 1) * 32 + (blk >> 3);
                for (int j = 0; j < 4; ++j) {
                    const int tq = 64 * j + ((j & 1) ? (63 - cb) : cb);
                    attn_unit(lds, wave, lane, bb, 16 * tq, QIb, KIb, WIb, Qb, KVb, YAYP);
                    __syncthreads();
                }
            } else {
                for (int j = 0; j < (1024 + G - 1) / G; ++j) {
                    const int id = G * j + ((j & 1) ? (G - 1 - blk) : blk);
                    if (id < 1024) attn_unit(lds, wave, lane, id & 3, 16 * (id >> 2), QIb, KIb, WIb, Qb, KVb, YAYP);
                    __syncthreads();
                }
            }
            for (int repw_ = 0; repw_ < (ATT_PROBE == 4 ? 2 : 1); ++repw_) pool_window(Ub, YAYP + 512, gtid, NT);
            __syncthreads();
            { pg8::StaticSched S; S.init(M, D, G, blk, PB16 + (size_t)l * M * PLE, PLE, lw + LW_PLEP, PLE);
              pg8::EpiBf16 E{PLEPb, 1024, 0, nullptr};
              pg8::gemm_phase<pg8::EpiBf16, pg8::StaticSched, true>(lds, wave, pg8::Gemm{PLE, PLE}, S, E); }
        }
        else if (kind == 3) { }
        else if (kind == 4 && HASK(4)) REPS(4) {
            PHASE_VARS
            { pg8::StaticSched S; S.init(M, D, G, blk, YAYP, 1024, lw + LW_WUPA, 1024);
              pg8::EpiGateMerge E{SGA, SGB, MRG};
              pg8::gemm_phase<pg8::EpiGateMerge, pg8::StaticSched, true>(lds, wave, pg8::Gemm{1024, 1024}, S, E); }
        }
        else if (kind == 5 && HASK(5)) REPS(5) {
            PHASE_VARS
            pg8::StaticSched S; S.init(M, D, G, blk, MRG, D, lw + LW_WOUT, D);
            pg8::EpiResid E{XF, T1, DN_ALPHA};
            pg8::gemm_phase<pg8::EpiResid, pg8::StaticSched, true>(lds, wave, pg8::Gemm{D, D}, S, E);
        }
        else if (kind == 6 && HASK(6)) REPS(6) {
            PHASE_VARS
            if (blk < 256) ln1_router_phase(lds, tid, wave, lane, blk, T1, ARGP(10) + (size_t)l * D, ARGP(11) + (size_t)l * D, ARGP(12) + (size_t)l * D * NE, ARGP(13) + (size_t)l * NE,
                                            X1F, X1Q, X1S, TOPI, GATE, LRANK, HISTL);
        }
        else if (kind == 7 && HASK(7)) REPS(7) {
            PHASE_VARS
            if (blk < 256) scatter_phase(lds, tid, wave, lane, blk, HISTL, TOPI, GATE, LRANK, X1Q, X1S, (unsigned char*)XS, ROWG, ROWS, TOKROW, TILE);
        }
        else if (kind == 8 && HASK(8)) REPS(8) {
            PHASE_VARS
            LAS int* TL = (LAS int*)(lds + XTRA_OFF);
            for (int i = tid; i < 512; i += NWAVES * 64) TL[i] = __hip_atomic_load(TILE + i, __ATOMIC_RELAXED, __HIP_MEMORY_SCOPE_AGENT);
            __syncthreads();
            const int ntiles = TL[0];
            const int slotsH = ((ntiles * 8 + G - 1) / G) * G - ntiles * 8, pleH = slotsH < 256 ? slotsH : 256;
            { pg8::MoeSched S{ntiles, 8, G, (blk & 7) * (G >> 3) + (blk >> 3), TL + 1, (const char*)XS, (const char*)(lw + LW_WGU), (size_t)256 * D, (size_t)2048 * D, (size_t)256 * D,
                              0, pleH, (const char*)X1Q, (const char*)(lw + LW_PLEG), (size_t)256 * D, (size_t)256 * D};
              pg8::EpiSwigluPle E{{ARGP(15) + (size_t)l * NE * 2048, ROWS, (unsigned char*)ACT}, {PLEPb, X1S, PLEV}};
              pg8::gemm_phase<pg8::EpiSwigluPle, pg8::MoeSched, true, true>(lds, wave, pg8::Gemm{D / 2, D / 2}, S, E); }
        }
        else if (kind == 9 && HASK(9)) REPS(9) {
            PHASE_VARS
            LAS int* TL = (LAS int*)(lds + XTRA_OFF);
            for (int i = tid; i < 512; i += NWAVES * 64) TL[i] = __hip_atomic_load(TILE + i, __ATOMIC_RELAXED, __HIP_MEMORY_SCOPE_AGENT);
            __syncthreads();
            const int ntiles = TL[0];
            const int slotsH = ((ntiles * 8 + G - 1) / G) * G - ntiles * 8, pleH = slotsH < 256 ? slotsH : 256;
            { pg8::MoeSched S{ntiles, 4, G, (blk & 7) * (G >> 3) + (blk >> 3), TL + 1, (const char*)ACT, (const char*)(lw + LW_WDN), (size_t)256 * DFF, (size_t)D * DFF, (size_t)256 * DFF,
                              pleH, 256 - pleH, (const char*)X1Q, (const char*)(lw + LW_PLEG), (size_t)256 * D, (size_t)256 * D};
              pg8::EpiDownPle E{{ARGP(17) + (size_t)l * NE * D, ROWG, YR}, {PLEPb, X1S, PLEV}};
              pg8::gemm_phase<pg8::EpiDownPle, pg8::MoeSched, true, true>(lds, wave, pg8::Gemm{DFF / 2, DFF / 2}, S, E); }
        }
        else if (kind == 10 && HASK(10)) REPS(10) {
            PHASE_VARS
            combine_ln2_phase(gw, NGW, lane, X1F, PLEV, YR, TOKROW, ARGP(20) + (size_t)l * D, ARGP(21) + (size_t)l * D, XF, XQ, XQS, (l == DEPTH - 1) ? (float*)(GAS float*)kargs_[22] : nullptr);
        }
    if (ph + 1 < hi && kind != 3) { GRID_BAR(); if (ATT_PROBE == 5) GRID_BAR(); }
    }
}

#if MK_N_LAUNCHES == 1
#define MEGA_ALL mega_fwd<0x7ffu>
#else
typedef void (*kern_t)(Args);
static kern_t phase_kernel(int kind) {
    switch (kind) { case 0: return mega_fwd<1u>; case 1: return mega_fwd<2u>; case 2: return mega_fwd<4u>; case 3: return mega_fwd<8u>; case 4: return mega_fwd<16u>; case 5: return mega_fwd<32u>;
                    case 6: return mega_fwd<64u>; case 7: return mega_fwd<128u>; case 8: return mega_fwd<256u>; case 9: return mega_fwd<512u>; default: return mega_fwd<1024u>; }
}
#endif
extern "C" void kernel_launch(void* const* d_in, const int* in_sizes, int n_in, void* d_out, int out_size, void* d_ws, size_t ws_size, hipStream_t stream) {
    static int grid = 0;
    if (grid == 0) {
        if (n_in != 22 || out_size != M * D || ws_size < WS_END) { fprintf(stderr, "kernel_launch: unexpected shapes (n_in %d out %d ws %zu need %zu)\n", n_in, out_size, ws_size, (size_t)WS_END); grid = -1; return; }
        int dev = 0, cus = 0, per_cu = 0;
        if (hipGetDevice(&dev) != hipSuccess || hipDeviceGetAttribute(&cus, hipDeviceAttributeMultiprocessorCount, dev) != hipSuccess) { grid = -1; return; }
#if MK_N_LAUNCHES == 1
        if (hipFuncSetAttribute((const void*)MEGA_ALL, hipFuncAttributeMaxDynamicSharedMemorySize, LDS_BYTES) != hipSuccess) { fprintf(stderr, "kernel_launch: hipFuncSetAttribute failed\n"); grid = -1; return; }
        if (hipOccupancyMaxActiveBlocksPerMultiprocessor(&per_cu, (const void*)MEGA_ALL, NWAVES * 64, LDS_BYTES) != hipSuccess || per_cu < 1) { fprintf(stderr, "kernel_launch: occupancy query says %d blocks per CU\n", per_cu); grid = -1; return; }
#else
        for (int k = 0; k <= PH_PER_LAYER; ++k) if (hipFuncSetAttribute((const void*)phase_kernel(k), hipFuncAttributeMaxDynamicSharedMemorySize, LDS_BYTES) != hipSuccess) { fprintf(stderr, "kernel_launch: hipFuncSetAttribute failed\n"); grid = -1; return; }
        per_cu = 1;
#endif
        (void)hipGetLastError();
        grid = cus < 256 ? cus : 256;
    }
    if (grid < 0) return;
    (void)hipMemsetAsync((char*)d_ws + WS_CTL, 0, CTL_ZERO_BYTES, stream);
    Args a{};
    for (int i = 0; i < 22; ++i) a.in[i] = (const float*)d_in[i];
    a.out = (float*)d_out; a.ws = (unsigned char*)d_ws;
#if MK_N_LAUNCHES == 1
    a.ph_lo = 0; a.ph_hi = N_PHASES;
    hipLaunchKernelGGL(MEGA_ALL, dim3(grid), dim3(NWAVES * 64), LDS_BYTES, stream, a);
#else
    for (int ph = 0; ph < N_PHASES; ++ph) { a.ph_lo = ph; a.ph_hi = ph + 1; hipLaunchKernelGGL(phase_kernel(PH_KIND(ph)), dim3(grid), dim3(NWAVES * 64), LDS_BYTES, stream, a); }
#endif
}
```

```cpp
#include <hip/hip_runtime.h>
#ifndef ATT_PROBE
#define ATT_PROBE 0
#endif
#include <cstdio>
#include <cstdint>

#define LAS __attribute__((address_space(3)))
#define GAS __attribute__((address_space(1)))
typedef unsigned short bf16;
typedef short bf16x8 __attribute__((ext_vector_type(8)));
typedef float f32x4 __attribute__((ext_vector_type(4)));
typedef float f32x2 __attribute__((ext_vector_type(2)));
typedef float f32x16 __attribute__((ext_vector_type(16)));
typedef unsigned u32x4 __attribute__((ext_vector_type(4)));
typedef unsigned u32x2 __attribute__((ext_vector_type(2)));
typedef GAS unsigned gu32;

constexpr int D = 1024, BATCH = 4, SEQ = 4096, M = BATCH * SEQ, DEPTH = 2;
constexpr int NZ = 4096;
constexpr int D_IN = 3912;
constexpr int NE = 32, TOPK = 4, DFF = 1024, PLE = 256;
constexpr int NSEL = 256;
constexpr int RMAX = M * TOPK + NE * 256;
constexpr int TMAX = RMAX / 256;
constexpr int CAPE = M;
constexpr float LN_EPS = 1e-5f;
constexpr float DN_ALPHA = 1.41421356237309515f;

__device__ __forceinline__ unsigned f2bf(float f) { unsigned u = __builtin_bit_cast(unsigned, f); return (u + 0x7fffu + ((u >> 16) & 1u)) >> 16; }
typedef __bf16 hwbf16x2 __attribute__((ext_vector_type(2)));
__device__ __forceinline__ unsigned pk2(float lo, float hi) { const f32x2 v = {lo, hi}; return __builtin_bit_cast(unsigned, __builtin_convertvector(v, hwbf16x2)); }
__device__ __forceinline__ float bf2f(unsigned short h) { return __builtin_bit_cast(float, (unsigned)h << 16); }
__device__ __forceinline__ float bflo(unsigned w) { return __builtin_bit_cast(float, w << 16); }
__device__ __forceinline__ float bfhi(unsigned w) { return __builtin_bit_cast(float, w & 0xffff0000u); }
__device__ __forceinline__ float sigmoidf_(float x) { return __builtin_amdgcn_rcpf(1.0f + __expf(-x)); }
constexpr float I8_WS_GU = 127.0f / (6.0f / 32.0f), I8_WS_DN = 127.0f / (6.0f / 64.0f), I8_AS = 127.0f / 10.0f;
__device__ __forceinline__ unsigned pack4_i8(float a, float b, float c, float d) {
    unsigned r = 0u;
    r = __builtin_amdgcn_cvt_pk_u8_f32(a + 128.0f, 0, r); r = __builtin_amdgcn_cvt_pk_u8_f32(b + 128.0f, 1, r);
    r = __builtin_amdgcn_cvt_pk_u8_f32(c + 128.0f, 2, r); r = __builtin_amdgcn_cvt_pk_u8_f32(d + 128.0f, 3, r);
    return r ^ 0x80808080u;
}
__device__ __forceinline__ unsigned pack4_fp8(float a, float b, float c, float d) { int r = __builtin_amdgcn_cvt_pk_fp8_f32(a, b, 0, false); r = __builtin_amdgcn_cvt_pk_fp8_f32(c, d, r, true); return (unsigned)r; }
#define LDS_WAIT() asm volatile("s_waitcnt lgkmcnt(0)" ::: "memory")
#define VM_WAIT() asm volatile("s_waitcnt vmcnt(0)" ::: "memory")
#define WAVE_FENCE() do { asm volatile("s_waitcnt lgkmcnt(0)" ::: "memory"); __builtin_amdgcn_wave_barrier(); } while (0)

template <int X> __device__ __forceinline__ float shx(float v) {
    static_assert(X == 1 || X == 2 || X == 4 || X == 8 || X == 16, "shx: xor distance below 32");
    return __builtin_bit_cast(float, __builtin_amdgcn_ds_swizzle(__builtin_bit_cast(int, v), (X << 10) | 0x1f));
}
template <int X> __device__ __forceinline__ int shxi(int v) { return __builtin_amdgcn_ds_swizzle(v, (X << 10) | 0x1f); }
struct SwapPair { unsigned a, b; };
__device__ __forceinline__ SwapPair swap32(float v) { unsigned a = __builtin_bit_cast(unsigned, v), b = a; asm volatile("" : "+v"(b)); const auto r = __builtin_amdgcn_permlane32_swap(a, b, false, false); return SwapPair{r[0], r[1]}; }
__device__ __forceinline__ float sum32(float v) { const SwapPair r = swap32(v); return __builtin_bit_cast(float, r.a) + __builtin_bit_cast(float, r.b); }
__device__ __forceinline__ float max32(float v) { const SwapPair r = swap32(v); return fmaxf(__builtin_bit_cast(float, r.a), __builtin_bit_cast(float, r.b)); }
__device__ __forceinline__ float min32(float v) { const SwapPair r = swap32(v); return fminf(__builtin_bit_cast(float, r.a), __builtin_bit_cast(float, r.b)); }
__device__ __forceinline__ float partner32(float v, bool upper_half) { const SwapPair r = swap32(v); return __builtin_bit_cast(float, upper_half ? r.a : r.b); }

namespace pg8 {
typedef int i32x4 __attribute__((ext_vector_type(4)));
typedef int i32x8 __attribute__((ext_vector_type(8)));
constexpr int BM = 256, BK = 64, HALF = 128, HTB = HALF * BK * 2  , STAGE_BYTES = 8 * HTB;

__host__ __device__ __forceinline__ int lds_byte(int r, int c) { const int st = (r >> 4) * 2 + (c >> 5), rr = r & 15, cc = c & 31, ob = rr * 64 + cc * 2; return st * 1024 + (ob ^ (((ob >> 9) & 1) << 5)); }
__host__ __device__ __forceinline__ void stage_rc(int b, int& R, int& C) { const int st = b / 1024, sb = b % 1024, swz = sb ^ (((sb >> 9) & 1) << 5); R = (st >> 1) * 16 + swz / 64; C = (st & 1) * 32 + (swz % 64) / 2; }
__host__ __device__ __forceinline__ int perm32(int rho) { const int n = rho >> 4, i = rho & 15; return 8 * (i >> 2) + 4 * n + (i & 3); }

struct Unit { int pm, pn, aux, ui; const char* a; const char* b; };
struct Gemm { int lda, K; };

template <class Epi, class Sched, bool ALIGN_EPI, bool I8 = false, bool GATHER = false>
__device__ __forceinline__ void gemm_phase(LAS unsigned char* lds, const int wave_id, const Gemm g, const Sched& S, const Epi& E, const LAS int* RT = nullptr) {
    int lane = (int)__builtin_amdgcn_mbcnt_hi(~0u, __builtin_amdgcn_mbcnt_lo(~0u, 0u)); asm volatile("" : "+v"(lane));
    const int wid = wave_id, tid = wave_id * 64 + lane, wr = wid >> 2, wc = wid & 3, fr = lane & 15, fq = lane >> 4;
    const int K = g.K, nt = K / BK, lda = g.lda;
    unsigned voffA[2], voffB[2]; int gR[2]; unsigned gCb[2];
#pragma unroll
    for (int i = 0; i < 2; ++i) { int R, C; stage_rc(tid * 16 + i * 8192, R, C); const int Rb = Epi::PERM ? ((R & ~31) + perm32(R & 31)) : R;
        voffA[i] = (unsigned)(R * lda + C) * 2u; voffB[i] = (unsigned)(Rb * K + C) * 2u; gR[i] = R; gCb[i] = (unsigned)C * 2u; }
    unsigned gC[2][2], gN[2][2], gS[2][2];
#define PG8_GLOAD(dst, uidx) do { _Pragma("unroll") for (int h_ = 0; h_ < 2; ++h_) _Pragma("unroll") for (int i_ = 0; i_ < 2; ++i_) \
        dst[h_][i_] = (unsigned)RT[(uidx) * 256 + h_ * 128 + gR[i_]] * (unsigned)(lda * 2) + gCb[i_]; \
        asm volatile("s_waitcnt lgkmcnt(0)" : "+v"(dst[0][0]), "+v"(dst[0][1]), "+v"(dst[1][0]), "+v"(dst[1][1]) :: "memory"); } while (0)
    const size_t kstep = (size_t)(BK * 2);
    const size_t hstepA = (size_t)HALF * lda * 2, hstepB = (size_t)HALF * K * 2;
    const unsigned ldsw = (unsigned)wid * 1024u;
    const int aoff = lds_byte(wr * 64 + fr, fq * 8), boff = lds_byte(wc * 32 + fr, fq * 8);
#define PG8_SA(b, h) (((b) * 2 + (h)) * HTB)
#define PG8_SB(b, h) ((4 + (b) * 2 + (h)) * HTB)
#define PG8_STAGE(bufoff, gbase, voff) do { _Pragma("unroll") for (int _i = 0; _i < 2; ++_i) \
        __builtin_amdgcn_global_load_lds((const unsigned*)((const char*)(gbase) + (voff)[_i]), (LAS unsigned*)(lds + (bufoff) + ldsw + _i * 8192), 16, 0, 0); } while (0)
#define PG8_LDA(dst, b, h) do { _Pragma("unroll") for (int m = 0; m < 4; ++m) dst[m] = __builtin_shufflevector(*(const LAS i32x4*)(lds + PG8_SA(b, h) + aoff + m * 2048), *(const LAS i32x4*)(lds + PG8_SA(b, h) + aoff + m * 2048 + 1024), 0, 1, 2, 3, 4, 5, 6, 7); } while (0)
#define PG8_LDB(dst, b, h) do { _Pragma("unroll") for (int n = 0; n < 2; ++n) dst[n] = __builtin_shufflevector(*(const LAS i32x4*)(lds + PG8_SB(b, h) + boff + n * 2048), *(const LAS i32x4*)(lds + PG8_SB(b, h) + boff + n * 2048 + 1024), 0, 1, 2, 3, 4, 5, 6, 7); } while (0)
#define PG8_HALFI(v, k) __builtin_shufflevector(v, v, 4 * (k), 4 * (k) + 1, 4 * (k) + 2, 4 * (k) + 3)
#define PG8_HALF(v, k) __builtin_bit_cast(bf16x8, __builtin_shufflevector(v, v, 4 * (k), 4 * (k) + 1, 4 * (k) + 2, 4 * (k) + 3))
#define PG8_MMA(ai, bj, At, Bt) do { __builtin_amdgcn_s_setprio(1); \
        if constexpr (I8) { _Pragma("unroll") for (int m = 0; m < 4; ++m) _Pragma("unroll") for (int n = 0; n < 2; ++n) { \
            acc[ai][bj][m][n] = __builtin_bit_cast(f32x4, __builtin_amdgcn_mfma_i32_16x16x64_i8(PG8_HALFI(Bt[n], 0), PG8_HALFI(At[m], 0), __builtin_bit_cast(i32x4, acc[ai][bj][m][n]), 0, 0, 0)); \
            acc[ai][bj][m][n] = __builtin_bit_cast(f32x4, __builtin_amdgcn_mfma_i32_16x16x64_i8(PG8_HALFI(Bt[n], 1), PG8_HALFI(At[m], 1), __builtin_bit_cast(i32x4, acc[ai][bj][m][n]), 0, 0, 0)); } } \
        else { _Pragma("unroll") for (int m = 0; m < 4; ++m) _Pragma("unroll") for (int n = 0; n < 2; ++n) { \
            acc[ai][bj][m][n] = __builtin_amdgcn_mfma_f32_16x16x32_bf16(PG8_HALF(Bt[n], 0), PG8_HALF(At[m], 0), acc[ai][bj][m][n], 0, 0, 0); \
            acc[ai][bj][m][n] = __builtin_amdgcn_mfma_f32_16x16x32_bf16(PG8_HALF(Bt[n], 1), PG8_HALF(At[m], 1), acc[ai][bj][m][n], 0, 0, 0); } } \
        __builtin_amdgcn_s_setprio(0); } while (0)
#define PG8_WAIT_V(n) asm volatile("s_waitcnt vmcnt(" #n ")" ::: "memory")
#define PG8_WAIT_L(n) asm volatile("s_waitcnt lgkmcnt(" #n ")" ::: "memory")
#define PG8_BAR __builtin_amdgcn_s_barrier()
#define PG8_SCHED __builtin_amdgcn_sched_barrier(0)
    Unit cur, nxt; int ui = 0;
    if (!S.next(0, cur)) return;
    f32x4 acc[2][2][4][2];
#pragma unroll
    for (int a = 0; a < 2; ++a)
#pragma unroll
        for (int b = 0; b < 2; ++b)
#pragma unroll
            for (int m = 0; m < 4; ++m)
#pragma unroll
                for (int n = 0; n < 2; ++n) acc[a][b][m][n] = (f32x4){0.f, 0.f, 0.f, 0.f};
    i32x8 At[4], B0[2], B1[2];
    const char* cA = cur.a; const char* cB = cur.b;
    if constexpr (GATHER) { PG8_GLOAD(gC, 0); }
#define PG8_STAGE_A(bufoff, gbase, h_, gsel) do { if constexpr (GATHER) PG8_STAGE(bufoff, gbase, gsel[h_]); else PG8_STAGE(bufoff, (gbase) + (h_) * hstepA, voffA); } while (0)
    PG8_STAGE(PG8_SB(0, 0), cB, voffB); PG8_STAGE(PG8_SB(0, 1), cB + hstepB, voffB); PG8_STAGE_A(PG8_SA(0, 0), cA, 0, gC); PG8_STAGE_A(PG8_SA(0, 1), cA, 1, gC);
    if (wr == 1) PG8_BAR;
    PG8_WAIT_V(2); PG8_BAR;
    PG8_STAGE(PG8_SB(1, 0), cB + kstep, voffB); PG8_STAGE_A(PG8_SA(1, 0), cA + kstep, 0, gC); PG8_STAGE(PG8_SB(1, 1), cB + hstepB + kstep, voffB);
    PG8_WAIT_V(6); PG8_BAR;
    for (;;) {
        const bool has_next = S.next(ui + 1, nxt);
        const char* nA = has_next ? nxt.a : cA; const char* nB = has_next ? nxt.b : cB;
        if constexpr (GATHER) { if (has_next) { PG8_GLOAD(gN, ui + 1); } else {
#pragma unroll
            for (int h_ = 0; h_ < 2; ++h_)
#pragma unroll
                for (int i_ = 0; i_ < 2; ++i_) gN[h_][i_] = gC[h_][i_]; } }
#pragma unroll 1
        for (int t = 0; t < nt; t += 2) {
            const bool last = (t == nt - 2);
            const char* a1 = cA + (size_t)(t + 1) * kstep;
            const char* a2 = last ? nA : cA + (size_t)(t + 2) * kstep; const char* b2 = last ? nB : cB + (size_t)(t + 2) * kstep;
            const char* a3 = a2 + kstep; const char* b3 = b2 + kstep;
            if constexpr (GATHER) {
#pragma unroll
                for (int h_ = 0; h_ < 2; ++h_)
#pragma unroll
                    for (int i_ = 0; i_ < 2; ++i_) gS[h_][i_] = last ? gN[h_][i_] : gC[h_][i_]; }
            PG8_LDB(B0, 0, 0); PG8_LDB(B1, 0, 1); PG8_SCHED; PG8_LDA(At, 0, 0); PG8_STAGE_A(PG8_SA(1, 1), a1, 1, gC);
            PG8_WAIT_V(8); PG8_WAIT_L(0); PG8_BAR; PG8_MMA(0, 0, At, B0); PG8_MMA(0, 1, At, B1); PG8_BAR; PG8_SCHED;
            PG8_LDA(At, 0, 1); PG8_STAGE(PG8_SB(0, 0), b2, voffB); PG8_STAGE(PG8_SB(0, 1), b2 + hstepB, voffB); PG8_STAGE_A(PG8_SA(0, 0), a2, 0, gS);
            PG8_WAIT_V(8); PG8_WAIT_L(0); PG8_BAR; PG8_MMA(1, 0, At, B0); PG8_MMA(1, 1, At, B1); PG8_BAR; PG8_SCHED;
            PG8_LDB(B0, 1, 0); PG8_LDB(B1, 1, 1); PG8_SCHED; PG8_LDA(At, 1, 0); PG8_STAGE_A(PG8_SA(0, 1), a2, 1, gS);
            PG8_WAIT_V(8); PG8_WAIT_L(0); PG8_BAR; PG8_MMA(0, 0, At, B0); PG8_MMA(0, 1, At, B1); PG8_BAR; PG8_SCHED;
            PG8_LDA(At, 1, 1); PG8_STAGE(PG8_SB(1, 0), b3, voffB); PG8_STAGE(PG8_SB(1, 1), b3 + hstepB, voffB); PG8_STAGE_A(PG8_SA(1, 0), a3, 0, gS);
            PG8_WAIT_V(8); PG8_WAIT_L(0); PG8_BAR; PG8_MMA(1, 0, At, B0); PG8_MMA(1, 1, At, B1); PG8_BAR; PG8_SCHED;
            if constexpr (Epi::MID) { if (t + 2 == nt / 2) { int fr_m = fr, fq_m = fq; asm volatile("" : "+v"(fr_m), "+v"(fq_m)); E.mid(acc, cur, wr, wc, fr_m, fq_m); } }
        }
        if constexpr (ALIGN_EPI) { if (wr == 0) PG8_BAR; }
        { int fr_e = fr, fq_e = fq; asm volatile("" : "+v"(fr_e), "+v"(fq_e));
          E(acc, cur, wr, wc, fr_e, fq_e);
#if ATT_PROBE == 9
          if constexpr (I8) { asm volatile("" : "+v"(fr_e), "+v"(fq_e)); E(acc, cur, wr, wc, fr_e, fq_e); }
#endif
        }
        if (!has_next) break;
#pragma unroll
        for (int a = 0; a < 2; ++a)
#pragma unroll
            for (int b = 0; b < 2; ++b)
#pragma unroll
                for (int m = 0; m < 4; ++m)
#pragma unroll
                    for (int n = 0; n < 2; ++n) acc[a][b][m][n] = (f32x4){0.f, 0.f, 0.f, 0.f};
        cur = nxt; cA = nA; cB = nB; ++ui;
        if constexpr (GATHER) {
#pragma unroll
            for (int h_ = 0; h_ < 2; ++h_)
#pragma unroll
                for (int i_ = 0; i_ < 2; ++i_) gC[h_][i_] = gN[h_][i_]; }
        if constexpr (ALIGN_EPI) { if (wr == 1) PG8_BAR; }
    }
    PG8_WAIT_V(0);
    if constexpr (!ALIGN_EPI) { if (wr == 0) PG8_BAR; }
    PG8_BAR;
#undef PG8_SA
#undef PG8_SB
#undef PG8_STAGE
#undef PG8_STAGE_A
#undef PG8_GLOAD
#undef PG8_LDA
#undef PG8_LDB
#undef PG8_HALF
#undef PG8_HALFI
#undef PG8_MMA
#undef PG8_WAIT_V
#undef PG8_WAIT_L
#undef PG8_BAR
#undef PG8_SCHED
}
}

namespace pg8 {
constexpr int NXCD = 8, WGM = 8;
struct StaticSched {
    int nM, nN, nwg, G, c; const char* A; const char* B; size_t strideA, strideB;
    __device__ __forceinline__ void init(int M_, int N_, int G_, int c_, const void* A_, int lda, const void* B_, int K) {
        nM = M_ / BM; nN = N_ / BM; nwg = nM * nN; G = G_; c = c_; A = (const char*)A_; B = (const char*)B_; strideA = (size_t)BM * lda * 2; strideB = (size_t)BM * K * 2; }
    __device__ __forceinline__ bool next(int i, Unit& u) const {
        const long L = (long)i * G + c; if (L >= nwg) return false;
        int wgid = (int)L; { const int q = nwg / NXCD, r = nwg % NXCD, xcd = wgid % NXCD, off = wgid / NXCD; wgid = (xcd < r ? xcd * (q + 1) : r * (q + 1) + (xcd - r) * q) + off; }
        const int nig = WGM * nN, gid = wgid / nig, fm = gid * WGM, gsz = (nM - fm) < WGM ? (nM - fm) : WGM;
        u.pm = fm + ((wgid % nig) % gsz); u.pn = (wgid % nig) / gsz; u.aux = 0; u.ui = i;
        u.a = A + (size_t)u.pm * strideA; u.b = B + (size_t)u.pn * strideB; return true;
    }
};
struct MoeSched {
    int ntiles, nN, G, v; const LAS int* tile_e; const char* A; const char* W; size_t strideA, strideE, strideB;
    int p0, np; const char* PA; const char* PW; size_t pstrideA, pstrideB;
    __device__ __forceinline__ bool next(int i, Unit& u) const {
        const int L = i * G + v, nmoe = ntiles * nN;
        if (L < nmoe) { const int tile = L / nN, pn = L - tile * nN; const int e = tile_e[tile];
            u.pm = tile; u.pn = pn; u.aux = e; u.ui = i; u.a = A + (size_t)tile * strideA; u.b = W + (size_t)e * strideE + (size_t)pn * strideB; return true; }
        const int p = L - nmoe; if (p >= np) return false;
        const int q = p0 + p; u.pm = q >> 2; u.pn = q & 3; u.aux = -1; u.ui = i; u.a = PA + (size_t)u.pm * pstrideA; u.b = PW + (size_t)u.pn * pstrideB; return true;
    }
};

#define EPI_LOOP_ROWS for (int ai = 0; ai < 2; ++ai) _Pragma("unroll") for (int m = 0; m < 4; ++m)
__device__ __forceinline__ u32x4 pack8(f32x4 v0, f32x4 v1) { u32x4 w; w.x = pk2(v0[0], v0[1]); w.y = pk2(v0[2], v0[3]); w.z = pk2(v1[0], v1[1]); w.w = pk2(v1[2], v1[3]); return w; }

__device__ __forceinline__ f32x4 i2f4(f32x4 a) { const i32x4 v = __builtin_bit_cast(i32x4, a); return (f32x4){(float)v[0], (float)v[1], (float)v[2], (float)v[3]}; }
template <bool I8IN> struct EpiZ {
    static constexpr bool PERM = true, MID = false;
    bf16 *Q, *KV, *QI, *KI; float* WI; bf16 *U, *SGA, *SGB; const float* rope; const float* rows;
    __device__ __forceinline__ void operator()(const f32x4 (&acc)[2][2][4][2], const Unit& u, int wr, int wc, int fr, int fq) const {
        const int pn = u.pn; bf16* dst; int ldc, cb; unsigned ropemask = 0u; int mode = 0;
        if (pn < 2) { dst = Q; ldc = 512; cb = 256 * pn; ropemask = 0xFu; }
        else if (pn == 2) { dst = KV; ldc = 256; cb = 0; ropemask = 0x3u; }
        else if (pn < 5) { dst = QI; ldc = 512; cb = 256 * (pn - 3); ropemask = 0xFu; }
        else if (pn == 5) { dst = KI; ldc = 64; cb = 0; ropemask = 0x1u; mode = 2; }
        else if (pn < 8) { dst = U; ldc = 512; cb = 256 * (pn - 6); }
        else if (pn < 12) { dst = SGA; ldc = 1024; cb = 256 * (pn - 8); mode = 1; }
        else { dst = SGB; ldc = 1024; cb = 256 * (pn - 12); mode = 1; }
        const int row0 = u.pm * BM + wr * 64 + fr;
        float rsv[2][4];
#pragma unroll
        EPI_LOOP_ROWS { rsv[ai][m] = 1.0f; if constexpr (I8IN) rsv[ai][m] = rows[row0 + ai * HALF + m * 16]; }
        const bool ropewave = ropemask != 0u && !(wc & 1);
#pragma unroll
        for (int ai = 0; ai < 2; ++ai) {
        f32x4 rc[4][4];
#pragma unroll
        for (int m = 0; m < 4; ++m)
#pragma unroll
            for (int q = 0; q < 4; ++q) rc[m][q] = (f32x4){0.f, 0.f, 0.f, 0.f};
        if (ropewave && fq < 2) {
#pragma unroll
            for (int m = 0; m < 4; ++m) { const int pos = (row0 + ai * HALF + m * 16) & (SEQ - 1);
#pragma unroll
                for (int q = 0; q < 4; ++q) rc[m][q] = *(const f32x4*)(rope + pos * 16 + 4 * q); }
        }
        asm volatile("" ::: "memory");
#pragma unroll
        for (int m = 0; m < 4; ++m) {
            const int row = row0 + ai * HALF + m * 16;
            const float rs = rsv[ai][m] * (1.0f / I8_WS_GU);
#pragma unroll
            for (int bj = 0; bj < 2; ++bj) {
                f32x4 v0 = acc[ai][bj][m][0], v1 = acc[ai][bj][m][1];
                if constexpr (I8IN) { v0 = i2f4(v0) * rs; v1 = i2f4(v1) * rs; }
                const int grp = 2 * bj + (wc >> 1);
                if (((ropemask >> grp) & 1u) && !(wc & 1)) {
                    f32x4 p0, p1;
#pragma unroll
                    for (int e = 0; e < 4; ++e) { p0[e] = shx<16>(v0[e]); p1[e] = shx<16>(v1[e]); }
                    if (fq < 2) {
                        const f32x4 c0 = rc[m][0], c1 = rc[m][1], s0 = rc[m][2], s1 = rc[m][3];
                        if (fq == 0) { v0 = v0 * c0 - p0 * s0; v1 = v1 * c1 - p1 * s1; }
                        else         { v0 = v0 * c0 + p0 * s0; v1 = v1 * c1 + p1 * s1; }
                    }
                }
                if (mode == 1) {
#pragma unroll
                    for (int e = 0; e < 4; ++e) { v0[e] = sigmoidf_(v0[e]); v1[e] = sigmoidf_(v1[e]); }
                }
                if (mode == 2) {
                    if (bj == 0) {
                        if (wc < 2) *(u32x4*)(KI + ((size_t)((row >> 5) * 4 + 2 * wc + (fq >> 1)) * 64 + (row & 31) + 32 * (fq & 1)) * 8) = pack8(v0, v1);
                        else if (wc == 2 && fq == 0) { *(f32x4*)(WI + (size_t)row * 8) = v0; *(f32x4*)(WI + (size_t)row * 8 + 4) = v1; }
                    }
                } else if (pn == 2) {
                    u32x2 w8; w8.x = pack4_fp8(v0[0], v0[1], v0[2], v0[3]); w8.y = pack4_fp8(v1[0], v1[1], v1[2], v1[3]);
                    *(u32x2*)((unsigned char*)KV + (size_t)row * 256 + 128 * bj + 32 * wc + 8 * fq) = w8;
                } else {
                    if (mode == 1) __builtin_nontemporal_store(pack8(v0, v1), (u32x4*)(dst + (size_t)row * ldc + cb + 128 * bj + 32 * wc + 8 * fq));
                    else *(u32x4*)(dst + (size_t)row * ldc + cb + 128 * bj + 32 * wc + 8 * fq) = pack8(v0, v1);
                }
            }
        }
        asm volatile("" ::: "memory");
        }
    }
};
struct EpiBf16 {
    static constexpr bool PERM = true, MID = false;
    bf16* O; int ldc, coff; const float* scale;
    __device__ __forceinline__ void operator()(const f32x4 (&acc)[2][2][4][2], const Unit& u, int wr, int wc, int fr, int fq) const {
        const int row0 = u.pm * BM + wr * 64 + fr, col0 = u.pn * BM + wc * 32 + 8 * fq;
        f32x4 sv[2][2];
#pragma unroll
        for (int bj = 0; bj < 2; ++bj)
#pragma unroll
            for (int n = 0; n < 2; ++n) sv[bj][n] = scale ? *(const f32x4*)(scale + col0 + bj * HALF + 4 * n) : (f32x4){1.f, 1.f, 1.f, 1.f};
#pragma unroll
        EPI_LOOP_ROWS {
            bf16* rowp = O + (size_t)(row0 + ai * HALF + m * 16) * ldc + coff + col0;
#pragma unroll
            for (int bj = 0; bj < 2; ++bj) *(u32x4*)(rowp + bj * HALF) = pack8(acc[ai][bj][m][0] * sv[bj][0], acc[ai][bj][m][1] * sv[bj][1]);
        }
    }
};
struct EpiGateMerge {
    static constexpr bool PERM = true, MID = true;
    const bf16* SGA; const bf16* SGB; bf16* O;
    __device__ __forceinline__ void mid(f32x4 (&acc)[2][2][4][2], const Unit& u, int wr, int wc, int fr, int fq) const {
        const int row0 = u.pm * BM + wr * 64 + fr, col0 = u.pn * BM + wc * 32 + 8 * fq;
#pragma unroll
        for (int aq = 0; aq < 4; ++aq) {
            const int ai = aq >> 1;
            u32x4 ga[2][2], gb[2][2];
#pragma unroll
            for (int mm = 0; mm < 2; ++mm)
#pragma unroll
                for (int bj = 0; bj < 2; ++bj) { const size_t off = (size_t)(row0 + ai * HALF + (2 * (aq & 1) + mm) * 16) * 1024 + col0 + bj * HALF; ga[mm][bj] = *(const u32x4*)(SGA + off); gb[mm][bj] = *(const u32x4*)(SGB + off); }
            asm volatile("" ::: "memory");
#pragma unroll
            for (int mm = 0; mm < 2; ++mm)
#pragma unroll
                for (int bj = 0; bj < 2; ++bj) {
                    const int m = 2 * (aq & 1) + mm;
                    const u32x4 a = ga[mm][bj], b = gb[mm][bj];
                    f32x4& v0 = acc[ai][bj][m][0]; f32x4& v1 = acc[ai][bj][m][1];
                    v0[0] *= bflo(a.x) * __builtin_amdgcn_rcpf(bflo(b.x)); v0[1] *= bfhi(a.x) * __builtin_amdgcn_rcpf(bfhi(b.x)); v0[2] *= bflo(a.y) * __builtin_amdgcn_rcpf(bflo(b.y)); v0[3] *= bfhi(a.y) * __builtin_amdgcn_rcpf(bfhi(b.y));
                    v1[0] *= bflo(a.z) * __builtin_amdgcn_rcpf(bflo(b.z)); v1[1] *= bfhi(a.z) * __builtin_amdgcn_rcpf(bfhi(b.z)); v1[2] *= bflo(a.w) * __builtin_amdgcn_rcpf(bflo(b.w)); v1[3] *= bfhi(a.w) * __builtin_amdgcn_rcpf(bfhi(b.w));
                }
            asm volatile("" ::: "memory");
        }
    }
    __device__ __forceinline__ void operator()(const f32x4 (&acc)[2][2][4][2], const Unit& u, int wr, int wc, int fr, int fq) const {
        const int row0 = u.pm * BM + wr * 64 + fr, col0 = u.pn * BM + wc * 32 + 8 * fq;
        u32x4 gq[2][4][2];
#pragma unroll
        EPI_LOOP_ROWS
#pragma unroll
            for (int bj = 0; bj < 2; ++bj) gq[ai][m][bj] = *(const u32x4*)(SGB + (size_t)(row0 + ai * HALF + m * 16) * 1024 + col0 + bj * HALF);
        asm volatile("" ::: "memory");
#pragma unroll
        EPI_LOOP_ROWS {
            const size_t off = (size_t)(row0 + ai * HALF + m * 16) * 1024 + col0;
#pragma unroll
            for (int bj = 0; bj < 2; ++bj) {
                const u32x4 g = gq[ai][m][bj];
                f32x4 v0 = acc[ai][bj][m][0], v1 = acc[ai][bj][m][1];
                v0[0] *= bflo(g.x); v0[1] *= bfhi(g.x); v0[2] *= bflo(g.y); v0[3] *= bfhi(g.y); v1[0] *= bflo(g.z); v1[1] *= bfhi(g.z); v1[2] *= bflo(g.w); v1[3] *= bfhi(g.w);
                *(u32x4*)(O + off + bj * HALF) = pack8(v0, v1);
            }
        }
        asm volatile("" ::: "memory");
    }
};
struct EpiResid {
    static constexpr bool PERM = true, MID = false;
    const bf16* X; bf16* V; float alpha;
    __device__ __forceinline__ void operator()(const f32x4 (&acc)[2][2][4][2], const Unit& u, int wr, int wc, int fr, int fq) const {
        const int row0 = u.pm * BM + wr * 64 + fr, col0 = u.pn * BM + wc * 32 + 8 * fq;
        u32x4 xv[2][4][2];
#pragma unroll
        EPI_LOOP_ROWS
#pragma unroll
            for (int bj = 0; bj < 2; ++bj) xv[ai][m][bj] = *(const u32x4*)(X + (size_t)(row0 + ai * HALF + m * 16) * 1024 + col0 + bj * HALF);
        asm volatile("" ::: "memory");
#pragma unroll
        EPI_LOOP_ROWS
#pragma unroll
            for (int bj = 0; bj < 2; ++bj) { const u32x4 w = xv[ai][m][bj];
                *(u32x4*)(V + (size_t)(row0 + ai * HALF + m * 16) * 1024 + col0 + bj * HALF) =
                    pack8((f32x4){bflo(w.x), bfhi(w.x), bflo(w.y), bfhi(w.y)} * alpha + acc[ai][bj][m][0], (f32x4){bflo(w.z), bfhi(w.z), bflo(w.w), bfhi(w.w)} * alpha + acc[ai][bj][m][1]); }
        asm volatile("" ::: "memory");
    }
};
__device__ __forceinline__ f32x4 swiglu4(f32x4 g, f32x4 u) {
    f32x4 gt, up, sg;
#pragma unroll
    for (int e = 0; e < 4; ++e) { gt[e] = fminf(g[e], 7.0f); up[e] = fminf(fmaxf(u[e], -7.0f), 7.0f); }
    const f32x4 ea = gt * (-1.702f * 1.44269504088896341f);
#pragma unroll
    for (int e = 0; e < 4; ++e) sg[e] = __builtin_amdgcn_exp2f(ea[e]);
    sg = sg + 1.0f;
#pragma unroll
    for (int e = 0; e < 4; ++e) sg[e] = __builtin_amdgcn_rcpf(sg[e]);
    const f32x4 as4 = (f32x4){I8_AS, I8_AS, I8_AS, I8_AS};
    return (gt * sg) * __builtin_elementwise_fma(up, as4, as4);
}
struct EpiSwigluI8 {
    static constexpr bool PERM = true, MID = false;
    const float* bgu; const LAS float* rsl; unsigned char* ACT;
    __device__ __forceinline__ void operator()(const f32x4 (&acc)[2][2][4][2], const Unit& u, int wr, int wc, int fr, int fq) const {
        const int row0 = u.pm * BM + wr * 64 + fr, cin = wc * 32 + 8 * fq, col0 = u.pn * HALF + cin;
        const float* bb = bgu + (size_t)u.aux * 2048 + col0;
        const f32x4 bg0 = *(const f32x4*)(bb), bg1 = *(const f32x4*)(bb + 4), bu0 = *(const f32x4*)(bb + 1024), bu1 = *(const f32x4*)(bb + 1028);
        float rsv[2][4];
#pragma unroll
        EPI_LOOP_ROWS rsv[ai][m] = rsl[u.ui * 256 + wr * 64 + fr + ai * HALF + m * 16];
        asm volatile("" ::: "memory");
#pragma unroll
        EPI_LOOP_ROWS {
            const int row = row0 + ai * HALF + m * 16; const float rs = rsv[ai][m] * (1.0f / I8_WS_GU);
            const f32x4 rs4 = (f32x4){rs, rs, rs, rs};
            const f32x4 o0 = swiglu4(__builtin_elementwise_fma(i2f4(acc[ai][0][m][0]), rs4, bg0), __builtin_elementwise_fma(i2f4(acc[ai][1][m][0]), rs4, bu0));
            const f32x4 o1 = swiglu4(__builtin_elementwise_fma(i2f4(acc[ai][0][m][1]), rs4, bg1), __builtin_elementwise_fma(i2f4(acc[ai][1][m][1]), rs4, bu1));
            u32x2 w; w.x = pack4_i8(o0[0], o0[1], o0[2], o0[3]); w.y = pack4_i8(o1[0], o1[1], o1[2], o1[3]);
            *(u32x2*)(ACT + (size_t)row * 1024 + col0) = w;
        }
        asm volatile("" ::: "memory");
    }
};
struct EpiDownI8 {
    static constexpr bool PERM = true, MID = false;
    const float* bdn; const float* p2g; const LAS int* ts; bf16* YR;
    __device__ __forceinline__ void operator()(const f32x4 (&acc)[2][2][4][2], const Unit& u, int wr, int wc, int fr, int fq) const {
        const int row0 = u.pm * BM + wr * 64 + fr, col0 = u.pn * BM + wc * 32 + 8 * fq;
        const float* bp = bdn + (size_t)u.aux * 1024 + col0;
        constexpr float rs = 1.0f / (I8_AS * I8_WS_DN);
        f32x4 bv[2][2]; float gv[2][4];
#pragma unroll
        for (int bj = 0; bj < 2; ++bj) { bv[bj][0] = *(const f32x4*)(bp + bj * HALF); bv[bj][1] = *(const f32x4*)(bp + bj * HALF + 4); }
        const float* gp = p2g + (size_t)u.aux * CAPE + (u.pm - ts[u.aux]) * BM + wr * 64 + fr;
#pragma unroll
        EPI_LOOP_ROWS gv[ai][m] = gp[ai * HALF + m * 16];
        asm volatile("" ::: "memory");
#pragma unroll
        EPI_LOOP_ROWS {
            const int row = row0 + ai * HALF + m * 16; const float gt = gv[ai][m];
#pragma unroll
            for (int bj = 0; bj < 2; ++bj)
                *(u32x4*)(YR + (size_t)row * 1024 + col0 + bj * HALF) = pack8((i2f4(acc[ai][bj][m][0]) * rs + bv[bj][0]) * gt, (i2f4(acc[ai][bj][m][1]) * rs + bv[bj][1]) * gt);
        }
        asm volatile("" ::: "memory");
    }
};
struct EpiPleGateI8 {
    static constexpr bool PERM = true, MID = false;
    const bf16* P; const float* rows; bf16* O;
    __device__ __forceinline__ void operator()(const f32x4 (&acc)[2][2][4][2], const Unit& u, int wr, int wc, int fr, int fq) const {
        const int row0 = u.pm * BM + wr * 64 + fr, col0 = u.pn * BM + wc * 32 + 8 * fq;
        float rsv[2][4];
#pragma unroll
        EPI_LOOP_ROWS rsv[ai][m] = rows[row0 + ai * HALF + m * 16];
#pragma unroll
        for (int ai = 0; ai < 2; ++ai) {
            u32x4 gq[4][2];
#pragma unroll
            for (int m = 0; m < 4; ++m)
#pragma unroll
                for (int bj = 0; bj < 2; ++bj) gq[m][bj] = *(const u32x4*)(P + (size_t)(row0 + ai * HALF + m * 16) * 1024 + col0 + bj * HALF);
            asm volatile("" ::: "memory");
#pragma unroll
            for (int m = 0; m < 4; ++m) {
                const int row = row0 + ai * HALF + m * 16; const size_t off = (size_t)row * 1024 + col0; const float rs = rsv[ai][m] * (1.0f / I8_WS_GU);
#pragma unroll
                for (int bj = 0; bj < 2; ++bj) {
                    const u32x4 g = gq[m][bj];
                    f32x4 v0 = i2f4(acc[ai][bj][m][0]) * rs, v1 = i2f4(acc[ai][bj][m][1]) * rs;
                    v0[0] = sigmoidf_(v0[0]) * bflo(g.x); v0[1] = sigmoidf_(v0[1]) * bfhi(g.x); v0[2] = sigmoidf_(v0[2]) * bflo(g.y); v0[3] = sigmoidf_(v0[3]) * bfhi(g.y);
                    v1[0] = sigmoidf_(v1[0]) * bflo(g.z); v1[1] = sigmoidf_(v1[1]) * bfhi(g.z); v1[2] = sigmoidf_(v1[2]) * bflo(g.w); v1[3] = sigmoidf_(v1[3]) * bfhi(g.w);
                    *(u32x4*)(O + off + bj * HALF) = pack8(v0, v1);
                }
            }
            asm volatile("" ::: "memory");
        }
    }
};
struct EpiSwigluPle {
    static constexpr bool PERM = true, MID = false;
    EpiSwigluI8 moe; EpiPleGateI8 ple;
    __device__ __forceinline__ void operator()(const f32x4 (&acc)[2][2][4][2], const Unit& u, int wr, int wc, int fr, int fq) const { if (u.aux >= 0) moe(acc, u, wr, wc, fr, fq); else ple(acc, u, wr, wc, fr, fq); }
};
struct EpiDownPle {
    static constexpr bool PERM = true, MID = false;
    EpiDownI8 moe; EpiPleGateI8 ple;
    __device__ __forceinline__ void operator()(const f32x4 (&acc)[2][2][4][2], const Unit& u, int wr, int wc, int fr, int fq) const { if (u.aux >= 0) moe(acc, u, wr, wc, fr, fq); else ple(acc, u, wr, wc, fr, fq); }
};
#undef EPI_LOOP_ROWS
}

constexpr size_t MiB = 1u << 20;
constexpr size_t WS_CTL = 0, CTL_ZERO_BYTES = 1 * MiB;
constexpr int CW_BAR = 4096;
constexpr size_t LW_WIN = 0, LW_WUPA = 8 * MiB, LW_WUPB = 9 * MiB, LW_POOL = 10 * MiB, LW_WOUT = 11 * MiB, LW_PLEG = 13 * MiB, LW_PLEP = 15 * MiB, LW_WGU = 16 * MiB, LW_WDN = 144 * MiB, LW_SIZE = 208 * MiB;
constexpr size_t WS_W = 1 * MiB;
constexpr size_t WS_ROPE = WS_W + DEPTH * LW_SIZE;
constexpr size_t WS_PB16 = WS_ROPE + 1 * MiB;
constexpr size_t WS_XF = WS_PB16 + 16 * MiB;
constexpr size_t WS_XB = WS_XF + 64 * MiB;
constexpr size_t WS_Q = WS_XB + 32 * MiB;
constexpr size_t WS_KV = WS_Q + 16 * MiB;
constexpr size_t WS_QI = WS_KV + 8 * MiB;
constexpr size_t WS_KI = WS_QI + 16 * MiB;
constexpr size_t WS_WI = WS_KI + 2 * MiB;
constexpr size_t WS_U = WS_WI + 1 * MiB;
constexpr size_t WS_SGA = WS_U + 16 * MiB;
constexpr size_t WS_SGB = WS_SGA + 32 * MiB;
constexpr size_t WS_YAYP = WS_SGB + 32 * MiB;
constexpr size_t WS_DP = WS_YAYP + 32 * MiB;
constexpr size_t WS_T1 = WS_DP + 16 * MiB;
constexpr size_t WS_MRG = WS_T1 + 64 * MiB;
constexpr size_t WS_X1F = WS_MRG + 32 * MiB;
constexpr size_t WS_X1B = WS_X1F + 64 * MiB;
constexpr size_t WS_XS = WS_X1B + 32 * MiB;
constexpr size_t WS_ACT = WS_XS + 144 * MiB;
constexpr size_t WS_YR = WS_ACT + 144 * MiB;
constexpr size_t WS_PLEP = WS_YR + 144 * MiB;
constexpr size_t WS_PLEV = WS_PLEP + 32 * MiB;
constexpr size_t WS_ROUTE = WS_PLEV + 32 * MiB;
constexpr size_t RT_TOPI = 0, RT_GATE = 256 * 1024, RT_LRANK = 512 * 1024, RT_TOKROW = 768 * 1024, RT_ROWG = 1024 * 1024, RT_HIST = 1536 * 1024, RT_TILE = 1664 * 1024, RT_ROWS = 1700 * 1024, RT_X1S = 1472 * 1024, RT_XQS = 1988 * 1024;
constexpr size_t WS_END = WS_ROUTE + 3 * MiB;
static_assert((size_t)RMAX * 1024 * 2 == 144 * MiB, "row buffers");
static_assert(RT_ROWG + (size_t)RMAX * 4 <= RT_X1S && RT_X1S + (size_t)M * 4 <= RT_HIST && RT_HIST + (size_t)DEPTH * 256 * 32 * 4 <= RT_TILE && RT_ROWS + (size_t)RMAX * 4 <= RT_XQS, "routing map");

constexpr int RING_BYTES = 131072;
constexpr int XTRA_OFF = RING_BYTES;
constexpr int XTRA_BYTES = 24576;
constexpr int MISC_OFF = XTRA_OFF + XTRA_BYTES;
constexpr int LDS_BYTES = MISC_OFF + 4096;
constexpr int NWAVES = 8;
constexpr int CW_CNT = 1024;

#define XB_TMO      128
#define XB_XCNT(j)  (256  + 64 * (j))
#define XB_XSUB(j)  (1280 + 64 * (j))
#define XB_XGEN(j)  (2304 + 64 * (j))
#define XB_TOP      3328
#define XB_TOPGEN   3392
#define XCD_BAR_WORDS 3456
#define XB_SPIN_CAP (1u << 18)

__device__ __forceinline__ unsigned xb_ld(unsigned* p)              { return __hip_atomic_load(p, __ATOMIC_RELAXED, __HIP_MEMORY_SCOPE_AGENT); }
__device__ __forceinline__ unsigned xb_add(unsigned* p, unsigned v) { return __hip_atomic_fetch_add(p, v, __ATOMIC_RELAXED, __HIP_MEMORY_SCOPE_AGENT); }
__device__ __forceinline__ unsigned xb_xcc_id() { return (unsigned)__builtin_amdgcn_s_getreg((3 << 11) | 20) & 0xFu; }
#define XB_SPIN(cond, bar) do { unsigned _sp = 0; while (cond) { __builtin_amdgcn_s_sleep(1); \
    if ((++_sp & 255u) == 0u) { if (xb_ld(&(bar)[XB_TMO])) break; if (_sp > XB_SPIN_CAP) { atomicAdd(&(bar)[XB_TMO], 1u); break; } } } } while (0)

struct XcdBarrier {
    unsigned* bar; unsigned x;
    volatile LAS unsigned* st;
};

__device__ __forceinline__ XcdBarrier xcd_barrier_post(unsigned* bar, volatile LAS unsigned* st) {
    XcdBarrier b; b.bar = bar; b.x = xb_xcc_id(); b.st = st;
    if (threadIdx.x == 0) (void)xb_add(&bar[XB_XCNT(b.x)], 1u);
    return b;
}
__device__ __forceinline__ void xcd_barrier_complete(unsigned* bar, unsigned x, unsigned& nloc, unsigned& nx) {
    const unsigned G = gridDim.x * gridDim.y * gridDim.z;
    unsigned sum, cnt, mine, sp = 0u;
    for (;;) {
        sum = 0u; cnt = 0u; mine = 0u;
#pragma unroll
        for (unsigned j = 0; j < 16; ++j) { const unsigned c = xb_ld(&bar[XB_XCNT(j)]); sum += c; cnt += (c > 0u) ? 1u : 0u; mine = (j == x) ? c : mine; }
        if (sum == G) break;
        __builtin_amdgcn_s_sleep(1);
        if ((++sp & 255u) == 0u) { if (xb_ld(&bar[XB_TMO])) break; if (sp > XB_SPIN_CAP) { atomicAdd(&bar[XB_TMO], 1u); break; } }
    }
    nloc = mine > 0u ? mine : 1u; nx = cnt > 0u ? cnt : 1u;
}

__device__ __forceinline__ void xcd_barrier(const XcdBarrier& b) {
    asm volatile("s_waitcnt vmcnt(0)" ::: "memory");
    __syncthreads();
    if (threadIdx.x == 0) {
        unsigned* bar = b.bar; { size_t zo_ = 0; asm volatile("" : "+s"(zo_)); bar += zo_; }
        __builtin_amdgcn_s_waitcnt(0);
        unsigned bx = b.x; asm volatile("" : "+s"(bx));
        unsigned nloc = b.st[0], nx = b.st[1];
        if (nloc == 0u) { xcd_barrier_complete(bar, bx, nloc, nx); b.st[0] = nloc; b.st[1] = nx; }
        const unsigned old = xb_add(&bar[XB_XSUB(bx)], 1u);
        const unsigned gen = old / nloc;
        if (old + 1u == (gen + 1u) * nloc) {
            __builtin_amdgcn_fence(__ATOMIC_RELEASE, "agent");
            asm volatile("s_waitcnt vmcnt(0)" ::: "memory");
            const unsigned og = xb_add(&bar[XB_TOP], 1u);
            const unsigned tg = og / nx;
            if (og + 1u == (tg + 1u) * nx) xb_add(&bar[XB_TOPGEN], 1u);
            else XB_SPIN(xb_ld(&bar[XB_TOPGEN]) == tg, bar);
            __builtin_amdgcn_fence(__ATOMIC_ACQUIRE, "agent");
            xb_add(&bar[XB_XGEN(bx)], 1u);
            asm volatile("s_waitcnt vmcnt(0)" ::: "memory");
        } else {
            XB_SPIN(xb_ld(&bar[XB_XGEN(bx)]) == gen, bar);
            __builtin_amdgcn_fence(__ATOMIC_ACQUIRE, "agent");
            asm volatile("s_waitcnt vmcnt(0)" ::: "memory");
        }
    }
    __syncthreads();
}


template <int CTRL> __device__ __forceinline__ float dppx(float v) { return __builtin_bit_cast(float, __builtin_amdgcn_update_dpp(0, __builtin_bit_cast(int, v), CTRL, 0xf, 0xf, false)); }
__device__ __forceinline__ float wave_sum(float v, int) { v += dppx<0xB1>(v); v += dppx<0x4E>(v); v += dppx<0x141>(v); v += dppx<0x140>(v); v += shx<16>(v); return sum32(v); }
__device__ __forceinline__ float wave_max(float v, int) { v = fmaxf(v, dppx<0xB1>(v)); v = fmaxf(v, dppx<0x4E>(v)); v = fmaxf(v, dppx<0x141>(v)); v = fmaxf(v, dppx<0x140>(v)); v = fmaxf(v, shx<16>(v)); return max32(v); }
__device__ __forceinline__ float wave_min(float v, int) { v = fminf(v, dppx<0xB1>(v)); v = fminf(v, dppx<0x4E>(v)); v = fminf(v, dppx<0x141>(v)); v = fminf(v, dppx<0x140>(v)); v = fminf(v, shx<16>(v)); return min32(v); }
struct MapId { __device__ __forceinline__ int operator()(int n) const { return n; } };
struct MapWin { __device__ __forceinline__ int operator()(int n) const {
    if (n < 512) return n;
    if (n < 768) return n;
    if (n < 1352) return n;
    if (n < 1536) return -1;
    if (n < 2048) return 1352 + (n - 1536);
    if (n < 3072) return 1864 + (n - 2048);
    return 2888 + (n - 3072); } };
struct MapGU { __device__ __forceinline__ int operator()(int n) const { const int t = n >> 8, w = n & 255; return w < 128 ? t * 128 + w : 1024 + t * 128 + (w - 128); } };

struct LnGB { f32x4 g[4], b[4]; };
__device__ __forceinline__ void ln_load(LnGB& p, const float* g, const float* b, int lane) {
#pragma unroll
    for (int j = 0; j < 4; ++j) { p.g[j] = *(const f32x4*)(g + 4 * lane + 256 * j); p.b[j] = *(const f32x4*)(b + 4 * lane + 256 * j); }
    asm volatile("" ::: "memory");
}
__device__ __forceinline__ void ln_regs(f32x4 (&v)[4], const LnGB& p, int lane) {
    float s = 0.f;
#pragma unroll
    for (int j = 0; j < 4; ++j) s += (v[j].x + v[j].y) + (v[j].z + v[j].w);
    const float mean = wave_sum(s, lane) * (1.f / D); float s2 = 0.f;
#pragma unroll
    for (int j = 0; j < 4; ++j) { v[j] = v[j] - mean; s2 += (v[j].x * v[j].x + v[j].y * v[j].y) + (v[j].z * v[j].z + v[j].w * v[j].w); }
    const float rstd = 1.f / sqrtf(wave_sum(s2, lane) * (1.f / D) + LN_EPS);
#pragma unroll
    for (int j = 0; j < 4; ++j) v[j] = v[j] * rstd * p.g[j] + p.b[j];
}
__device__ __forceinline__ void store_row_f32(float* row, const f32x4 (&v)[4], int lane) {
#pragma unroll
    for (int j = 0; j < 4; ++j) __builtin_nontemporal_store(v[j], (f32x4*)(row + 4 * lane + 256 * j));
}
__device__ __forceinline__ float store_row_i8(unsigned char* row, float* scale_out, const f32x4 (&v)[4], int lane) {
    float mx = 0.f;
#pragma unroll
    for (int j = 0; j < 4; ++j) mx = fmaxf(fmaxf(mx, fmaxf(fabsf(v[j].x), fabsf(v[j].y))), fmaxf(fabsf(v[j].z), fabsf(v[j].w)));
    mx = fmaxf(wave_max(mx, lane), 1e-20f); const float inv = 127.0f / mx;
    if (lane == 0) *scale_out = mx * (1.0f / 127.0f);
#pragma unroll
    for (int j = 0; j < 4; ++j) *(unsigned*)(row + 4 * lane + 256 * j) = pack4_i8(v[j].x * inv, v[j].y * inv, v[j].z * inv, v[j].w * inv);
    return mx * (1.0f / 127.0f);
}
__device__ __forceinline__ void store_row_bf16(bf16* row, const f32x4 (&v)[4], int lane) {
#pragma unroll
    for (int j = 0; j < 4; ++j) { u32x2 w; w.x = pk2(v[j].x, v[j].y); w.y = pk2(v[j].z, v[j].w); __builtin_nontemporal_store(w, (u32x2*)(row + 4 * lane + 256 * j)); }
}

typedef __bf16 bf16x2_t __attribute__((ext_vector_type(2)));
typedef short v4i16_t __attribute__((ext_vector_type(4)));
typedef int v2i32_t __attribute__((ext_vector_type(2)));
typedef short s16x4_t __attribute__((ext_vector_type(4)));
__device__ __forceinline__ float dot2bf(unsigned a, unsigned b, float c) { return __builtin_amdgcn_fdot2_f32_bf16(__builtin_bit_cast(bf16x2_t, a), __builtin_bit_cast(bf16x2_t, b), c, false); }

__device__ __forceinline__ int score_bin(float v, float vmin, float scale) { return (int)((v - vmin) * scale); }

__device__ __forceinline__ void attn_unit(LAS unsigned char* lds, const int wave, const int lane_in, const int b, const int t0,
                                          const bf16* QI, const bf16* KI, const float* WI, const bf16* Q, const bf16* KV, bf16* YAYP) {
    int lane = lane_in; asm volatile("" : "+v"(lane));
    const int m0 = b * SEQ + t0;
    const int r = lane & 31, h = lane >> 5;
    const int qit = 2 * ((r >> 2) & 1) + (r >> 4), hd = (r & 3) + 4 * ((r >> 3) & 1);
    bf16x8 Af[4][4];
#pragma unroll
    for (int mt = 0; mt < 4; ++mt)
#pragma unroll
        for (int ks = 0; ks < 4; ++ks) Af[mt][ks] = *(const bf16x8*)(QI + (size_t)(m0 + 4 * mt + qit) * 512 + hd * 64 + 16 * ks + 8 * h);
    f32x4 wv[4][2][2];
#pragma unroll
    for (int mt = 0; mt < 4; ++mt)
#pragma unroll
        for (int qq = 0; qq < 2; ++qq) { const float* wp = WI + (size_t)(m0 + 4 * mt + 2 * h + qq) * 8; wv[mt][qq][0] = *(const f32x4*)wp; wv[mt][qq][1] = *(const f32x4*)(wp + 4); }
    typedef _Float16 h16x2 __attribute__((ext_vector_type(2)));
    h16x2 wh[4][2][4];
#pragma unroll
    for (int mt = 0; mt < 4; ++mt)
#pragma unroll
        for (int qq = 0; qq < 2; ++qq)
#pragma unroll
            for (int p = 0; p < 4; ++p) wh[mt][qq][p] = __builtin_bit_cast(h16x2, __builtin_amdgcn_cvt_pkrtz(wv[mt][qq][p >> 1][2 * (p & 1)], wv[mt][qq][p >> 1][2 * (p & 1) + 1]));
    for (int rep2_ = 0; rep2_ < (ATT_PROBE == 1 ? 2 : 1); ++rep2_) {
    const int nkt = (t0 + 16 + 31) >> 5;
    LAS _Float16* SCH = (LAS _Float16*)lds;
    const bf16* kib = KI + (size_t)b * SEQ * 64;
#pragma unroll 1
    for (int kt0 = wave; kt0 < nkt; kt0 += 32) {
        bf16x8 Bq[4][4];
#pragma unroll
        for (int u = 0; u < 4; ++u) {
            if (kt0 + 8 * u < nkt) {
#pragma unroll
                for (int ks = 0; ks < 4; ++ks) Bq[u][ks] = *(const bf16x8*)(kib + ((size_t)((kt0 + 8 * u) * 4 + ks) * 64 + lane) * 8);
            }
        }
#pragma unroll
        for (int u = 0; u < 4; ++u) {
            if (kt0 + 8 * u < nkt) {
                const int key = 32 * (kt0 + 8 * u) + r;
#pragma unroll
                for (int mt = 0; mt < 4; ++mt) {
                    f32x16 acc;
#pragma unroll
                    for (int i = 0; i < 16; ++i) acc[i] = 0.f;
#pragma unroll
                    for (int ks = 0; ks < 4; ++ks) acc = __builtin_amdgcn_mfma_f32_32x32x16_bf16(Af[mt][ks], Bq[u][ks], acc, 0, 0, 0);
                    h16x2 a0 = (h16x2){(_Float16)0.f, (_Float16)0.f}, a1 = a0; const h16x2 z2 = a0;
#pragma unroll
                    for (int p = 0; p < 4; ++p) {
                        a0 = __builtin_elementwise_fma(__builtin_elementwise_max(__builtin_bit_cast(h16x2, __builtin_amdgcn_cvt_pkrtz(acc[2 * p], acc[2 * p + 1])), z2), wh[mt][0][p], a0);
                        a1 = __builtin_elementwise_fma(__builtin_elementwise_max(__builtin_bit_cast(h16x2, __builtin_amdgcn_cvt_pkrtz(acc[8 + 2 * p], acc[9 + 2 * p])), z2), wh[mt][1][p], a1); }
                    const int qa = 4 * mt + 2 * h;
                    SCH[qa * 4096 + key] = a0.x + a0.y; SCH[(qa + 1) * 4096 + key] = a1.x + a1.y;
                }
            }
        }
    }
    }
    __syncthreads();
    asm volatile("" : "+v"(lane));
    LAS unsigned* HIST = (LAS unsigned*)(lds + XTRA_OFF + wave * 2048);
#pragma unroll 1
    for (int qs3_ = 0; qs3_ < 2 * (ATT_PROBE == 2 ? 2 : 1); ++qs3_) {
    asm volatile("" : "+v"(lane));
    const int qi = 2 * wave + (qs3_ & 1);
    const LAS _Float16* SCw = (const LAS _Float16*)lds + qi * 4096;
    LAS unsigned short* SEL = (LAS unsigned short*)(lds + XTRA_OFF + 16384 + wave * 1024 + (qs3_ & 1) * 512);
    const int n = t0 + qi + 1;
    const unsigned long long ltmask = (1ull << lane) - 1ull;
    {
    if (n <= NSEL) {
        for (int i = lane; i < NSEL; i += 64) SEL[i] = (unsigned short)(i < n ? i : 0);
    } else {
        const int nj = (n + 63) >> 6;
        float sv[64]; float vmax = -INFINITY, vmin = INFINITY;
#pragma unroll
        for (int gq = 0; gq < 8; ++gq) {
            if (512 * (gq + 1) <= n) {
#pragma unroll
                for (int jj = 0; jj < 8; ++jj) { const int j = 8 * gq + jj; const float v = (float)SCw[64 * j + lane]; sv[j] = v; vmax = fmaxf(vmax, v); vmin = fminf(vmin, v); }
            } else if (512 * gq < n) {
#pragma unroll
                for (int jj = 0; jj < 8; ++jj) { const int j = 8 * gq + jj; const float v = (float)SCw[64 * j + lane]; const bool in = 64 * j + lane < n;
                    sv[j] = in ? v : -INFINITY; vmax = fmaxf(vmax, sv[j]); vmin = fminf(vmin, in ? v : INFINITY); }
            } else {
#pragma unroll
                for (int jj = 0; jj < 8; ++jj) sv[8 * gq + jj] = -INFINITY;
            }
        }
        vmax = wave_max(vmax, lane); vmin = wave_min(vmin, lane);
        const float range = vmax - vmin, scale = range > 0.f ? 511.5f / range : 0.f;
        LAS unsigned char* HISTB = (LAS unsigned char*)HIST;
#pragma unroll
        for (int i = 0; i < 8; ++i) HIST[lane * 8 + i] = 0u;
        WAVE_FENCE();
        int ba[64];
#pragma unroll
        for (int gq = 0; gq < 8; ++gq) {
            if (512 * (gq + 1) <= n) {
#pragma unroll
                for (int jj = 0; jj < 8; ++jj) { const int j = 8 * gq + jj; LAS unsigned* cp = (LAS unsigned*)(HISTB + 4 * score_bin(sv[j], vmin, scale)); ba[j] = (int)(unsigned long long)cp;
                    __hip_atomic_fetch_add(cp, 1u, __ATOMIC_RELAXED, __HIP_MEMORY_SCOPE_WORKGROUP); }
            } else if (512 * gq < n) {
#pragma unroll
                for (int jj = 0; jj < 8; ++jj) { const int j = 8 * gq + jj; const bool in = 64 * j + lane < n; LAS unsigned* cp = (LAS unsigned*)(HISTB + 4 * (in ? score_bin(sv[j], vmin, scale) : 0)); ba[j] = in ? (int)(unsigned long long)cp : -4;
                    if (in) __hip_atomic_fetch_add(cp, 1u, __ATOMIC_RELAXED, __HIP_MEMORY_SCOPE_WORKGROUP); }
            } else {
#pragma unroll
                for (int jj = 0; jj < 8; ++jj) ba[8 * gq + jj] = -4;
            }
        }
        WAVE_FENCE();
        unsigned wds[8]; unsigned sl = 0u;
#pragma unroll
        for (int i = 0; i < 8; ++i) { wds[i] = HIST[lane * 8 + i]; sl += wds[i]; }
        unsigned T = sl;
#pragma unroll
        for (int off = 1; off < 64; off <<= 1) { const unsigned o = (unsigned)__builtin_amdgcn_ds_bpermute((lane + off) << 2, (int)T); if (lane + off < 64) T += o; }
        const unsigned E = T - sl;
        int tb = 0; unsigned cab = 0u, ctb = 0u;
        { unsigned run = E; bool found = false;
#pragma unroll
          for (int bb = 7; bb >= 0; --bb) { const unsigned c = wds[bb];
              if (!found) { if (run + c >= (unsigned)NSEL) { found = true; tb = lane * 8 + bb; cab = run; ctb = c; } else run += c; } } }
        const unsigned long long bal = __ballot(E < (unsigned)NSEL && T >= (unsigned)NSEL);
        const int L = __ffsll((long long)bal) - 1;
        tb = __builtin_amdgcn_readlane(tb, L); cab = (unsigned)__builtin_amdgcn_readlane((int)cab, L); ctb = (unsigned)__builtin_amdgcn_readlane((int)ctb, L);
        const int need = NSEL - (int)cab;
        const int tb4 = (int)(unsigned long long)(HISTB + tb * 4);
        WAVE_FENCE();
        LAS float* CVAL = (LAS float*)HIST; LAS int* CKEY = (LAS int*)(HIST + 256);
        const bool docand = ctb <= 256u;
        unsigned nsr = 0u, ncr = 0u;
#pragma unroll
        for (int gq = 0; gq < 8; ++gq) {
            if (512 * gq < n) {
#pragma unroll
                for (int jj = 0; jj < 8; ++jj) { const int j = 8 * gq + jj; const int key = 64 * j + lane;
                    const bool isel = ba[j] > tb4; const unsigned long long ms = __ballot(isel);
                    if (isel) SEL[nsr + __builtin_amdgcn_mbcnt_hi((unsigned)(ms >> 32), __builtin_amdgcn_mbcnt_lo((unsigned)ms, 0u))] = (unsigned short)key;
                    nsr += (unsigned)__popcll(ms);
                    if (docand) { const bool ic = ba[j] == tb4; const unsigned long long mc = __ballot(ic);
                        if (mc != 0ull) { if (ic) CKEY[ncr + __builtin_amdgcn_mbcnt_hi((unsigned)(mc >> 32), __builtin_amdgcn_mbcnt_lo((unsigned)mc, 0u))] = key; ncr += (unsigned)__popcll(mc); } } }
            }
        }
        int nsel = (int)cab; const int ncand = (int)ctb;
        WAVE_FENCE();
        if (docand) for (int i = lane; i < ncand; i += 64) CVAL[i] = (float)SCw[CKEY[i]];
        (void)nj;
        WAVE_FENCE();
        if (ncand <= 256) {
            for (int c0 = 0; c0 < ncand; c0 += 64) {
                const int i = c0 + lane; const bool act = i < ncand; const float vi = act ? CVAL[i] : 0.f; const int ki = act ? CKEY[i] : 0;
                int rank = 0;
                for (int jj = 0; jj < ncand; jj += 4) {
                    const f32x4 v4 = *(const LAS f32x4*)(CVAL + jj); const u32x4 kq4 = *(const LAS u32x4*)(CKEY + jj); const int k4x = (int)kq4.x, k4y = (int)kq4.y, k4z = (int)kq4.z, k4w = (int)kq4.w;
                    rank += (int)((jj + 0 < ncand) & ((v4[0] > vi) | ((v4[0] == vi) & (k4x < ki))));
                    rank += (int)((jj + 1 < ncand) & ((v4[1] > vi) | ((v4[1] == vi) & (k4y < ki))));
                    rank += (int)((jj + 2 < ncand) & ((v4[2] > vi) | ((v4[2] == vi) & (k4z < ki))));
                    rank += (int)((jj + 3 < ncand) & ((v4[3] > vi) | ((v4[3] == vi) & (k4w < ki)))); }
                const bool take = act && rank < need; const unsigned long long ms = __ballot(take);
                if (take) SEL[nsel + __popcll(ms & ltmask)] = (unsigned short)ki;
                nsel += __popcll(ms);
            }
        } else {
            for (int j = 0; j < nj; ++j) {
                const int key = 64 * j + lane; const bool in = key < n; const float v = in ? (float)SCw[key] : 0.f; const bool ic = in && score_bin(v, vmin, scale) == tb;
                if (__ballot(ic) == 0ull) continue;
                int rank = 0;
                for (int jj = 0; jj < n; ++jj) { const float vj = (float)SCw[jj]; rank += (score_bin(vj, vmin, scale) == tb && (vj > v || (vj == v && jj < key))) ? 1 : 0; }
                const bool take = ic && rank < need; const unsigned long long ms = __ballot(take);
                if (take) SEL[nsel + __popcll(ms & ltmask)] = (unsigned short)key;
                nsel += __popcll(ms);
            }
        }
    }
    WAVE_FENCE();
    }
    }
    asm volatile("" : "+v"(lane));
#pragma unroll 1
    for (int qs4_ = 0; qs4_ < 2 * (ATT_PROBE == 3 ? 2 : 1); ++qs4_) {
    asm volatile("" : "+v"(lane));
    const int qi = 2 * wave + (qs4_ & 1);
    const LAS unsigned short* SEL = (const LAS unsigned short*)(lds + XTRA_OFF + 16384 + wave * 1024 + (qs4_ & 1) * 512);
    const int n = t0 + qi + 1, cnt = n < NSEL ? n : NSEL;
    const int m = m0 + qi;
    LAS unsigned char* RING = lds + wave * 16384;
    const char* kvb = (const char*)KV + (size_t)b * SEQ * 256;
    const int li = lane & 15, kq = lane >> 4;
    long qb[2][2];
    { u32x4 qw[2][2]; const int lq = li < 4 ? li : 0;
#pragma unroll
      for (int c = 0; c < 2; ++c)
#pragma unroll
          for (int ks = 0; ks < 2; ++ks) qw[c][ks] = *(const u32x4*)(Q + (size_t)m * 512 + (4 * c + lq) * 64 + 32 * ks + 8 * kq);
#pragma unroll
      for (int c = 0; c < 2; ++c)
#pragma unroll
          for (int ks = 0; ks < 2; ++ks) { const u32x4 w = qw[c][ks];
              const unsigned lo = pack4_fp8(bflo(w.x), bfhi(w.x), bflo(w.y), bfhi(w.y)), hi = pack4_fp8(bflo(w.z), bfhi(w.z), bflo(w.w), bfhi(w.w));
              qb[c][ks] = li < 4 ? (long)(((unsigned long long)hi << 32) | lo) : 0l; } }
    int koff[2][2];
#pragma unroll
    for (int c = 0; c < 2; ++c)
#pragma unroll
        for (int ks = 0; ks < 2; ++ks) koff[c][ks] = li * 128 + (((4 * c + 2 * ks + (kq >> 1)) ^ ((li >> 1) & 7)) << 4) + 8 * (kq & 1);
    const int tq = li >> 1, tp = li & 1, rowv = 16 * (tq >> 2) + 4 * kq + (tq & 3);
    int voff[2][4];
#pragma unroll
    for (int c = 0; c < 2; ++c)
#pragma unroll
        for (int dt = 0; dt < 4; ++dt) voff[c][dt] = rowv * 128 + (((4 * c + dt) ^ ((rowv >> 1) & 7)) << 4) + 8 * tp;
    const int r8 = lane >> 3, c16 = lane & 7;
    unsigned dsw[4];
#pragma unroll
    for (int j = 0; j < 4; ++j) dsw[j] = (unsigned)((c16 ^ ((4 * j + (r8 >> 1)) & 7)) << 4);
#define ATT_KEYS(s_) (*(const LAS u32x2*)(SEL + 32 * ((s_) & 7) + 4 * r8))
#define ATT_ISSUE(s_, kk_) do { const unsigned part_ = (((s_) & 15) >> 3) * 128u; \
        _Pragma("unroll") for (int j_ = 0; j_ < 4; ++j_) { const unsigned key_ = (((j_ & 2) ? (kk_).y : (kk_).x) >> ((j_ & 1) * 16)) & 0xffffu; \
            __builtin_amdgcn_global_load_lds((const unsigned*)(kvb + (size_t)key_ * 256 + part_ + dsw[j_]), (LAS unsigned*)(RING + ((s_) & 3) * 4096 + j_ * 1024), 16, 0, 0); } } while (0)
    { const u32x2 k0 = ATT_KEYS(0), k1 = ATT_KEYS(1), k2 = ATT_KEYS(2); ATT_ISSUE(0, k0); ATT_ISSUE(1, k1); ATT_ISSUE(2, k2); }
    u32x2 kk = ATT_KEYS(3);
    f32x4 lgs[8][2][2];
#pragma unroll
    for (int s = 0; s < 8; ++s) {
        ATT_ISSUE(s + 3, kk);
        kk = ATT_KEYS(s + 4);
        asm volatile("s_waitcnt vmcnt(12)" ::: "memory");
        const LAS unsigned char* slot = RING + (s & 3) * 4096;
#pragma unroll
        for (int T = 0; T < 2; ++T)
#pragma unroll
            for (int c = 0; c < 2; ++c) {
                f32x4 acc = (f32x4){0.f, 0.f, 0.f, 0.f};
#pragma unroll
                for (int ks = 0; ks < 2; ++ks) acc = __builtin_amdgcn_mfma_f32_16x16x32_fp8_fp8(*(const LAS long*)(slot + T * 2048 + koff[c][ks]), qb[c][ks], acc, 0, 0, 0);
                lgs[s][T][c] = acc;
            }
        asm volatile("s_waitcnt lgkmcnt(0)" ::: "memory");
    }
    if (cnt < NSEL) {
#pragma unroll
        for (int s = 0; s < 8; ++s)
#pragma unroll
            for (int T = 0; T < 2; ++T)
#pragma unroll
                for (int c = 0; c < 2; ++c)
#pragma unroll
                    for (int i = 0; i < 4; ++i) lgs[s][T][c][i] = (32 * s + 16 * (kq & 1) + 4 * i + 2 * T + (kq >> 1) < cnt) ? lgs[s][T][c][i] : -INFINITY;
    }
    float inv[2];
#pragma unroll
    for (int c = 0; c < 2; ++c) {
        float mx = -INFINITY;
#pragma unroll
        for (int s = 0; s < 8; ++s)
#pragma unroll
            for (int T = 0; T < 2; ++T) mx = fmaxf(fmaxf(mx, fmaxf(lgs[s][T][c][0], lgs[s][T][c][1])), fmaxf(lgs[s][T][c][2], lgs[s][T][c][3]));
        mx = fmaxf(mx, shx<16>(mx)); mx = max32(mx);
        const float mxs = mx * 0.18033688011112042f;
        float sm = 0.f;
#pragma unroll
        for (int s = 0; s < 8; ++s)
#pragma unroll
            for (int T = 0; T < 2; ++T)
#pragma unroll
                for (int i = 0; i < 4; ++i) { const float p = __builtin_amdgcn_exp2f(lgs[s][T][c][i] * 0.18033688011112042f - mxs); lgs[s][T][c][i] = p; sm += p; }
        sm += shx<16>(sm); sm = sum32(sm);
        inv[c] = 1.0f / sm;
    }
    f32x4 o[2][4];
#pragma unroll
    for (int c = 0; c < 2; ++c)
#pragma unroll
        for (int dt = 0; dt < 4; ++dt) o[c][dt] = (f32x4){0.f, 0.f, 0.f, 0.f};
#pragma unroll
    for (int s = 8; s < 16; ++s) {
        ATT_ISSUE(s + 3, kk);
        kk = ATT_KEYS(s + 4);
        asm volatile("s_waitcnt vmcnt(12)" ::: "memory");
        const LAS unsigned char* slot = RING + (s & 3) * 4096;
        long vfr[2][4];
        { const unsigned sa = (unsigned)(unsigned long long)slot;
#pragma unroll
          for (int c = 0; c < 2; ++c)
#pragma unroll
              for (int dt = 0; dt < 4; ++dt) asm volatile("ds_read_b64_tr_b8 %0, %1" : "=v"(vfr[c][dt]) : "v"(sa + (unsigned)voff[c][dt]) : "memory");
          asm volatile("s_waitcnt lgkmcnt(0)" : "+v"(vfr[0][0]), "+v"(vfr[0][1]), "+v"(vfr[0][2]), "+v"(vfr[0][3]), "+v"(vfr[1][0]), "+v"(vfr[1][1]), "+v"(vfr[1][2]), "+v"(vfr[1][3]) :: "memory"); }
#pragma unroll
        for (int c = 0; c < 2; ++c) {
            const f32x4 t0 = lgs[s - 8][0][c], t1 = lgs[s - 8][1][c];
            const long pf = (long)(((unsigned long long)pack4_fp8(t1[0], t1[1], t1[2], t1[3]) << 32) | pack4_fp8(t0[0], t0[1], t0[2], t0[3]));
#pragma unroll
            for (int dt = 0; dt < 4; ++dt) o[c][dt] = __builtin_amdgcn_mfma_f32_16x16x32_fp8_fp8(vfr[c][dt], pf, o[c][dt], 0, 0, 0);
        }
    }
#undef ATT_ISSUE
#undef ATT_KEYS
    if (li < 4) {
#pragma unroll
        for (int c = 0; c < 2; ++c)
#pragma unroll
            for (int dt = 0; dt < 4; ++dt) { const f32x4 v = o[c][dt] * inv[c]; u32x2 w; w.x = pk2(v[0], v[1]); w.y = pk2(v[2], v[3]);
                *(u32x2*)(YAYP + (size_t)m * 1024 + (4 * c + li) * 64 + 16 * dt + 4 * kq) = w; }
    }
    asm volatile("s_waitcnt vmcnt(0)" ::: "memory");
    }
}

template <int WIN> __device__ __forceinline__ void pool_item(const bf16* U, bf16* DP, const int mrow, const int ck) {
    const int t = mrow & (SEQ - 1), cw = WIN < t + 1 ? WIN : t + 1;
    u32x4 x[WIN];
#pragma unroll
    for (int i = 0; i < WIN; ++i) x[i] = *(const u32x4*)(U + (size_t)(mrow - (i < cw ? i : 0)) * 512 + 8 * ck);
    float s[8];
#pragma unroll
    for (int e = 0; e < 8; ++e) s[e] = 0.f;
#pragma unroll
    for (int i = 0; i < WIN; ++i) { const float w = i < cw ? 1.f : 0.f;
        s[0] += w * bflo(x[i].x); s[1] += w * bfhi(x[i].x); s[2] += w * bflo(x[i].y); s[3] += w * bfhi(x[i].y); s[4] += w * bflo(x[i].z); s[5] += w * bfhi(x[i].z); s[6] += w * bflo(x[i].w); s[7] += w * bfhi(x[i].w); }
    const float inv = 1.0f / (float)cw;
    u32x4 o; o.x = pk2(s[0] * inv - bflo(x[0].x), s[1] * inv - bfhi(x[0].x)); o.y = pk2(s[2] * inv - bflo(x[0].y), s[3] * inv - bfhi(x[0].y));
    o.z = pk2(s[4] * inv - bflo(x[0].z), s[5] * inv - bfhi(x[0].z)); o.w = pk2(s[6] * inv - bflo(x[0].w), s[7] * inv - bfhi(x[0].w));
    *(u32x4*)(DP + (size_t)mrow * 1024 + 8 * ck) = o;
}
template <int WIN> __device__ __forceinline__ void pool_item4(const bf16* U, bf16* DP, const int r0, const int ck) {
    const int t0 = r0 & (SEQ - 1);
    u32x4 xr[WIN + 3];
#pragma unroll
    for (int k = 0; k < WIN + 3; ++k) { const int tt = t0 + 3 - k; xr[k] = *(const u32x4*)(U + (size_t)(tt >= 0 ? r0 + 3 - k : r0) * 512 + 8 * ck); }
#pragma unroll
    for (int k = 4; k < WIN + 3; ++k) { if (t0 + 3 - k < 0) xr[k] = (u32x4){0u, 0u, 0u, 0u}; }
    float s[8];
#pragma unroll
    for (int e = 0; e < 8; ++e) s[e] = 0.f;
#define POOL_ADD(x_, sg_) do { s[0] += sg_ bflo((x_).x); s[1] += sg_ bfhi((x_).x); s[2] += sg_ bflo((x_).y); s[3] += sg_ bfhi((x_).y); s[4] += sg_ bflo((x_).z); s[5] += sg_ bfhi((x_).z); s[6] += sg_ bflo((x_).w); s[7] += sg_ bfhi((x_).w); } while (0)
#pragma unroll
    for (int i = 0; i < WIN; ++i) POOL_ADD(xr[3 + i], +);
#pragma unroll
    for (int q = 0; q < 4; ++q) {
        if (q > 0) { POOL_ADD(xr[3 - q], +); POOL_ADD(xr[3 - q + WIN], -); }
        const int tq = t0 + q, cw = WIN < tq + 1 ? WIN : tq + 1; const float inv = 1.0f / (float)cw; const u32x4 x0 = xr[3 - q];
        u32x4 o; o.x = pk2(s[0] * inv - bflo(x0.x), s[1] * inv - bfhi(x0.x)); o.y = pk2(s[2] * inv - bflo(x0.y), s[3] * inv - bfhi(x0.y));
        o.z = pk2(s[4] * inv - bflo(x0.z), s[5] * inv - bfhi(x0.z)); o.w = pk2(s[6] * inv - bflo(x0.w), s[7] * inv - bfhi(x0.w));
        *(u32x4*)(DP + (size_t)(r0 + q) * 1024 + 8 * ck) = o;
    }
#undef POOL_ADD
}
__device__ __forceinline__ void pool_window(const bf16* U, bf16* DP, int gtid, int nthreads) {
    for (int it = gtid; it < M * 16; it += nthreads) {
        const int w = __builtin_amdgcn_readfirstlane(it >> 6), g = w & 3, ln = it & 63, r0 = 16 * (w >> 2) + 4 * (ln >> 4), ck = 16 * g + (ln & 15);
        if (g == 0) pool_item4<2>(U, DP, r0, ck); else if (g == 1) pool_item4<4>(U, DP, r0, ck); else if (g == 2) pool_item4<8>(U, DP, r0, ck); else pool_item4<16>(U, DP, r0, ck);
    }
}

__device__ __forceinline__ void butterfly32(const float (&lg)[32], const int lane, float& out) {
    float r16[16], r8[8], r4[4], r2[2], r1;
    { const bool hi = (lane & 32) != 0;
#pragma unroll
      for (int q = 0; q < 16; ++q) r16[q] = lg[q] + partner32(lg[16 + q], hi); }
#pragma unroll
    for (int q = 0; q < 8; ++q) r8[q] = r16[q] + shx<16>(r16[8 + q]);
#pragma unroll
    for (int q = 0; q < 4; ++q) r4[q] = r8[q] + shx<8>(r8[4 + q]);
#pragma unroll
    for (int q = 0; q < 2; ++q) r2[q] = r4[q] + shx<4>(r4[2 + q]);
    r1 = r2[0] + shx<2>(r2[1]);
    out = r1 + shx<1>(r1);
}
__device__ __forceinline__ void ln1_router_phase(LAS unsigned char* lds, const int tid, const int wave, const int lane_in, const int blk,
                                                 const bf16* V, const float* g1, const float* b1, const float* Wr, const float* br,
                                                 bf16* X1F, unsigned char* X1Q, float* X1S, int* TOPI, int* POS, int* P2T, float* P2G, float* P2S, int* CNTG) {
    LAS float* WL = (LAS float*)lds;
    { f32x4 wr[16];
#pragma unroll
      for (int q = 0; q < 16; ++q) wr[q] = *(const f32x4*)(Wr + 4 * (tid + q * NWAVES * 64));
      asm volatile("" ::: "memory");
#pragma unroll
      for (int q = 0; q < 16; ++q) { const int i = tid + q * NWAVES * 64, k = i >> 3, e4 = (i & 7) * 4;
          const int xm = ((k & 255) >> 2) >> 1;
          WL[((e4 + 0) ^ xm) * 1024 + k] = wr[q].x; WL[((e4 + 1) ^ xm) * 1024 + k] = wr[q].y; WL[((e4 + 2) ^ xm) * 1024 + k] = wr[q].z; WL[((e4 + 3) ^ xm) * 1024 + k] = wr[q].w; } }
    LAS int* EL = (LAS int*)(lds + XTRA_OFF);
    LAS float* LG = (LAS float*)(lds + XTRA_OFF + 2048 + wave * 512);
    LAS float* TV = LG + 64; LAS int* TE = (LAS int*)(LG + 72);
    LAS float* GL = (LAS float*)(lds + XTRA_OFF + 6144); LAS float* SL = (LAS float*)(lds + XTRA_OFF + 7168); LAS int* BASEL = (LAS int*)(lds + XTRA_OFF + 7424);
    __syncthreads();
    const int lane = lane_in, row0 = blk * 64 + wave * 8;
    f32x4 va[4], vb[4];
#pragma unroll
    for (int j = 0; j < 4; ++j) { const u32x2 wa = *(const u32x2*)(V + (size_t)row0 * D + 4 * lane + 256 * j), wb = *(const u32x2*)(V + (size_t)(row0 + 1) * D + 4 * lane + 256 * j);
        va[j] = (f32x4){bflo(wa.x), bfhi(wa.x), bflo(wa.y), bfhi(wa.y)}; vb[j] = (f32x4){bflo(wb.x), bfhi(wb.x), bflo(wb.y), bfhi(wb.y)}; }
#pragma unroll 1
    for (int pr = 0; pr < 4; ++pr) {
        const int rowA = row0 + 2 * pr;
        { LnGB gb; ln_load(gb, g1, b1, lane); ln_regs(va, gb, lane); ln_regs(vb, gb, lane); }
        store_row_bf16(X1F + (size_t)rowA * D, va, lane); store_row_bf16(X1F + (size_t)(rowA + 1) * D, vb, lane);
        { const float sa = store_row_i8(X1Q + (size_t)rowA * D, X1S + rowA, va, lane), sb = store_row_i8(X1Q + (size_t)(rowA + 1) * D, X1S + rowA + 1, vb, lane);
          if (lane == 0) { SL[rowA - blk * 64] = sa; SL[rowA + 1 - blk * 64] = sb; } }
        f32x2 l2[32];
#pragma unroll
        for (int e = 0; e < 32; ++e) l2[e] = (f32x2){0.f, 0.f};
        { f32x4 wq[2][4];
#pragma unroll
          for (int q = 0; q < 4; ++q) wq[0][q] = *(const LAS f32x4*)(WL + q * 1024 + 4 * lane);
#pragma unroll
          for (int gI = 0; gI < 32; ++gI) {
              const int j = gI >> 3, e0 = 4 * (gI & 7), cb = gI & 1;
              if (gI + 1 < 32) { const int jn = (gI + 1) >> 3, en = 4 * ((gI + 1) & 7);
#pragma unroll
                  for (int q = 0; q < 4; ++q) wq[cb ^ 1][q] = *(const LAS f32x4*)(WL + (en + q) * 1024 + 4 * lane + 256 * jn); }
              __builtin_amdgcn_sched_barrier(0);
              const f32x2 p0 = (f32x2){va[j].x, vb[j].x}, p1 = (f32x2){va[j].y, vb[j].y}, p2 = (f32x2){va[j].z, vb[j].z}, p3 = (f32x2){va[j].w, vb[j].w};
#pragma unroll
              for (int q = 0; q < 4; ++q) l2[e0 + q] = __builtin_elementwise_fma(p0, (f32x2){wq[cb][q].x, wq[cb][q].x}, l2[e0 + q]);
#pragma unroll
              for (int q = 0; q < 4; ++q) l2[e0 + q] = __builtin_elementwise_fma(p1, (f32x2){wq[cb][q].y, wq[cb][q].y}, l2[e0 + q]);
#pragma unroll
              for (int q = 0; q < 4; ++q) l2[e0 + q] = __builtin_elementwise_fma(p2, (f32x2){wq[cb][q].z, wq[cb][q].z}, l2[e0 + q]);
#pragma unroll
              for (int q = 0; q < 4; ++q) l2[e0 + q] = __builtin_elementwise_fma(p3, (f32x2){wq[cb][q].w, wq[cb][q].w}, l2[e0 + q]);
              __builtin_amdgcn_sched_barrier(0);
          } }
        float la[32], lb[32];
#pragma unroll
        for (int e = 0; e < 32; ++e) { la[e] = l2[e].x; lb[e] = l2[e].y; }
        { const int rowN = row0 + 2 * (pr < 3 ? pr + 1 : pr);
#pragma unroll
          for (int j = 0; j < 4; ++j) { const u32x2 wa = *(const u32x2*)(V + (size_t)rowN * D + 4 * lane + 256 * j), wb = *(const u32x2*)(V + (size_t)(rowN + 1) * D + 4 * lane + 256 * j);
              va[j] = (f32x4){bflo(wa.x), bfhi(wa.x), bflo(wa.y), bfhi(wa.y)}; vb[j] = (f32x4){bflo(wb.x), bfhi(wb.x), bflo(wb.y), bfhi(wb.y)}; }
          asm volatile("" ::: "memory"); }
        float vala, valb; butterfly32(la, lane, vala); butterfly32(lb, lane, valb);
        int em = lane >> 1; asm volatile("" : "+v"(em));
        const int myrow = lane & 1; const float bias = br[em];
        vala += bias; valb += bias;
        if (myrow == 0) LG[em] = vala; else LG[32 + em] = valb;
        WAVE_FENCE();
        const float mine = myrow ? valb : vala; int rank = 0;
#pragma unroll
        for (int q = 0; q < 8; ++q) { const f32x4 o4 = *(const LAS f32x4*)(LG + 32 * myrow + 4 * q);
#pragma unroll
            for (int u = 0; u < 4; ++u) rank += (int)((o4[u] > mine) | ((o4[u] == mine) & (4 * q + u < em))); }
        if (rank < 4) { TV[4 * myrow + rank] = mine; TE[4 * myrow + rank] = em; }
        WAVE_FENCE();
        if (lane < 2) {
            const f32x4 tv = *(const LAS f32x4*)(TV + 4 * lane); const int t0 = TE[4 * lane], t1 = TE[4 * lane + 1], t2 = TE[4 * lane + 2], t3 = TE[4 * lane + 3];
            const float e1 = __expf(tv[1] - tv[0]), e2 = __expf(tv[2] - tv[0]), e3 = __expf(tv[3] - tv[0]); const float inv = 1.0f / (1.0f + e1 + e2 + e3);
            const int row = rowA + lane, gi = row * 4, rl = row - blk * 64;
            *(int4*)(TOPI + gi) = make_int4(t0, t1, t2, t3);
            *(LAS f32x4*)(GL + rl * 4) = (f32x4){inv, e1 * inv, e2 * inv, e3 * inv};
            EL[rl * 4] = t0; EL[rl * 4 + 1] = t1; EL[rl * 4 + 2] = t2; EL[rl * 4 + 3] = t3;
        }
        WAVE_FENCE();
    }
    __syncthreads();
    LAS int* CNT = (LAS int*)(lds + XTRA_OFF + 1024);
    int e = 0, rk = 0;
    if (wave < 4) {
        e = EL[tid];
#pragma unroll 4
        for (int q = 0; q < 32; ++q) { const unsigned long long mq = __ballot(e == q); if (e == q) rk = __popcll(mq & ((1ull << lane_in) - 1ull)); if (lane_in == q) CNT[wave * 32 + q] = __popcll(mq); }
    }
    __syncthreads();
    if (tid < 32) BASEL[tid] = __hip_atomic_fetch_add(CNTG + tid, CNT[tid] + CNT[32 + tid] + CNT[64 + tid] + CNT[96 + tid], __ATOMIC_RELAXED, __HIP_MEMORY_SCOPE_AGENT);
    __syncthreads();
    if (wave < 4) {
        for (int w2 = 0; w2 < wave; ++w2) rk += CNT[w2 * 32 + e];
        const int pos = BASEL[e] + rk, gi = blk * 256 + tid; const size_t ix = (size_t)e * CAPE + pos;
        POS[gi] = pos; P2T[ix] = gi >> 2; P2G[ix] = GL[tid]; P2S[ix] = SL[tid >> 2];
    }
    __syncthreads();
}

__device__ __forceinline__ void ln1_router_mfma(LAS unsigned char* lds, const int tid, const int wave, const int lane_in, const int blk,
                                                const bf16* V, const float* g1, const float* b1, const bf16* WT, const float* br,
                                                bf16* X1F, unsigned char* X1Q, float* X1S, int* TOPI, int* POS, int* P2T, float* P2G, float* P2S, int* CNTG) {
    LAS unsigned char* XH = lds; LAS unsigned char* XL = lds + 65536;
    LAS float* PART = (LAS float*)lds;
    LAS int* EL = (LAS int*)(lds + XTRA_OFF);
    LAS float* LG = (LAS float*)(lds + XTRA_OFF + 2048 + wave * 512);
    LAS float* TV = LG + 64; LAS int* TE = (LAS int*)(LG + 72);
    LAS float* GL = (LAS float*)(lds + XTRA_OFF + 6144); LAS float* SL = (LAS float*)(lds + XTRA_OFF + 7168); LAS int* BASEL = (LAS int*)(lds + XTRA_OFF + 7424);
    const int lane = lane_in, mrow = lane & 31, kh = lane >> 5;
    bf16x8 Bh[8], Bl[8];
#pragma unroll
    for (int s = 0; s < 8; ++s) { Bh[s] = *(const bf16x8*)(WT + (size_t)mrow * 1024 + 128 * wave + 16 * s + 8 * kh); Bl[s] = *(const bf16x8*)(WT + 32768 + (size_t)mrow * 1024 + 128 * wave + 16 * s + 8 * kh); }
    LnGB gb; ln_load(gb, g1, b1, lane);
    u32x2 vr[4][4];
#pragma unroll
    for (int rr = 0; rr < 4; ++rr)
#pragma unroll
        for (int j = 0; j < 4; ++j) vr[rr][j] = *(const u32x2*)(V + (size_t)(blk * 64 + 4 * wave + rr) * D + 4 * lane + 256 * j);
#pragma unroll 1
    for (int hb = 0; hb < 2; ++hb) {
        const int rbase = blk * 64 + 32 * hb;
#pragma unroll
        for (int tr = 0; tr < 2; ++tr) {
            const int rloc = 4 * wave + 2 * tr, rowA = rbase + rloc;
            f32x4 va[4], vb[4];
#pragma unroll
            for (int j = 0; j < 4; ++j) { const u32x2 wa = vr[2 * tr][j], wb = vr[2 * tr + 1][j];
                va[j] = (f32x4){bflo(wa.x), bfhi(wa.x), bflo(wa.y), bfhi(wa.y)}; vb[j] = (f32x4){bflo(wb.x), bfhi(wb.x), bflo(wb.y), bfhi(wb.y)}; }
            if (tr == 1) {
#pragma unroll
                for (int rr = 0; rr < 4; ++rr)
#pragma unroll
                    for (int j = 0; j < 4; ++j) vr[rr][j] = *(const u32x2*)(V + (size_t)(blk * 64 + 32 * (hb ^ 1) + 4 * wave + rr) * D + 4 * lane + 256 * j);
                asm volatile("" ::: "memory"); }
            ln_regs(va, gb, lane); ln_regs(vb, gb, lane);
            store_row_bf16(X1F + (size_t)rowA * D, va, lane); store_row_bf16(X1F + (size_t)(rowA + 1) * D, vb, lane);
            { const float sa = store_row_i8(X1Q + (size_t)rowA * D, X1S + rowA, va, lane), sb = store_row_i8(X1Q + (size_t)(rowA + 1) * D, X1S + rowA + 1, vb, lane);
              if (lane == 0) { SL[rowA - blk * 64] = sa; SL[rowA + 1 - blk * 64] = sb; } }
#pragma unroll
            for (int j = 0; j < 4; ++j) {
                const int c = (lane >> 1) + 32 * j;
                { const unsigned h0 = pk2(va[j].x, va[j].y), h1 = pk2(va[j].z, va[j].w);
                  const unsigned l0 = pk2(va[j].x - bflo(h0), va[j].y - bfhi(h0)), l1 = pk2(va[j].z - bflo(h1), va[j].w - bfhi(h1));
                  const int off = rloc * 2048 + 16 * (c ^ (rloc & 15)) + 8 * (lane & 1);
                  *(LAS u32x2*)(XH + off) = (u32x2){h0, h1}; *(LAS u32x2*)(XL + off) = (u32x2){l0, l1}; }
                { const unsigned h0 = pk2(vb[j].x, vb[j].y), h1 = pk2(vb[j].z, vb[j].w);
                  const unsigned l0 = pk2(vb[j].x - bflo(h0), vb[j].y - bfhi(h0)), l1 = pk2(vb[j].z - bflo(h1), vb[j].w - bfhi(h1));
                  const int off = (rloc + 1) * 2048 + 16 * (c ^ ((rloc + 1) & 15)) + 8 * (lane & 1);
                  *(LAS u32x2*)(XH + off) = (u32x2){h0, h1}; *(LAS u32x2*)(XL + off) = (u32x2){l0, l1}; }
            }
        }
        __syncthreads();
        f32x16 acc;
#pragma unroll
        for (int i = 0; i < 16; ++i) acc[i] = 0.f;
#pragma unroll
        for (int s = 0; s < 8; ++s) { const int off = mrow * 2048 + 16 * ((16 * wave + 2 * s + kh) ^ (mrow & 15));
            const bf16x8 ah = *(const LAS bf16x8*)(XH + off), al = *(const LAS bf16x8*)(XL + off);
            acc = __builtin_amdgcn_mfma_f32_32x32x16_bf16(ah, Bh[s], acc, 0, 0, 0);
            acc = __builtin_amdgcn_mfma_f32_32x32x16_bf16(al, Bh[s], acc, 0, 0, 0);
            acc = __builtin_amdgcn_mfma_f32_32x32x16_bf16(ah, Bl[s], acc, 0, 0, 0); }
        __syncthreads();
#pragma unroll
        for (int i = 0; i < 16; ++i) PART[(wave * 32 + 8 * (i >> 2) + 4 * kh + (i & 3)) * 32 + mrow] = acc[i];
        __syncthreads();
#pragma unroll 1
        for (int tr = 0; tr < 2; ++tr) {
            const int rloc = 4 * wave + 2 * tr, rowA = rbase + rloc;
            int em = lane >> 1; asm volatile("" : "+v"(em));
            const int myrow = lane & 1;
            float mine = br[em];
#pragma unroll
            for (int pw = 0; pw < 8; ++pw) mine += PART[(pw * 32 + rloc + myrow) * 32 + em];
            LG[32 * myrow + em] = mine;
            WAVE_FENCE();
            int rank = 0;
#pragma unroll
            for (int q = 0; q < 8; ++q) { const f32x4 o4 = *(const LAS f32x4*)(LG + 32 * myrow + 4 * q);
#pragma unroll
                for (int u = 0; u < 4; ++u) rank += (int)((o4[u] > mine) | ((o4[u] == mine) & (4 * q + u < em))); }
            if (rank < 4) { TV[4 * myrow + rank] = mine; TE[4 * myrow + rank] = em; }
            WAVE_FENCE();
            if (lane < 2) {
                const f32x4 tv = *(const LAS f32x4*)(TV + 4 * lane); const int t0 = TE[4 * lane], t1 = TE[4 * lane + 1], t2 = TE[4 * lane + 2], t3 = TE[4 * lane + 3];
                const float e1 = __expf(tv[1] - tv[0]), e2 = __expf(tv[2] - tv[0]), e3 = __expf(tv[3] - tv[0]); const float inv = 1.0f / (1.0f + e1 + e2 + e3);
                const int row = rowA + lane, gi = row * 4, rl = row - blk * 64;
                *(int4*)(TOPI + gi) = make_int4(t0, t1, t2, t3);
                *(LAS f32x4*)(GL + rl * 4) = (f32x4){inv, e1 * inv, e2 * inv, e3 * inv};
                EL[rl * 4] = t0; EL[rl * 4 + 1] = t1; EL[rl * 4 + 2] = t2; EL[rl * 4 + 3] = t3;
            }
            WAVE_FENCE();
        }
        __syncthreads();
    }
    LAS int* CNT = (LAS int*)(lds + XTRA_OFF + 1024);
    int e = 0, rk = 0;
    if (wave < 4) {
        e = EL[tid];
#pragma unroll 4
        for (int q = 0; q < 32; ++q) { const unsigned long long mq = __ballot(e == q); if (e == q) rk = __popcll(mq & ((1ull << lane_in) - 1ull)); if (lane_in == q) CNT[wave * 32 + q] = __popcll(mq); }
    }
    __syncthreads();
    if (tid < 32) BASEL[tid] = __hip_atomic_fetch_add(CNTG + tid, CNT[tid] + CNT[32 + tid] + CNT[64 + tid] + CNT[96 + tid], __ATOMIC_RELAXED, __HIP_MEMORY_SCOPE_AGENT);
    __syncthreads();
    if (wave < 4) {
        for (int w2 = 0; w2 < wave; ++w2) rk += CNT[w2 * 32 + e];
        const int pos = BASEL[e] + rk, gi = blk * 256 + tid; const size_t ix = (size_t)e * CAPE + pos;
        POS[gi] = pos; P2T[ix] = gi >> 2; P2G[ix] = GL[tid]; P2S[ix] = SL[tid >> 2];
    }
    __syncthreads();
}

__device__ __forceinline__ void build_tiles(LAS int* TL, LAS int* TS, LAS int* CN, const int* CNTG, const int tid) {
    if (tid < 64) {
        const int c = tid < 32 ? __hip_atomic_load(CNTG + (tid & 31), __ATOMIC_RELAXED, __HIP_MEMORY_SCOPE_AGENT) : 0; const int nt = (c + 255) >> 8;
        int incl = nt;
#pragma unroll
        for (int off = 1; off < 32; off <<= 1) { const int o = __shfl_up(incl, off); if (tid >= off) incl += o; }
        const int ts = incl - nt;
        if (tid < 32) { CN[tid] = c; TS[tid] = ts;
#pragma unroll 1
            for (int k = 0; k < nt; ++k) TL[1 + ts + k] = tid;
            if (tid == 31) TL[0] = incl; }
    }
    __syncthreads();
}

__device__ __forceinline__ void add_bf16_row(f32x4 (&v)[4], const bf16* row, int lane) {
#pragma unroll
    for (int j = 0; j < 4; ++j) { const u32x2 w = *(const u32x2*)(row + 4 * lane + 256 * j); v[j].x += bflo(w.x); v[j].y += bfhi(w.x); v[j].z += bflo(w.y); v[j].w += bfhi(w.y); }
}
__device__ __forceinline__ void combine_ln2_phase(const int gw, const int ngw, const int lane, const bf16* X1F, const bf16* PLEV, const bf16* YR, const int* TOPI, const int* POS, const LAS int* TS,
                                                  const float* g2, const float* b2, bf16* XF, unsigned char* XQ, float* XQS, float* OUT) {
#pragma unroll 1
    for (int row = gw; row < M; row += 2 * ngw) {
        const int rowb = row + ngw;
        int4 ra, rb;
        { const int4 ea = *(const int4*)(TOPI + row * 4), eb = *(const int4*)(TOPI + rowb * 4), pa = *(const int4*)(POS + row * 4), pb = *(const int4*)(POS + rowb * 4);
          ra = make_int4(TS[ea.x] * 256 + pa.x, TS[ea.y] * 256 + pa.y, TS[ea.z] * 256 + pa.z, TS[ea.w] * 256 + pa.w);
          rb = make_int4(TS[eb.x] * 256 + pb.x, TS[eb.y] * 256 + pb.y, TS[eb.z] * 256 + pb.z, TS[eb.w] * 256 + pb.w); }
        const bf16* src[2][6] = {{X1F + (size_t)row * D, PLEV + (size_t)row * D, YR + (size_t)ra.x * D, YR + (size_t)ra.y * D, YR + (size_t)ra.z * D, YR + (size_t)ra.w * D},
                                 {X1F + (size_t)rowb * D, PLEV + (size_t)rowb * D, YR + (size_t)rb.x * D, YR + (size_t)rb.y * D, YR + (size_t)rb.z * D, YR + (size_t)rb.w * D}};
        u32x2 tq[2][6][4];
#pragma unroll
        for (int r = 0; r < 2; ++r)
#pragma unroll
            for (int k = 0; k < 6; ++k)
#pragma unroll
                for (int j = 0; j < 4; ++j) tq[r][k][j] = *(const u32x2*)(src[r][k] + 4 * lane + 256 * j);
        asm volatile("" ::: "memory");
        __builtin_amdgcn_sched_barrier(0);
        f32x4 va[4], vb[4];
#pragma unroll
        for (int j = 0; j < 4; ++j) {
            va[j] = (f32x4){bflo(tq[0][0][j].x), bfhi(tq[0][0][j].x), bflo(tq[0][0][j].y), bfhi(tq[0][0][j].y)} * DN_ALPHA;
            vb[j] = (f32x4){bflo(tq[1][0][j].x), bfhi(tq[1][0][j].x), bflo(tq[1][0][j].y), bfhi(tq[1][0][j].y)} * DN_ALPHA;
#pragma unroll
            for (int k = 1; k < 6; ++k) {
                va[j] += (f32x4){bflo(tq[0][k][j].x), bfhi(tq[0][k][j].x), bflo(tq[0][k][j].y), bfhi(tq[0][k][j].y)};
                vb[j] += (f32x4){bflo(tq[1][k][j].x), bfhi(tq[1][k][j].x), bflo(tq[1][k][j].y), bfhi(tq[1][k][j].y)}; }
        }
        { LnGB gb; ln_load(gb, g2, b2, lane); ln_regs(va, gb, lane); ln_regs(vb, gb, lane); }
        if (OUT) { store_row_f32(OUT + (size_t)row * D, va, lane); store_row_f32(OUT + (size_t)rowb * D, vb, lane); }
        else { store_row_bf16(XF + (size_t)row * D, va, lane); store_row_i8(XQ + (size_t)row * D, XQS + row, va, lane); store_row_bf16(XF + (size_t)rowb * D, vb, lane); store_row_i8(XQ + (size_t)rowb * D, XQS + rowb, vb, lane); }
    }
}

#ifndef MK_N_LAUNCHES
#define MK_N_LAUNCHES 1
#endif
constexpr int PH_PER_LAYER = 10, N_PHASES = 1 + DEPTH * PH_PER_LAYER;
constexpr double ROPE_TURNS[8] = {0.15915494309189535, 0.03086376340470123, 0.005985185712713705, 0.001160663641240061, 0.00022507907903927653, 4.364795279280289e-05, 8.464330808241401e-06, 1.6414262627950345e-06};

#define ARGP(i) ((const float*)(const GAS float*)kargs_[i])
constexpr int B_WIN = 8 * 16, B_UP = 4 * 4, B_OUT = 8 * 4, B_PLEP = 2 * 4, B_GU1 = 8 * 8, B_DN1 = 8 * 4;
constexpr int B_LAYER = B_WIN + B_UP + 2 * B_OUT + B_PLEP + NE * B_GU1 + NE * B_DN1;
struct P0D { const float* src; int nsrc; unsigned char* dst; int ldtb; int i8; float ws; int valid; };
__device__ __forceinline__ void p0_decode(P0D& d, const int it_in, const int wave, unsigned char* ws, const __attribute__((address_space(4))) unsigned long long* kargs_, const int lane) {
    int it = __builtin_amdgcn_readfirstlane(it_in); asm volatile("" : "+s"(it));
    const int ll = it / B_LAYER; int r = it - ll * B_LAYER; unsigned char* lw2 = ws + WS_W + (size_t)ll * LW_SIZE;
    const float* W; int nsrc, nblk, ldt, kind = 0; unsigned char* wt; d.i8 = 0; d.ws = 1.0f;
    if (r < B_WIN) { W = ARGP(4) + (size_t)ll * D * D_IN; nsrc = D_IN; wt = lw2 + LW_WIN; ldt = D; nblk = 16; kind = 1; d.i8 = 1; d.ws = I8_WS_GU; }
    else if ((r -= B_WIN) < B_UP) { W = ARGP(7) + (size_t)ll * 512 * D; nsrc = D; wt = lw2 + LW_WUPA; ldt = 1024; nblk = 4; }
    else if ((r -= B_UP) < B_OUT) { W = ARGP(9) + (size_t)ll * D * D; nsrc = D; wt = lw2 + LW_WOUT; ldt = D; nblk = 4; }
    else if ((r -= B_OUT) < B_OUT) { W = ARGP(18) + (size_t)ll * D * D; nsrc = D; wt = lw2 + LW_PLEG; ldt = D; nblk = 4; d.i8 = 1; d.ws = I8_WS_GU; }
    else if ((r -= B_OUT) < B_PLEP) { W = ARGP(19) + (size_t)ll * PLE * D; nsrc = D; wt = lw2 + LW_PLEP; ldt = PLE; nblk = 4; }
    else if ((r -= B_PLEP) < NE * B_GU1) { const int e = r / B_GU1; r -= e * B_GU1; W = ARGP(14) + ((size_t)ll * NE + e) * D * 2048; nsrc = 2048; wt = lw2 + LW_WGU + (size_t)e * 2048 * D; ldt = D; nblk = 8; kind = 2; d.i8 = 1; d.ws = I8_WS_GU; }
    else { r -= NE * B_GU1; const int e = r / B_DN1; r -= e * B_DN1; W = ARGP(16) + ((size_t)ll * NE + e) * DFF * D; nsrc = D; wt = lw2 + LW_WDN + (size_t)e * D * DFF; ldt = DFF; nblk = 4; d.i8 = 1; d.ws = I8_WS_DN; }
    const int kb = r / nblk, nb = r - kb * nblk, k0 = 128 * kb + 16 * wave, np = 256 * nb + 4 * lane;
    const int sc = kind == 1 ? MapWin()(np) : (kind == 2 ? MapGU()(np) : np);
    d.valid = sc >= 0; d.nsrc = nsrc; d.src = W + (size_t)k0 * nsrc + (sc < 0 ? 0 : sc);
    const int esz = d.i8 ? 1 : 2; d.ldtb = ldt * esz; d.dst = wt + (size_t)(256 * nb) * d.ldtb + (size_t)(128 * kb) * esz;
}
struct Args { const float* in[22]; float* out; unsigned char* ws; int ph_lo, ph_hi; };

template <unsigned PMASK>
__global__ void __launch_bounds__(NWAVES * 64, 2) mega_fwd(Args args) {
    extern __shared__ __attribute__((aligned(16))) unsigned char lds_raw[];
    LAS unsigned char* lds = (LAS unsigned char*)lds_raw;
    volatile LAS unsigned* MISC = (volatile LAS unsigned*)(lds + MISC_OFF);
    const int G = gridDim.x, blk = blockIdx.x;
    const int wave_s_ = __builtin_amdgcn_readfirstlane(threadIdx.x >> 6);
    for (int u = threadIdx.x; u < (LDS_BYTES - MISC_OFF) / 4; u += NWAVES * 64) ((LAS unsigned*)(lds + MISC_OFF))[u] = 0u;
    __syncthreads();
    XcdBarrier bar; bar.bar = (unsigned*)(args.ws + WS_CTL) + CW_BAR; bar.x = 0; bar.st = nullptr;
#if MK_N_LAUNCHES == 1
    bar = xcd_barrier_post((unsigned*)(args.ws + WS_CTL) + CW_BAR, MISC + 8);
#define GRID_BAR() xcd_barrier(bar)
#else
#define GRID_BAR() do { } while (0)
#endif
    const int lo = args.ph_lo, hi = args.ph_hi;
#ifndef PROBE_MASK
#define PROBE_MASK 0u
#endif
#define PH_KIND(k) ((k) == 0 ? 0 : 1 + ((k) - 1) % PH_PER_LAYER)
#define REPS(kk) for (int rep_ = 0; rep_ < (((PROBE_MASK >> (kk)) & 1u) ? 2 : 1); ++rep_)
#define HASK(kk) (((PMASK >> (kk)) & 1u) != 0u)

#define PHASE_VARS \
    const __attribute__((address_space(4))) unsigned long long* kargs_ = (const __attribute__((address_space(4))) unsigned long long*)__builtin_amdgcn_kernarg_segment_ptr(); \
    __builtin_amdgcn_s_waitcnt(0);       \
    asm volatile("" : "+s"(kargs_));     \
    unsigned char* ws = (unsigned char*)(GAS unsigned char*)kargs_[23]; \
    int lane_o_ = (int)__builtin_amdgcn_mbcnt_hi(~0u, __builtin_amdgcn_mbcnt_lo(~0u, 0u)); asm volatile("" : "+v"(lane_o_));     \
    const int lane = lane_o_, wave = wave_s_, tid = wave_s_ * 64 + lane_o_; \
    const int gw = blk * NWAVES + wave, NGW = G * NWAVES, gtid = blk * (NWAVES * 64) + tid, NT = G * NWAVES * 64; \
    (void)lane; (void)wave; (void)gw; (void)NGW; (void)gtid; (void)NT; \
    bf16* XF = (bf16*)(ws + WS_XF); bf16* XB = (bf16*)(ws + WS_XB);     \
    float* ROPE = (float*)(ws + WS_ROPE); bf16* PB16 = (bf16*)(ws + WS_PB16); \
    bf16* Qb = (bf16*)(ws + WS_Q); bf16* KVb = (bf16*)(ws + WS_KV); bf16* QIb = (bf16*)(ws + WS_QI); bf16* KIb = (bf16*)(ws + WS_KI); float* WIb = (float*)(ws + WS_WI); \
    bf16* Ub = (bf16*)(ws + WS_U); bf16* SGA = (bf16*)(ws + WS_SGA); bf16* SGB = (bf16*)(ws + WS_SGB); bf16* YAYP = (bf16*)(ws + WS_YAYP); bf16* DP = (bf16*)(ws + WS_DP); \
    bf16* T1 = (bf16*)(ws + WS_T1); bf16* MRG = (bf16*)(ws + WS_MRG); bf16* X1F = (bf16*)(ws + WS_X1F); bf16* X1B = (bf16*)(ws + WS_X1B); \
    bf16* XS = (bf16*)(ws + WS_XS); bf16* ACT = (bf16*)(ws + WS_ACT); bf16* YR = (bf16*)(ws + WS_YR); bf16* PLEPb = (bf16*)(ws + WS_PLEP); bf16* PLEV = (bf16*)(ws + WS_PLEV); \
    int* TOPI = (int*)(ws + WS_ROUTE + RT_TOPI); float* GATE = (float*)(ws + WS_ROUTE + RT_GATE); int* LRANK = (int*)(ws + WS_ROUTE + RT_LRANK); \
    int* TOKROW = (int*)(ws + WS_ROUTE + RT_TOKROW); float* ROWG = (float*)(ws + WS_ROUTE + RT_ROWG); float* ROWS = (float*)(ws + WS_ROUTE + RT_ROWS); (void)ROWS; float* X1S = (float*)(ws + WS_ROUTE + RT_X1S); (void)X1S; unsigned char* X1Q = (unsigned char*)(ws + WS_X1B); (void)X1Q; unsigned char* XQ = (unsigned char*)(ws + WS_XB); (void)XQ; float* XQS = (float*)(ws + WS_ROUTE + RT_XQS); (void)XQS; \
    unsigned char* lw = ws + WS_W + (size_t)l * LW_SIZE; \
    int* P2T = (int*)(ws + WS_XS); float* P2G = (float*)(ws + WS_XS + 2 * MiB); float* P2S = (float*)(ws + WS_XS + 4 * MiB); int* CNTG = (int*)(ws + WS_CTL) + CW_CNT + l * 32; (void)P2T; (void)P2G; (void)P2S; (void)CNTG;     \
    int* HISTL = (int*)(ws + WS_ROUTE + RT_HIST) + l * 256 * 32; int* TILE = (int*)(ws + WS_ROUTE + RT_TILE) + l * 512; \
    (void)XF; (void)XB; (void)ROPE; (void)PB16; (void)Qb; (void)KVb; (void)QIb; (void)KIb; (void)WIb; (void)Ub; (void)SGA; (void)SGB; (void)YAYP; (void)DP; (void)T1; (void)MRG; (void)X1F; (void)X1B; \
    (void)XS; (void)ACT; (void)YR; (void)PLEPb; (void)PLEV; (void)TOPI; (void)GATE; (void)LRANK; (void)TOKROW; (void)ROWG; (void)lw; (void)HISTL; (void)TILE;

#pragma unroll 1
    for (int ph = lo; ph < hi; ++ph) {
    const int kind = PH_KIND(ph), l = (ph - 1) / PH_PER_LAYER;
    if (kind == 0 && HASK(0)) REPS(0) {
        PHASE_VARS
        const float* x_in = ARGP(0); const float* p_in = ARGP(1);
        if (blk < DEPTH * B_LAYER) {
            P0D cur; p0_decode(cur, blk, wave, ws, kargs_, lane); f32x4 tv[16]; int par = 0;
#pragma unroll
            for (int i = 0; i < 16; ++i) tv[i] = __builtin_nontemporal_load((const f32x4*)(cur.src + (size_t)i * cur.nsrc));
#pragma unroll 1
            for (int it = blk;; it += G) {
                const bool has = it + G < DEPTH * B_LAYER; P0D nx; f32x4 tn[16];
                p0_decode(nx, has ? it + G : it, wave, ws, kargs_, lane);
#pragma unroll
                for (int i = 0; i < 16; ++i) tn[i] = __builtin_nontemporal_load((const f32x4*)(nx.src + (size_t)i * nx.nsrc));
                asm volatile("" ::: "memory");
                const float sc_ = cur.valid ? cur.ws : 0.f;
                LAS unsigned char* tile = lds + par * 65536; par ^= 1;
                if (cur.i8) {
#pragma unroll
                    for (int c = 0; c < 4; ++c) { u32x4 o;
                        o.x = pack4_i8(tv[0][c] * sc_, tv[1][c] * sc_, tv[2][c] * sc_, tv[3][c] * sc_); o.y = pack4_i8(tv[4][c] * sc_, tv[5][c] * sc_, tv[6][c] * sc_, tv[7][c] * sc_);
                        o.z = pack4_i8(tv[8][c] * sc_, tv[9][c] * sc_, tv[10][c] * sc_, tv[11][c] * sc_); o.w = pack4_i8(tv[12][c] * sc_, tv[13][c] * sc_, tv[14][c] * sc_, tv[15][c] * sc_);
                        *(LAS u32x4*)(tile + (4 * lane + c) * 128 + 16 * (wave ^ (lane & 7))) = o; }
                    LDS_WAIT(); __builtin_amdgcn_s_barrier();
#pragma unroll
                    for (int j = 0; j < 4; ++j) { const int ci = j * 512 + tid, n = ci >> 3, q = ci & 7;
                        __builtin_nontemporal_store(*(const LAS u32x4*)(tile + n * 128 + 16 * (q ^ ((n >> 2) & 7))), (GAS u32x4*)(cur.dst + (size_t)n * cur.ldtb + 16 * q)); }
                } else {
#pragma unroll
                    for (int c = 0; c < 4; ++c) { u32x4 o0, o1;
                        o0.x = pk2(tv[0][c] * sc_, tv[1][c] * sc_); o0.y = pk2(tv[2][c] * sc_, tv[3][c] * sc_); o0.z = pk2(tv[4][c] * sc_, tv[5][c] * sc_); o0.w = pk2(tv[6][c] * sc_, tv[7][c] * sc_);
                        o1.x = pk2(tv[8][c] * sc_, tv[9][c] * sc_); o1.y = pk2(tv[10][c] * sc_, tv[11][c] * sc_); o1.z = pk2(tv[12][c] * sc_, tv[13][c] * sc_); o1.w = pk2(tv[14][c] * sc_, tv[15][c] * sc_);
                        *(LAS u32x4*)(tile + (4 * lane + c) * 256 + 16 * ((2 * wave) ^ (lane & 7))) = o0; *(LAS u32x4*)(tile + (4 * lane + c) * 256 + 16 * ((2 * wave + 1) ^ (lane & 7))) = o1; }
                    LDS_WAIT(); __builtin_amdgcn_s_barrier();
#pragma unroll
                    for (int j = 0; j < 8; ++j) { const int ci = j * 512 + tid, n = ci >> 4, q = ci & 15;
                        __builtin_nontemporal_store(*(const LAS u32x4*)(tile + n * 256 + 16 * (q ^ ((n >> 2) & 7))), (GAS u32x4*)(cur.dst + (size_t)n * cur.ldtb + 16 * q)); }
                }
                if (!has) break;
                cur = nx;
#pragma unroll
                for (int i = 0; i < 16; ++i) tv[i] = tn[i];
            }
        }
        __syncthreads();
        for (int it = gtid; it < DEPTH * 64 * 1024; it += NT) {
            const int n = it & 1023, kc = (it >> 10) & 63, ll = it >> 16, g = kc >> 4, c0 = (kc & 15) * 8;
            const float* pw = ARGP(5) + ((size_t)(ll * 4 + g) * 128 + c0) * 128;
            const float* sc = ARGP(6) + (size_t)ll * 512 + g * 128;
            const float* wp = ARGP(8) + ((size_t)ll * 512 + g * 128) * D + n;
            LAS float* PWL = (LAS float*)(lds + wave * 8192);
#pragma unroll
            for (int q4 = 0; q4 < 4; ++q4) *(LAS f32x4*)(PWL + 4 * (lane + 64 * q4)) = *(const f32x4*)(pw + 4 * (lane + 64 * q4));
            if (lane < 32) *(LAS f32x4*)(PWL + 1024 + 4 * lane) = *(const f32x4*)(sc + 4 * lane);
            WAVE_FENCE();
            float a8[8];
#pragma unroll
            for (int j = 0; j < 8; ++j) a8[j] = 0.f;
#pragma unroll 1
            for (int d0 = 0; d0 < 128; d0 += 16) {
                float w16[16];
#pragma unroll
                for (int i = 0; i < 16; ++i) w16[i] = wp[(size_t)i * D];
                wp += (size_t)16 * D;
                asm volatile("" ::: "memory");
#pragma unroll
                for (int i4 = 0; i4 < 4; ++i4) {
                    const f32x4 s4 = *(const LAS f32x4*)(PWL + 1024 + d0 + 4 * i4);
                    const f32x4 w4 = (f32x4){w16[4 * i4] * s4[0], w16[4 * i4 + 1] * s4[1], w16[4 * i4 + 2] * s4[2], w16[4 * i4 + 3] * s4[3]};
#pragma unroll
                    for (int j = 0; j < 8; ++j) { const f32x4 p4 = *(const LAS f32x4*)(PWL + j * 128 + d0 + 4 * i4); a8[j] += (p4[0] * w4[0] + p4[1] * w4[1]) + (p4[2] * w4[2] + p4[3] * w4[3]); }
                }
            }
            u32x4 o; o.x = pk2(a8[0], a8[1]); o.y = pk2(a8[2], a8[3]); o.z = pk2(a8[4], a8[5]); o.w = pk2(a8[6], a8[7]);
            *(u32x4*)((bf16*)(ws + WS_W + (size_t)ll * LW_SIZE + LW_WUPA) + (size_t)n * 1024 + 512 + 8 * kc) = o;
            WAVE_FENCE();
        }
        for (int it = gtid; it < DEPTH * 32 * 128; it += NT) {
            const int ll = it >> 12, e = (it >> 7) & 31, k8 = it & 127; const float* wr = ARGP(12) + (size_t)ll * D * NE + (size_t)(8 * k8) * NE + e;
            float wv8[8];
#pragma unroll
            for (int i = 0; i < 8; ++i) wv8[i] = wr[i * NE];
            unsigned hh[4], lo4[4];
#pragma unroll
            for (int i = 0; i < 4; ++i) { hh[i] = pk2(wv8[2 * i], wv8[2 * i + 1]); lo4[i] = pk2(wv8[2 * i] - bflo(hh[i]), wv8[2 * i + 1] - bfhi(hh[i])); }
            bf16* wt = (bf16*)(ws + WS_W + (size_t)ll * LW_SIZE + LW_POOL);
            *(u32x4*)(wt + (size_t)e * 1024 + 8 * k8) = (u32x4){hh[0], hh[1], hh[2], hh[3]}; *(u32x4*)(wt + 32768 + (size_t)e * 1024 + 8 * k8) = (u32x4){lo4[0], lo4[1], lo4[2], lo4[3]};
        }
        for (int it = gtid; it < SEQ * 8; it += NT) {
            const int pos = it >> 3, i = it & 7; const double tr = (double)pos * ROPE_TURNS[i]; const float fr = (float)(tr - __builtin_rint(tr));
            ROPE[pos * 16 + i] = __builtin_amdgcn_cosf(fr); ROPE[pos * 16 + 8 + i] = __builtin_amdgcn_sinf(fr);
        }
        { f32x4 pa[8], pc[8];
#pragma unroll
          for (int q = 0; q < 8; ++q) { const size_t it = (size_t)gtid + (size_t)q * NT; pa[q] = __builtin_nontemporal_load((const f32x4*)(p_in + it * 8)); pc[q] = __builtin_nontemporal_load((const f32x4*)(p_in + it * 8 + 4)); }
#pragma unroll
          for (int q = 0; q < 8; ++q) { const size_t it = (size_t)gtid + (size_t)q * NT; *(u32x4*)(PB16 + it * 8) = pg8::pack8(pa[q], pc[q]); } }
#pragma unroll 1
        for (int m = gw; m < M; m += 4 * NGW) {
            f32x4 v[4][4];
#pragma unroll
            for (int u = 0; u < 4; ++u)
#pragma unroll
                for (int j = 0; j < 4; ++j) v[u][j] = __builtin_nontemporal_load((const f32x4*)(x_in + (size_t)(m + u * NGW) * D + 4 * lane + 256 * j));
            LnGB gb0; ln_load(gb0, ARGP(2), ARGP(3), lane);
#pragma unroll
            for (int u = 0; u < 4; ++u) { const int mr = m + u * NGW; ln_regs(v[u], gb0, lane);
                store_row_bf16(XF + (size_t)mr * D, v[u], lane); store_row_i8(XQ + (size_t)mr * D, XQS + mr, v[u], lane); }
        }
    }
        else if (kind == 1 && HASK(1)) REPS(1) {
            PHASE_VARS
            pg8::StaticSched S; S.init(M, NZ, G, blk, XQ, D / 2, lw + LW_WIN, D / 2);
            pg8::EpiZ<true> E{Qb, KVb, QIb, KIb, WIb, Ub, SGA, SGB, ROPE, XQS};
            pg8::gemm_phase<pg8::EpiZ<true>, pg8::StaticSched, true, true>(lds, wave, pg8::Gemm{D / 2, D / 2}, S, E);
        }
        else if (kind == 2 && HASK(2)) REPS(2) {
            PHASE_VARS
            if (G == 256) {
                const int bb = (blk & 7) >> 1, cb = ((blk & 7) & 1) * 32 + (blk >> 3);
                for (int j = 0; j < 4; ++j) {
                    const int tq = 64 * j + ((j & 1) ? (63 - cb) : cb);
                    attn_unit(lds, wave, lane, bb, 16 * tq, QIb, KIb, WIb, Qb, KVb, YAYP);
                    __syncthreads();
                }
            } else {
                for (int j = 0; j < (1024 + G - 1) / G; ++j) {
                    const int id = G * j + ((j & 1) ? (G - 1 - blk) : blk);
                    if (id < 1024) attn_unit(lds, wave, lane, id & 3, 16 * (id >> 2), QIb, KIb, WIb, Qb, KVb, YAYP);
                    __syncthreads();
                }
            }
            for (int repw_ = 0; repw_ < (ATT_PROBE == 4 ? 2 : 1); ++repw_) pool_window(Ub, YAYP + 512, gtid, NT);
            __syncthreads();
            { pg8::StaticSched S; S.init(M, D, G, blk, PB16 + (size_t)l * M * PLE, PLE, lw + LW_PLEP, PLE);
              pg8::EpiBf16 E{PLEPb, 1024, 0, nullptr};
              pg8::gemm_phase<pg8::EpiBf16, pg8::StaticSched, true>(lds, wave, pg8::Gemm{PLE, PLE}, S, E); }
        }
        else if (kind == 3) { }
        else if (kind == 4 && HASK(4)) REPS(4) {
            PHASE_VARS
            { pg8::StaticSched S; S.init(M, D, G, blk, YAYP, 1024, lw + LW_WUPA, 1024);
              pg8::EpiGateMerge E{SGA, SGB, MRG};
              pg8::gemm_phase<pg8::EpiGateMerge, pg8::StaticSched, true>(lds, wave, pg8::Gemm{1024, 1024}, S, E); }
        }
        else if (kind == 5 && HASK(5)) REPS(5) {
            PHASE_VARS
            pg8::StaticSched S; S.init(M, D, G, blk, MRG, D, lw + LW_WOUT, D);
            pg8::EpiResid E{XF, T1, DN_ALPHA};
            pg8::gemm_phase<pg8::EpiResid, pg8::StaticSched, true>(lds, wave, pg8::Gemm{D, D}, S, E);
        }
        else if (kind == 6 && HASK(6)) REPS(6) {
            PHASE_VARS
            if (blk < 256) ln1_router_mfma(lds, tid, wave, lane, blk, T1, ARGP(10) + (size_t)l * D, ARGP(11) + (size_t)l * D, (const bf16*)(lw + LW_POOL), ARGP(13) + (size_t)l * NE,
                                            X1F, X1Q, X1S, TOPI, TOKROW, P2T, P2G, P2S, CNTG);
        }
        else if (kind == 7) { }
        else if (kind == 8 && HASK(8)) REPS(8) {
            PHASE_VARS
            LAS int* TL = (LAS int*)(lds + XTRA_OFF); LAS int* TS = TL + 384; LAS int* CN = TL + 416;
            build_tiles(TL, TS, CN, CNTG, tid);
            const int ntiles = TL[0];
            const int slotsH = ((ntiles * 8 + G - 1) / G) * G - ntiles * 8, pleH = slotsH < 256 ? slotsH : 256;
            {
              pg8::MoeSched S{ntiles, 8, G, (blk & 7) * (G >> 3) + (blk >> 3), TL + 1, (const char*)X1Q, (const char*)(lw + LW_WGU), (size_t)0, (size_t)2048 * D, (size_t)256 * D,
                              0, pleH, (const char*)X1Q, (const char*)(lw + LW_PLEG), (size_t)0, (size_t)256 * D};
              LAS int* RT = (LAS int*)(lds + XTRA_OFF + 2048);
              LAS float* RS = (LAS float*)(lds + XTRA_OFF + 2048 + 10240);
              for (int i = wave;; i += NWAVES) { pg8::Unit u; if (!S.next(i, u)) break;
                  int rv[4]; float sv[4];
                  if (u.aux >= 0) { const int e = u.aux, p0 = (u.pm - TS[e]) * 256, ce = CN[e];
#pragma unroll
                      for (int k = 0; k < 4; ++k) { const int pos = p0 + lane + 64 * k; const size_t ix = (size_t)e * CAPE + (pos < ce ? pos : 0); rv[k] = P2T[ix]; sv[k] = P2S[ix]; }
                  } else {
#pragma unroll
                      for (int k = 0; k < 4; ++k) { rv[k] = u.pm * 256 + lane + 64 * k; sv[k] = 0.f; } }
#pragma unroll
                  for (int k = 0; k < 4; ++k) { RT[i * 256 + lane + 64 * k] = rv[k]; RS[i * 256 + lane + 64 * k] = sv[k]; } }
              __syncthreads();
              pg8::EpiSwigluPle E{{ARGP(15) + (size_t)l * NE * 2048, RS, (unsigned char*)ACT}, {PLEPb, X1S, PLEV}};
              pg8::gemm_phase<pg8::EpiSwigluPle, pg8::MoeSched, true, true, true>(lds, wave, pg8::Gemm{D / 2, D / 2}, S, E, RT); }
        }
        else if (kind == 9 && HASK(9)) REPS(9) {
            PHASE_VARS
            LAS int* TL = (LAS int*)(lds + XTRA_OFF); LAS int* TS = TL + 384; LAS int* CN = TL + 416;
            build_tiles(TL, TS, CN, CNTG, tid);
            const int ntiles = TL[0];
            const int slotsH = ((ntiles * 8 + G - 1) / G) * G - ntiles * 8, pleH = slotsH < 256 ? slotsH : 256;
            { pg8::MoeSched S{ntiles, 4, G, (blk & 7) * (G >> 3) + (blk >> 3), TL + 1, (const char*)ACT, (const char*)(lw + LW_WDN), (size_t)256 * DFF, (size_t)D * DFF, (size_t)256 * DFF,
                              pleH, 256 - pleH, (const char*)X1Q, (const char*)(lw + LW_PLEG), (size_t)256 * D, (size_t)256 * D};
              pg8::EpiDownPle E{{ARGP(17) + (size_t)l * NE * D, P2G, TS, YR}, {PLEPb, X1S, PLEV}};
              pg8::gemm_phase<pg8::EpiDownPle, pg8::MoeSched, true, true>(lds, wave, pg8::Gemm{DFF / 2, DFF / 2}, S, E); }
        }
        else if (kind == 10 && HASK(10)) REPS(10) {
            PHASE_VARS
            LAS int* TL = (LAS int*)(lds + XTRA_OFF); LAS int* TS = TL + 384; LAS int* CN = TL + 416;
            build_tiles(TL, TS, CN, CNTG, tid);
            combine_ln2_phase(gw, NGW, lane, X1F, PLEV, YR, TOPI, TOKROW, TS, ARGP(20) + (size_t)l * D, ARGP(21) + (size_t)l * D, XF, XQ, XQS, (l == DEPTH - 1) ? (float*)(GAS float*)kargs_[22] : nullptr);
        }
    if (ph + 1 < hi && kind != 3 && kind != 7) { GRID_BAR(); if (ATT_PROBE == 5) GRID_BAR(); }
    }
}

#if MK_N_LAUNCHES == 1
#define MEGA_ALL mega_fwd<0x7ffu>
#else
typedef void (*kern_t)(Args);
static kern_t phase_kernel(int kind) {
    switch (kind) { case 0: return mega_fwd<1u>; case 1: return mega_fwd<2u>; case 2: return mega_fwd<4u>; case 3: return mega_fwd<8u>; case 4: return mega_fwd<16u>; case 5: return mega_fwd<32u>;
                    case 6: return mega_fwd<64u>; case 7: return mega_fwd<128u>; case 8: return mega_fwd<256u>; case 9: return mega_fwd<512u>; default: return mega_fwd<1024u>; }
}
#endif
extern "C" void kernel_launch(void* const* d_in, const int* in_sizes, int n_in, void* d_out, int out_size, void* d_ws, size_t ws_size, hipStream_t stream) {
    static int grid = 0;
    if (grid == 0) {
        if (n_in != 22 || out_size != M * D || ws_size < WS_END) { fprintf(stderr, "kernel_launch: unexpected shapes (n_in %d out %d ws %zu need %zu)\n", n_in, out_size, ws_size, (size_t)WS_END); grid = -1; return; }
        int dev = 0, cus = 0, per_cu = 0;
        if (hipGetDevice(&dev) != hipSuccess || hipDeviceGetAttribute(&cus, hipDeviceAttributeMultiprocessorCount, dev) != hipSuccess) { grid = -1; return; }
#if MK_N_LAUNCHES == 1
        if (hipFuncSetAttribute((const void*)MEGA_ALL, hipFuncAttributeMaxDynamicSharedMemorySize, LDS_BYTES) != hipSuccess) { fprintf(stderr, "kernel_launch: hipFuncSetAttribute failed\n"); grid = -1; return; }
        if (hipOccupancyMaxActiveBlocksPerMultiprocessor(&per_cu, (const void*)MEGA_ALL, NWAVES * 64, LDS_BYTES) != hipSuccess || per_cu < 1) { fprintf(stderr, "kernel_launch: occupancy query says %d blocks per CU\n", per_cu); grid = -1; return; }
#else
        for (int k = 0; k <= PH_PER_LAYER; ++k) if (hipFuncSetAttribute((const void*)phase_kernel(k), hipFuncAttributeMaxDynamicSharedMemorySize, LDS_BYTES) != hipSuccess) { fprintf(stderr, "kernel_launch: hipFuncSetAttribute failed\n"); grid = -1; return; }
        per_cu = 1;
#endif
        (void)hipGetLastError();
        grid = cus < 256 ? cus : 256;
    }
    if (grid < 0) return;
    (void)hipMemsetAsync((char*)d_ws + WS_CTL, 0, CTL_ZERO_BYTES, stream);
    Args a{};
    for (int i = 0; i < 22; ++i) a.in[i] = (const float*)d_in[i];
    a.out = (float*)d_out; a.ws = (unsigned char*)d_ws;
#if MK_N_LAUNCHES == 1
    a.ph_lo = 0; a.ph_hi = N_PHASES;
    hipLaunchKernelGGL(MEGA_ALL, dim3(grid), dim3(NWAVES * 64), LDS_BYTES, stream, a);
#else
    for (int ph = 0; ph < N_PHASES; ++ph) { a.ph_lo = ph; a.ph_hi = ph + 1; hipLaunchKernelGGL(phase_kernel(PH_KIND(ph)), dim3(grid), dim3(NWAVES * 64), LDS_BYTES, stream, a); }
#endif
}
```
